# Optimizing an MI355X kernel written in HIP

```python
import jax, jax.numpy as jnp
from jax import lax
import numpy as np

D_MODEL = 1024
BATCH = 16
SEQ = 256
DEPTH = 1
DEC_BATCH = 2
DEC_SEQ = 1024
PAST_LEN = 256

GRID_W = 64
D_CONV = D_MODEL
CONV_W = 3
DN_HEADS = 8
DN_HEAD_DIM = 128
D_DN = DN_HEADS * DN_HEAD_DIM
DN_CONV_W = 3
CHUNK = 64
D_FF = 2816
N_ADA = 9
N_IN = 3 * D_CONV + 4 * D_DN + 2 * D_MODEL + 4 * DN_HEADS
EPS = 1e-6
POS_BASE = 10000.0

kernel_name = 'hybrid_conv_deltanet_flow_step'


def _rmsnorm(x, w):
    xf = x.astype(jnp.float32)
    y = xf * lax.rsqrt(jnp.mean(xf * xf, axis=-1, keepdims=True) + EPS)
    return (y * w.astype(jnp.float32)).astype(x.dtype)


def _modulate(x, shift, scale):
    return x * (1 + scale) + shift


def _swiglu(x, wg, wu, wd):
    return (jax.nn.silu(x @ wg) * (x @ wu)) @ wd


def _l2norm(x):
    return x * lax.rsqrt(jnp.sum(x * x, axis=-1, keepdims=True) + EPS)


def _conv_rows(x, w, n_rows):
    b, t, ch = x.shape
    width = w.shape[0]
    half = width // 2
    row_len = t // n_rows
    xp = jnp.pad(x.reshape(b, n_rows, row_len, ch), ((0, 0), (0, 0), (half, half), (0, 0)))
    y = xp[:, :, 0:row_len] * w[0]
    for i in range(1, width):
        y = y + xp[:, :, i:i + row_len] * w[i]
    return y.reshape(b, t, ch)


def _grid_pos_embed(n_rows):
    t = jnp.arange(n_rows * GRID_W)
    r = (t // GRID_W).astype(jnp.float32)
    col = (t % GRID_W).astype(jnp.float32)
    quarter = D_MODEL // 4
    omega = 1.0 / (POS_BASE ** (jnp.arange(quarter, dtype=jnp.float32) / quarter))
    ar = r[:, None] * omega
    ac = col[:, None] * omega
    return jnp.concatenate([jnp.sin(ar), jnp.cos(ar), jnp.sin(ac), jnp.cos(ac)], axis=-1)


def _gated_delta_chunked(q, k, v, g, beta, s0):
    b, h, t, dk = q.shape
    dv = v.shape[-1]
    n = t // CHUNK
    q = q.reshape(b, h, n, CHUNK, dk)
    k = k.reshape(b, h, n, CHUNK, dk)
    v = v.reshape(b, h, n, CHUNK, dv)
    g = g.reshape(b, h, n, CHUNK)
    beta = beta.reshape(b, h, n, CHUNK)
    gc = jnp.cumsum(g, axis=-1)
    incl = jnp.tril(jnp.ones((CHUNK, CHUNK), dtype=bool))
    strict = jnp.tril(jnp.ones((CHUNK, CHUNK), dtype=bool), -1)
    decay = jnp.exp(jnp.where(incl, gc[..., :, None] - gc[..., None, :], -jnp.inf))
    kb = k * beta[..., None]
    lower = jnp.where(strict, jnp.einsum('bhncd,bhnsd->bhncs', kb, k) * decay, 0.0)
    tmat = lower + jnp.eye(CHUNK, dtype=jnp.float32)
    rhs = jnp.concatenate([v * beta[..., None], kb * jnp.exp(gc)[..., None]], axis=-1)
    sol = lax.linalg.triangular_solve(tmat, rhs, left_side=True, lower=True, unit_diagonal=True)
    u = sol[..., :dv]
    w = sol[..., dv:]
    a_intra = jnp.where(incl, jnp.einsum('bhncd,bhnsd->bhncs', q, k) * decay, 0.0)
    q_dec = q * jnp.exp(gc)[..., None]
    k_dec = k * jnp.exp(gc[..., -1:] - gc)[..., None]
    g_last = jnp.exp(gc[..., -1])

    def step(s, inp):
        u_i, w_i, qd_i, kd_i, a_i, gl_i = inp
        v_new = u_i - jnp.einsum('bhck,bhkv->bhcv', w_i, s)
        o_i = jnp.einsum('bhck,bhkv->bhcv', qd_i, s) + jnp.einsum('bhcs,bhsv->bhcv', a_i, v_new)
        s = s * gl_i[..., None, None] + jnp.einsum('bhck,bhcv->bhkv', kd_i, v_new)
        return s, o_i

    xs = (jnp.moveaxis(u, 2, 0), jnp.moveaxis(w, 2, 0), jnp.moveaxis(q_dec, 2, 0),
          jnp.moveaxis(k_dec, 2, 0), jnp.moveaxis(a_intra, 2, 0), jnp.moveaxis(g_last, 2, 0))
    s_final, o = lax.scan(step, s0, xs)
    o = jnp.moveaxis(o, 0, 2).reshape(b, h, t, dv)
    return o, s_final


def _mixer(u, s0_f, s0_b, n_rows, p):
    b, t, _ = u.shape
    proj = u @ p['w_in']
    bg = proj[..., 0:D_CONV]
    cg = proj[..., D_CONV:2 * D_CONV]
    xa = proj[..., 2 * D_CONV:3 * D_CONV]
    o1 = 3 * D_CONV
    qkv = proj[..., o1:o1 + 3 * D_DN]
    z = proj[..., o1 + 3 * D_DN:o1 + 4 * D_DN]
    o2 = o1 + 4 * D_DN
    ga = proj[..., o2:o2 + D_MODEL]
    gb = proj[..., o2 + D_MODEL:o2 + 2 * D_MODEL]
    o3 = o2 + 2 * D_MODEL
    b_raw = proj[..., o3:o3 + 2 * DN_HEADS].reshape(b, t, 2, DN_HEADS).astype(jnp.float32)
    a_raw = proj[..., o3 + 2 * DN_HEADS:o3 + 4 * DN_HEADS].reshape(b, t, 2, DN_HEADS).astype(jnp.float32)

    y_a = (bg * _conv_rows(cg * xa, p['conv_w'], n_rows)) @ p['conv_out_w']

    qkv = jax.nn.silu(_conv_rows(qkv, p['dn_conv_w'], n_rows)).astype(jnp.float32)
    qkv = qkv.reshape(b, t, 3, DN_HEADS, DN_HEAD_DIM).transpose(2, 0, 3, 1, 4)
    q = _l2norm(qkv[0]) * (DN_HEAD_DIM ** -0.5)
    k = _l2norm(qkv[1])
    v = qkv[2]
    beta = jax.nn.sigmoid(b_raw).transpose(2, 0, 3, 1)
    g = (-jnp.exp(p['dn_a_log'].astype(jnp.float32))
         * jax.nn.softplus(a_raw + p['dn_dt_bias'].astype(jnp.float32))).transpose(2, 0, 3, 1)
    o_f, s_f = _gated_delta_chunked(q, k, v, g[0], beta[0], s0_f.astype(jnp.float32))
    o_b, s_b = _gated_delta_chunked(jnp.flip(q, 2), jnp.flip(k, 2), jnp.flip(v, 2),
                                    jnp.flip(g[1], -1), jnp.flip(beta[1], -1), s0_b.astype(jnp.float32))
    o = (o_f + jnp.flip(o_b, 2)).transpose(0, 2, 1, 3)
    o = (o * lax.rsqrt(jnp.mean(o * o, axis=-1, keepdims=True) + EPS)
         * p['dn_norm_w'].astype(jnp.float32)
         * jax.nn.silu(z.astype(jnp.float32).reshape(b, t, DN_HEADS, DN_HEAD_DIM)))
    y_b = o.reshape(b, t, D_DN).astype(u.dtype) @ p['dn_out_w']

    mix = (jax.nn.sigmoid(ga) * y_a + jax.nn.sigmoid(gb) * y_b) @ p['w_o']
    return mix, s_f, s_b


def _layer(x, cond, s0_f, s0_b, n_rows, p):
    mod = (jax.nn.silu(cond) @ p['ada_w'] + p['ada_b']).reshape(cond.shape[0], 1, N_ADA, D_MODEL)
    sh1, sc1, g1 = mod[:, :, 0], mod[:, :, 1], mod[:, :, 2]
    sh2, sc2, g2 = mod[:, :, 3], mod[:, :, 4], mod[:, :, 5]
    sh3, sc3, g3 = mod[:, :, 6], mod[:, :, 7], mod[:, :, 8]
    x = x + 0.5 * g1 * _swiglu(_modulate(_rmsnorm(x, p['norm_ffn1']), sh1, sc1),
                               p['ffn1_w_gate'], p['ffn1_w_up'], p['ffn1_w_down'])
    mix, s_f, s_b = _mixer(_modulate(_rmsnorm(x, p['norm_mix']), sh2, sc2), s0_f, s0_b, n_rows, p)
    x = x + g2 * mix
    x = x + 0.5 * g3 * _swiglu(_modulate(_rmsnorm(x, p['norm_ffn2']), sh3, sc3),
                               p['ffn2_w_gate'], p['ffn2_w_up'], p['ffn2_w_down'])
    return x, s_f, s_b


def setup_inputs(seed: int = 0) -> dict:
    key = jax.random.key(seed)
    ks = jax.random.split(key, 32)
    f32 = jnp.float32
    L = DEPTH

    def nrm(k, shape, scale):
        return jax.random.normal(k, shape, f32) * scale

    dt = jnp.exp(jax.random.uniform(ks[18], (L, 2, DN_HEADS), f32, np.log(1e-3), np.log(1e-1)))
    return {
        'x_prompt': nrm(ks[0], (BATCH, SEQ, D_MODEL), 1.0),
        'x_sample': nrm(ks[1], (DEC_BATCH, DEC_SEQ, D_MODEL), 1.0),
        'state_dn_fwd': nrm(ks[2], (DEC_BATCH, L, DN_HEADS, DN_HEAD_DIM, DN_HEAD_DIM), 0.05),
        'state_dn_bwd': nrm(ks[3], (DEC_BATCH, L, DN_HEADS, DN_HEAD_DIM, DN_HEAD_DIM), 0.05),
        'c': nrm(ks[4], (DEC_BATCH, D_MODEL), 1.0),
        'c_ctx': nrm(ks[5], (D_MODEL,), 1.0),
        'ada_w': nrm(ks[6], (L, D_MODEL, N_ADA * D_MODEL), 0.5 * D_MODEL ** -0.5),
        'ada_b': nrm(ks[7], (L, N_ADA * D_MODEL), 0.02),
        'norm_ffn1': 1.0 + nrm(ks[8], (L, D_MODEL), 0.02),
        'ffn1_w_gate': nrm(ks[9], (L, D_MODEL, D_FF), D_MODEL ** -0.5),
        'ffn1_w_up': nrm(ks[10], (L, D_MODEL, D_FF), D_MODEL ** -0.5),
        'ffn1_w_down': nrm(ks[11], (L, D_FF, D_MODEL), D_FF ** -0.5),
        'norm_mix': 1.0 + nrm(ks[12], (L, D_MODEL), 0.02),
        'w_in': nrm(ks[13], (L, D_MODEL, N_IN), D_MODEL ** -0.5),
        'conv_w': nrm(ks[14], (L, CONV_W, D_CONV), CONV_W ** -0.5),
        'conv_out_w': nrm(ks[15], (L, D_CONV, D_MODEL), D_CONV ** -0.5),
        'dn_conv_w': nrm(ks[16], (L, DN_CONV_W, 3 * D_DN), DN_CONV_W ** -0.5),
        'dn_a_log': jnp.log(jax.random.uniform(ks[17], (L, 2, DN_HEADS), f32, 1.0, 16.0)),
        'dn_dt_bias': dt + jnp.log(-jnp.expm1(-dt)),
        'dn_norm_w': 1.0 + nrm(ks[19], (L, DN_HEAD_DIM), 0.02),
        'dn_out_w': nrm(ks[20], (L, D_DN, D_MODEL), D_DN ** -0.5),
        'w_o': nrm(ks[21], (L, D_MODEL, D_MODEL), D_MODEL ** -0.5),
        'norm_ffn2': 1.0 + nrm(ks[22], (L, D_MODEL), 0.02),
        'ffn2_w_gate': nrm(ks[23], (L, D_MODEL, D_FF), D_MODEL ** -0.5),
        'ffn2_w_up': nrm(ks[24], (L, D_MODEL, D_FF), D_MODEL ** -0.5),
        'ffn2_w_down': nrm(ks[25], (L, D_FF, D_MODEL), D_FF ** -0.5),
        'norm_f': 1.0 + nrm(ks[26], (D_MODEL,), 0.02),
    }


def reference(x_prompt, x_sample, state_dn_fwd, state_dn_bwd, c, c_ctx, ada_w, ada_b,
              norm_ffn1, ffn1_w_gate, ffn1_w_up, ffn1_w_down, norm_mix, w_in, conv_w,
              conv_out_w, dn_conv_w, dn_a_log, dn_dt_bias, dn_norm_w, dn_out_w, w_o,
              norm_ffn2, ffn2_w_gate, ffn2_w_up, ffn2_w_down, norm_f):
    def layer_params(l):
        return {'ada_w': ada_w[l], 'ada_b': ada_b[l], 'norm_ffn1': norm_ffn1[l],
                'ffn1_w_gate': ffn1_w_gate[l], 'ffn1_w_up': ffn1_w_up[l], 'ffn1_w_down': ffn1_w_down[l],
                'norm_mix': norm_mix[l], 'w_in': w_in[l], 'conv_w': conv_w[l], 'conv_out_w': conv_out_w[l],
                'dn_conv_w': dn_conv_w[l], 'dn_a_log': dn_a_log[l], 'dn_dt_bias': dn_dt_bias[l],
                'dn_norm_w': dn_norm_w[l], 'dn_out_w': dn_out_w[l], 'w_o': w_o[l],
                'norm_ffn2': norm_ffn2[l], 'ffn2_w_gate': ffn2_w_gate[l], 'ffn2_w_up': ffn2_w_up[l],
                'ffn2_w_down': ffn2_w_down[l]}

    h = x_prompt
    zero_state = jnp.zeros((x_prompt.shape[0], DN_HEADS, DN_HEAD_DIM, DN_HEAD_DIM), jnp.float32)
    states_f = []
    states_b = []
    for l in range(DEPTH):
        h, s_f, s_b = _layer(h, c_ctx[None, :], zero_state, zero_state, 1, layer_params(l))
        states_f.append(s_f)
        states_b.append(s_b)
    y_prompt = _rmsnorm(h, norm_f)
    new_state_dn_fwd = jnp.stack(states_f, axis=1).astype(x_prompt.dtype)
    new_state_dn_bwd = jnp.stack(states_b, axis=1).astype(x_prompt.dtype)

    rows = x_sample.shape[1] // GRID_W
    zt = x_sample + _grid_pos_embed(rows).astype(x_sample.dtype)[None]
    for l in range(DEPTH):
        zt, _, _ = _layer(zt, c, state_dn_fwd[:, l], state_dn_bwd[:, l], rows, layer_params(l))
    y_sample = _rmsnorm(zt, norm_f)
    return (y_prompt, y_sample, new_state_dn_fwd, new_state_dn_bwd)
```

```cpp
#include <hip/hip_runtime.h>
#include <hip/hip_cooperative_groups.h>
#include <cstdio>
#include <cstdint>
namespace cg = cooperative_groups;
namespace pg8 {
#define PG8_LAS __attribute__((address_space(3)))
typedef unsigned short bf16_t;
typedef short bf16x8 __attribute__((ext_vector_type(8)));
typedef float f32x4 __attribute__((ext_vector_type(4)));
typedef unsigned u32x4 __attribute__((ext_vector_type(4)));
constexpr int BM = 256, BK = 64, HALF = 128, HTB = HALF * BK * 2  , STAGE_BYTES = 8 * HTB, NXCD = 8, WGM = 8;

__host__ __device__ __forceinline__ int lds_byte(int r, int c) { const int st = (r >> 4) * 2 + (c >> 5), rr = r & 15, cc = c & 31, ob = rr * 64 + cc * 2; return st * 1024 + (ob ^ (((ob >> 9) & 1) << 5)); }
__host__ __device__ __forceinline__ void stage_rc(int b, int& R, int& C) { const int st = b / 1024, sb = b % 1024, swz = sb ^ (((sb >> 9) & 1) << 5); R = (st >> 1) * 16 + swz / 64; C = (st & 1) * 32 + (swz % 64) / 2; }
__host__ __device__ __forceinline__ int perm32(int rho) { const int n = rho >> 4, i = rho & 15; return 8 * (i >> 2) + 4 * n + (i & 3); }

struct Unit { int pm, pn; };
struct Gemm { const bf16_t* A; const bf16_t* Bt; int M, N, K; };

struct StaticOrder {
    int nM, nN, nwg, G, c;
    __host__ __device__ void init(int M, int N, int G_, int c_) { nM = M / BM; nN = N / BM; nwg = nM * nN; G = G_; c = c_; }
    __host__ __device__ bool next(int i, Unit& u) const {
        const long L = (long)i * G + c; if (L >= nwg) return false;
        int wgid = (int)L; { const int q = nwg / NXCD, r = nwg % NXCD, xcd = wgid % NXCD, off = wgid / NXCD; wgid = (xcd < r ? xcd * (q + 1) : r * (q + 1) + (xcd - r) * q) + off; }
        const int nig = WGM * nN, gid = wgid / nig, fm = gid * WGM, gsz = (nM - fm) < WGM ? (nM - fm) : WGM;
        u.pm = fm + ((wgid % nig) % gsz); u.pn = (wgid % nig) / gsz; return true;
    }
    __device__ __forceinline__ void a_ready(const Unit&) const {}
    __device__ __forceinline__ void done(const Unit&) const {}
};
__device__ __forceinline__ unsigned pk2bf(float a, float b) { typedef float f2v __attribute__((ext_vector_type(2))); typedef __bf16 b2v __attribute__((ext_vector_type(2))); f2v v = {a, b}; b2v r = __builtin_convertvector(v, b2v); return __builtin_bit_cast(unsigned, r); }
__device__ __forceinline__ float bflo(unsigned u) { return __uint_as_float(u << 16); }
__device__ __forceinline__ float bfhi(unsigned u) { return __uint_as_float(u & 0xffff0000u); }
__device__ __forceinline__ float siluf(float x) { return x / (1.f + __expf(-x)); }
__device__ __forceinline__ float sigmf(float x) { return 1.f / (1.f + __expf(-x)); }
__device__ __forceinline__ int cond_of_tile(int pm) { return pm < 16 ? 0 : 1 + ((pm - 16) >> 2); }
constexpr int NTOK = 6144, DM = 1024, FFH = 2816, NMOD = 9216;
typedef unsigned u32x2 __attribute__((ext_vector_type(2)));

struct EpiSwiglu {
    static constexpr bool PERM = false, AFTER_DRAIN = false;
    bf16_t* H;
    __device__ __forceinline__ void operator()(const f32x4 (&acc)[2][2][4][2], const Unit& u, int wr, int wc, int fr, int fq) const {
        const int row0 = u.pm * BM + wr * 64 + fr, col0 = u.pn * 128 + wc * 32 + 4 * fq;
#pragma unroll
        for (int ai = 0; ai < 2; ++ai)
#pragma unroll
            for (int m = 0; m < 4; ++m) { bf16_t* rowp = H + (size_t)(row0 + ai * HALF + m * 16) * FFH + col0;
#pragma unroll
                for (int n = 0; n < 2; ++n) { const f32x4 g = acc[ai][0][m][n], up = acc[ai][1][m][n];
                    u32x2 o; o.x = pk2bf(siluf(g[0]) * up[0], siluf(g[1]) * up[1]); o.y = pk2bf(siluf(g[2]) * up[2], siluf(g[3]) * up[3]);
                    *(u32x2*)(rowp + n * 16) = o; } }
    }
};
struct EpiResid {
    static constexpr bool PERM = false, AFTER_DRAIN = false;
    const float* Xin; float* Xout; const float* gate; float scale;
    __device__ __forceinline__ void operator()(const f32x4 (&acc)[2][2][4][2], const Unit& u, int wr, int wc, int fr, int fq) const {
        const int row0 = u.pm * BM + wr * 64 + fr, col0 = u.pn * BM + wc * 32 + 4 * fq;
        const float* gp = gate + (size_t)cond_of_tile(u.pm) * NMOD + col0;
        f32x4 gv[2][2];
#pragma unroll
        for (int bj = 0; bj < 2; ++bj)
#pragma unroll
            for (int n = 0; n < 2; ++n) gv[bj][n] = *(const f32x4*)(gp + bj * HALF + n * 16) * scale;
#pragma unroll
        for (int ai = 0; ai < 2; ++ai)
#pragma unroll
            for (int m = 0; m < 4; ++m) { const size_t off = (size_t)(row0 + ai * HALF + m * 16) * DM + col0;
#pragma unroll
                for (int bj = 0; bj < 2; ++bj)
#pragma unroll
                    for (int n = 0; n < 2; ++n) { const f32x4 x = *(const f32x4*)(Xin + off + bj * HALF + n * 16);
                        *(f32x4*)(Xout + off + bj * HALF + n * 16) = x + gv[bj][n] * acc[ai][bj][m][n]; } }
    }
};
struct EpiProj {
    static constexpr bool PERM = false, AFTER_DRAIN = false;
    bf16_t* P; float* EX;
    __device__ __forceinline__ void operator()(const f32x4 (&acc)[2][2][4][2], const Unit& u, int wr, int wc, int fr, int fq) const {
        const int row0 = u.pm * BM + wr * 64 + fr;
        if (u.pn < 36) {
            bf16_t* base = P + (size_t)(u.pn >> 2) * NTOK * DM; const int col0 = (u.pn & 3) * 256 + wc * 32 + 4 * fq;
#pragma unroll
            for (int ai = 0; ai < 2; ++ai)
#pragma unroll
                for (int m = 0; m < 4; ++m) { bf16_t* rowp = base + (size_t)(row0 + ai * HALF + m * 16) * DM + col0;
#pragma unroll
                    for (int bj = 0; bj < 2; ++bj)
#pragma unroll
                        for (int n = 0; n < 2; ++n) { const f32x4 v = acc[ai][bj][m][n]; u32x2 o; o.x = pk2bf(v[0], v[1]); o.y = pk2bf(v[2], v[3]); *(u32x2*)(rowp + bj * HALF + n * 16) = o; } }
        } else if (wc == 0) {
#pragma unroll
            for (int ai = 0; ai < 2; ++ai)
#pragma unroll
                for (int m = 0; m < 4; ++m)
#pragma unroll
                    for (int n = 0; n < 2; ++n) *(f32x4*)(EX + (size_t)(row0 + ai * HALF + m * 16) * 32 + n * 16 + 4 * fq) = acc[ai][0][m][n];
        }
    }
};
template <int SECOND> struct EpiGate {
    static constexpr bool PERM = false, AFTER_DRAIN = false;
    const bf16_t* G; float* T; bf16_t* O;
    __device__ __forceinline__ void operator()(const f32x4 (&acc)[2][2][4][2], const Unit& u, int wr, int wc, int fr, int fq) const {
        const int row0 = u.pm * BM + wr * 64 + fr, col0 = u.pn * BM + wc * 32 + 4 * fq;
#pragma unroll
        for (int ai = 0; ai < 2; ++ai)
#pragma unroll
            for (int m = 0; m < 4; ++m) { const size_t off = (size_t)(row0 + ai * HALF + m * 16) * DM + col0;
#pragma unroll
                for (int bj = 0; bj < 2; ++bj)
#pragma unroll
                    for (int n = 0; n < 2; ++n) { const size_t o = off + bj * HALF + n * 16; const u32x2 gr = *(const u32x2*)(G + o); const f32x4 a = acc[ai][bj][m][n];
                        f32x4 v; v[0] = sigmf(bflo(gr.x)) * a[0]; v[1] = sigmf(bfhi(gr.x)) * a[1]; v[2] = sigmf(bflo(gr.y)) * a[2]; v[3] = sigmf(bfhi(gr.y)) * a[3];
                        if (SECOND == 0) *(f32x4*)(T + o) = v;
                        else { const f32x4 t = *(const f32x4*)(T + o); v = v + t; u32x2 w; w.x = pk2bf(v[0], v[1]); w.y = pk2bf(v[2], v[3]); *(u32x2*)(O + o) = w; } } }
    }
};

template <class Epi, class Sched, bool STAMP = false>
__device__ __forceinline__ void gemm_phase(PG8_LAS unsigned char* lds, const Gemm g, const Sched& S, const Epi& E, unsigned long long* stamps) {
    const int tid = threadIdx.x, wid = __builtin_amdgcn_readfirstlane(tid >> 6), lane = tid & 63, wr = wid >> 2, wc = wid & 3, fr = lane & 15, fq = lane >> 4;
    const int K = g.K, nt = K / BK;
    int ts_lo = 0, ts_hi = 0, nts = 0; const unsigned long long rt_entry = STAMP ? (unsigned long long)wall_clock64() : 0ull;
#define PG8_STAMP() do { if (STAMP && wid == 0 && nts < 64) { const unsigned long long _c = (unsigned long long)clock64(); \
        ts_lo = (lane == nts) ? (int)(unsigned)_c : ts_lo; ts_hi = (lane == nts) ? (int)(unsigned)(_c >> 32) : ts_hi; ++nts; } } while (0)
    PG8_STAMP();
    unsigned voffA[2], voffB[2];
#pragma unroll
    for (int i = 0; i < 2; ++i) { int R, C; stage_rc(tid * 16 + i * 8192, R, C); const int Rb = Epi::PERM ? ((R & ~31) + perm32(R & 31)) : R;
        voffA[i] = (unsigned)(R * K + C) * 2u; voffB[i] = (unsigned)(Rb * K + C) * 2u; }
    const size_t kstep = (size_t)(BK * 2);
    const size_t hstep = (size_t)HALF * K * 2;
    const size_t tstep = 2 * hstep;
    const unsigned ldsw = (unsigned)wid * 1024u;
    const int aoff = lds_byte(wr * 64 + fr, fq * 8), boff = lds_byte(wc * 32 + fr, fq * 8);
#define PG8_SA(b, h) (((b) * 2 + (h)) * HTB)
#define PG8_SB(b, h) ((4 + (b) * 2 + (h)) * HTB)
#define PG8_STAGE(bufoff, gbase, voff) do { _Pragma("unroll") for (int _i = 0; _i < 2; ++_i) \
        __builtin_amdgcn_global_load_lds((const unsigned*)((const char*)(gbase) + (voff)[_i]), (PG8_LAS unsigned*)(lds + (bufoff) + ldsw + _i * 8192), 16, 0, 0); } while (0)
#define PG8_LDA(dst, b, h) do { _Pragma("unroll") for (int m = 0; m < 4; ++m) _Pragma("unroll") for (int k = 0; k < 2; ++k) dst[m][k] = *(const PG8_LAS bf16x8*)(lds + PG8_SA(b, h) + aoff + m * 2048 + k * 1024); } while (0)
#define PG8_LDB(dst, b, h) do { _Pragma("unroll") for (int n = 0; n < 2; ++n) _Pragma("unroll") for (int k = 0; k < 2; ++k) dst[n][k] = *(const PG8_LAS bf16x8*)(lds + PG8_SB(b, h) + boff + n * 2048 + k * 1024); } while (0)
#define PG8_MMA(ai, bj, At, Bt) do { __builtin_amdgcn_s_setprio(1); _Pragma("unroll") for (int m = 0; m < 4; ++m) _Pragma("unroll") for (int n = 0; n < 2; ++n) _Pragma("unroll") for (int k = 0; k < 2; ++k) \
        acc[ai][bj][m][n] = __builtin_amdgcn_mfma_f32_16x16x32_bf16(Bt[n][k], At[m][k], acc[ai][bj][m][n], 0, 0, 0); __builtin_amdgcn_s_setprio(0); } while (0)
#define PG8_WAIT_V(n) asm volatile("s_waitcnt vmcnt(" #n ")" ::: "memory")
#define PG8_WAIT_L(n) asm volatile("s_waitcnt lgkmcnt(" #n ")" ::: "memory")
#define PG8_BAR __builtin_amdgcn_s_barrier()
#define PG8_SCHED __builtin_amdgcn_sched_barrier(0)
    Unit cur, nxt; int ui = 0;
    if (!S.next(0, cur)) return;
    f32x4 acc[2][2][4][2];
#pragma unroll
    for (int a = 0; a < 2; ++a)
#pragma unroll
        for (int b = 0; b < 2; ++b)
#pragma unroll
            for (int m = 0; m < 4; ++m)
#pragma unroll
                for (int n = 0; n < 2; ++n) acc[a][b][m][n] = (f32x4){0.f, 0.f, 0.f, 0.f};
    bf16x8 At[4][2], B0[2][2], B1[2][2];
    const char* cA = (const char*)g.A + (size_t)cur.pm * tstep; const char* cB = (const char*)g.Bt + (size_t)cur.pn * tstep;
    S.a_ready(cur);
    PG8_STAGE(PG8_SB(0, 0), cB, voffB); PG8_STAGE(PG8_SA(0, 0), cA, voffA); PG8_STAGE(PG8_SB(0, 1), cB + hstep, voffB); PG8_STAGE(PG8_SA(0, 1), cA + hstep, voffA);
    if (wr == 1) PG8_BAR;
    PG8_WAIT_V(4); PG8_BAR;
    PG8_STAGE(PG8_SB(1, 0), cB + kstep, voffB); PG8_STAGE(PG8_SA(1, 0), cA + kstep, voffA); PG8_STAGE(PG8_SB(1, 1), cB + hstep + kstep, voffB);
    PG8_WAIT_V(6); PG8_BAR;
    PG8_STAMP();
    for (;;) {
        const bool has_next = S.next(ui + 1, nxt);
        const char* nA = has_next ? (const char*)g.A + (size_t)nxt.pm * tstep : cA; const char* nB = has_next ? (const char*)g.Bt + (size_t)nxt.pn * tstep : cB;
        for (int t = 0; t < nt; t += 2) {
            const bool last = (t == nt - 2);
            const char* a1 = cA + (size_t)(t + 1) * kstep;
            const char* a2 = last ? nA : cA + (size_t)(t + 2) * kstep; const char* b2 = last ? nB : cB + (size_t)(t + 2) * kstep;
            const char* a3 = a2 + kstep; const char* b3 = b2 + kstep;
            if (last && has_next) S.a_ready(nxt);
            PG8_LDB(B0, 0, 0); PG8_SCHED; PG8_LDA(At, 0, 0); PG8_STAGE(PG8_SA(1, 1), a1 + hstep, voffA);
            PG8_WAIT_L(8); PG8_BAR; PG8_WAIT_L(0); PG8_MMA(0, 0, At, B0); PG8_BAR; PG8_SCHED;
            PG8_LDB(B1, 0, 1); PG8_STAGE(PG8_SB(0, 0), b2, voffB);
            PG8_BAR; PG8_WAIT_L(0); PG8_MMA(0, 1, At, B1); PG8_BAR;
            PG8_LDA(At, 0, 1); PG8_STAGE(PG8_SA(0, 0), a2, voffA);
            PG8_BAR; PG8_WAIT_L(0); PG8_MMA(1, 0, At, B0); PG8_BAR; PG8_SCHED;
            PG8_STAGE(PG8_SB(0, 1), b2 + hstep, voffB);
            PG8_WAIT_V(6); PG8_BAR; PG8_MMA(1, 1, At, B1); PG8_BAR;
            PG8_LDB(B0, 1, 0); PG8_SCHED; PG8_LDA(At, 1, 0); PG8_STAGE(PG8_SA(0, 1), a2 + hstep, voffA);
            PG8_WAIT_L(8); PG8_BAR; PG8_WAIT_L(0); PG8_MMA(0, 0, At, B0); PG8_BAR; PG8_SCHED;
            PG8_LDB(B1, 1, 1); PG8_STAGE(PG8_SB(1, 0), b3, voffB);
            PG8_BAR; PG8_WAIT_L(0); PG8_MMA(0, 1, At, B1); PG8_BAR;
            PG8_LDA(At, 1, 1); PG8_STAGE(PG8_SA(1, 0), a3, voffA);
            PG8_BAR; PG8_WAIT_L(0); PG8_MMA(1, 0, At, B0); PG8_BAR; PG8_SCHED;
            PG8_STAGE(PG8_SB(1, 1), b3 + hstep, voffB);
            PG8_WAIT_V(6); PG8_BAR; PG8_MMA(1, 1, At, B1); PG8_BAR;
        }
        PG8_STAMP();
        if constexpr (!Epi::AFTER_DRAIN) { E(acc, cur, wr, wc, fr, fq); S.done(cur); }
        PG8_STAMP();
        if (!has_next) break;
#pragma unroll
        for (int a = 0; a < 2; ++a)
#pragma unroll
            for (int b = 0; b < 2; ++b)
#pragma unroll
                for (int m = 0; m < 4; ++m)
#pragma unroll
                    for (int n = 0; n < 2; ++n) acc[a][b][m][n] = (f32x4){0.f, 0.f, 0.f, 0.f};
        cur = nxt; cA = nA; cB = nB; ++ui;
    }
    PG8_WAIT_V(0);
    if (wr == 0) PG8_BAR;
    PG8_BAR;
    if constexpr (Epi::AFTER_DRAIN) { E.fused(acc, cur, wr, wc, fr, fq, lds, wid, lane); S.done(cur); }
    PG8_STAMP();
    if (STAMP && wid == 0) { stamps[lane] = lane < nts ? (((unsigned long long)(unsigned)ts_hi << 32) | (unsigned)ts_lo) : 0ull;
        if (lane == 62) stamps[62] = rt_entry; if (lane == 63) stamps[63] = (unsigned long long)wall_clock64(); }
#undef PG8_STAMP
#undef PG8_SA
#undef PG8_SB
#undef PG8_STAGE
#undef PG8_LDA
#undef PG8_LDB
#undef PG8_MMA
#undef PG8_WAIT_V
#undef PG8_WAIT_L
#undef PG8_BAR
#undef PG8_SCHED
}
}
using pg8::bf16_t; using pg8::f32x4; using pg8::pk2bf; using pg8::bflo; using pg8::bfhi; using pg8::siluf; using pg8::sigmf; using pg8::u32x2;
using pg8::NTOK; using pg8::DM; using pg8::FFH; using pg8::NMOD;
typedef unsigned v4u __attribute__((ext_vector_type(4)));
#define LDS_WAIT() asm volatile("s_waitcnt lgkmcnt(0)" ::: "memory")
constexpr int NCTX = 4096, NWAVES = 8, LDS_BYTES = 131072;
constexpr size_t MiB = 1048576;
constexpr size_t OFF_WCO = 0, OFF_WDNO = 2 * MiB, OFF_WO = 4 * MiB;
constexpr size_t OFF_WGU = 6 * MiB;
constexpr size_t OFF_WD = 17 * MiB;
constexpr size_t OFF_WIN = 23 * MiB;
constexpr size_t OFF_X0 = 42 * MiB;
constexpr size_t OFF_DN = 6 * MiB;
constexpr size_t OFF_X1 = 114 * MiB;
constexpr size_t OFF_PROJ = 138 * MiB;
constexpr size_t OFF_EX = 246 * MiB;
constexpr size_t OFF_MOD = 247 * MiB;
constexpr size_t WS_NEED = 248 * MiB;
constexpr size_t BLK = (size_t)NTOK * DM;

struct Params {
    const float *x_prompt, *x_sample, *st_f, *st_b, *c, *c_ctx, *ada_w, *ada_b, *norm_ffn1, *f1g, *f1u, *f1d, *norm_mix, *w_in, *conv_w, *conv_out_w,
        *dn_conv_w, *dn_a_log, *dn_dt_bias, *dn_norm_w, *dn_out_w, *w_o, *norm_ffn2, *f2g, *f2u, *f2d, *norm_f;
    float* out; unsigned char* ws;
};

__device__ __forceinline__ float wave_sum(float v) {
#pragma unroll
    for (int o = 1; o < 64; o <<= 1) v += __shfl_xor(v, o);
    return v;
}
__device__ __forceinline__ float sum16(float v) {
#pragma unroll
    for (int o = 1; o < 16; o <<= 1) v += __shfl_xor(v, o);
    return v;
}
__device__ __forceinline__ void transpose_item(const float* W, int N, int k0, int n0, bf16_t* WT, int Kd, int dst_row0, float* scr, int lane) {
#pragma unroll 8
    for (int i = 0; i < 32; ++i) { const int kk = 2 * i + (lane >> 5); scr[kk * 33 + (lane & 31)] = W[(size_t)(k0 + kk) * N + n0 + (lane & 31)]; }
    LDS_WAIT();
    const int c = lane & 7;
#pragma unroll
    for (int j = 0; j < 4; ++j) { const int n = (lane >> 3) + 8 * j; const float* s = scr + (8 * c) * 33 + n;
        v4u o; o.x = pk2bf(s[0 * 33], s[1 * 33]); o.y = pk2bf(s[2 * 33], s[3 * 33]); o.z = pk2bf(s[4 * 33], s[5 * 33]); o.w = pk2bf(s[6 * 33], s[7 * 33]);
        *(v4u*)(WT + (size_t)(dst_row0 + n) * Kd + k0 + 8 * c) = o; }
    LDS_WAIT();
}
__device__ __forceinline__ void transpose_matrix(const float* W, int K, int N, bf16_t* WT, int mode, int gw, int ngw, float* scr, int lane) {
    const int nblk = N / 32, nitems = (K / 64) * nblk;
    for (int it = gw; it < nitems; it += ngw) {
        const int kb = it / nblk, nb = it % nblk, n0 = nb * 32;
        const int dr = mode == 0 ? n0 : ((n0 >> 7) * 256 + (n0 & 127) + (mode == 2 ? 128 : 0));
        transpose_item(W, N, kb * 64, n0, WT, K, dr, scr, lane);
    }
}

__device__ __forceinline__ void phase_prep(const Params& p, unsigned char* lds, int wave, int lane) {
    unsigned char* ws = p.ws;
    float* scr = (float*)lds + wave * (64 * 33);
    const int gw = wave * gridDim.x + blockIdx.x, ngw = gridDim.x * NWAVES;
    transpose_matrix(p.w_in, 1024, 9248, (bf16_t*)(ws + OFF_WIN), 0, gw, ngw, scr, lane);
    transpose_matrix(p.f1g, 1024, FFH, (bf16_t*)(ws + OFF_WGU), 1, gw, ngw, scr, lane);
    transpose_matrix(p.f1u, 1024, FFH, (bf16_t*)(ws + OFF_WGU), 2, gw, ngw, scr, lane);
    transpose_matrix(p.f1d, FFH, 1024, (bf16_t*)(ws + OFF_WD), 0, gw, ngw, scr, lane);
    transpose_matrix(p.conv_out_w, 1024, 1024, (bf16_t*)(ws + OFF_WCO), 0, gw, ngw, scr, lane);
    transpose_matrix(p.dn_out_w, 1024, 1024, (bf16_t*)(ws + OFF_WDNO), 0, gw, ngw, scr, lane);
    transpose_matrix(p.w_o, 1024, 1024, (bf16_t*)(ws + OFF_WO), 0, gw, ngw, scr, lane);
    {
        v4u z = {0u, 0u, 0u, 0u}; v4u* zp = (v4u*)((bf16_t*)(ws + OFF_WIN) + (size_t)9248 * 1024);
        const int nz = 224 * 1024 * 2 / 16;
        for (int i = blockIdx.x * 512 + threadIdx.x; i < nz; i += gridDim.x * 512) zp[i] = z;
    }
    __syncthreads();
    float* sc = (float*)lds;
    float* red = (float*)lds + 3072;
    if ((int)blockIdx.x < 144) {
        for (int i = threadIdx.x; i < 3072; i += 512) { const int cc = i >> 10, k = i & 1023; const float v = cc == 0 ? p.c_ctx[k] : p.c[(cc - 1) * 1024 + k]; sc[i] = siluf(v); }
        __syncthreads();
        for (int it = blockIdx.x; it < 144; it += gridDim.x) {
            const int n = it * 64 + lane; float a0 = 0.f, a1 = 0.f, a2 = 0.f;
            const float* wp = p.ada_w + (size_t)(wave * 128) * NMOD + n;
#pragma unroll 8
            for (int k = 0; k < 128; ++k) { const float wv = wp[(size_t)k * NMOD]; const int kk = wave * 128 + k; a0 += sc[kk] * wv; a1 += sc[1024 + kk] * wv; a2 += sc[2048 + kk] * wv; }
            red[(wave * 3 + 0) * 64 + lane] = a0; red[(wave * 3 + 1) * 64 + lane] = a1; red[(wave * 3 + 2) * 64 + lane] = a2;
            __syncthreads();
            if (threadIdx.x < 192) { const int cc = threadIdx.x >> 6, l = threadIdx.x & 63; float s = 0.f;
#pragma unroll
                for (int w = 0; w < 8; ++w) s += red[(w * 3 + cc) * 64 + l];
                ((float*)(ws + OFF_MOD))[cc * NMOD + it * 64 + l] = s + p.ada_b[it * 64 + l]; }
            __syncthreads();
        }
    }
}

template <bool FIRST> __device__ __forceinline__ void phase_norm(const Params& p, const float* X, float* X0, const float* nw, int modi, bf16_t* A, int wave, int lane) {
    const float* mod = (const float*)(p.ws + OFF_MOD);
    const int gw = wave * gridDim.x + blockIdx.x, ngw = gridDim.x * NWAVES;
    for (int row = gw; row < NTOK; row += ngw) {
        const int cond = row < NCTX ? 0 : 1 + ((row - NCTX) >> 10);
        f32x4 v[4];
        if (FIRST) {
            const float* src = row < NCTX ? p.x_prompt + (size_t)row * DM : p.x_sample + (size_t)(row - NCTX) * DM;
#pragma unroll
            for (int j = 0; j < 4; ++j) v[j] = *(const f32x4*)(src + 4 * lane + 256 * j);
            if (row >= NCTX) {
                const int t = (row - NCTX) & 1023; const float r = (float)(t >> 6), cl = (float)(t & 63);
#pragma unroll
                for (int e = 0; e < 4; ++e) { const int i = 4 * lane + e; const float om = 1.0f / powf(10000.0f, (float)i * (1.0f / 256.0f));
                    v[0][e] += sinf(r * om); v[1][e] += cosf(r * om); v[2][e] += sinf(cl * om); v[3][e] += cosf(cl * om); }
            }
#pragma unroll
            for (int j = 0; j < 4; ++j) *(f32x4*)(X0 + (size_t)row * DM + 4 * lane + 256 * j) = v[j];
        } else {
#pragma unroll
            for (int j = 0; j < 4; ++j) v[j] = *(const f32x4*)(X + (size_t)row * DM + 4 * lane + 256 * j);
        }
        float ss = 0.f;
#pragma unroll
        for (int j = 0; j < 4; ++j) ss += v[j][0] * v[j][0] + v[j][1] * v[j][1] + v[j][2] * v[j][2] + v[j][3] * v[j][3];
        const float rstd = rsqrtf(wave_sum(ss) * (1.0f / 1024.0f) + 1e-6f);
        const float* sh = mod + (size_t)cond * NMOD + modi * 1024; const float* scp = sh + 1024;
#pragma unroll
        for (int j = 0; j < 4; ++j) { const int d = 4 * lane + 256 * j; const f32x4 w = *(const f32x4*)(nw + d), s1 = *(const f32x4*)(scp + d), s0 = *(const f32x4*)(sh + d);
            f32x4 y;
#pragma unroll
            for (int e = 0; e < 4; ++e) y[e] = v[j][e] * rstd * w[e] * (1.f + s1[e]) + s0[e];
            u32x2 o; o.x = pk2bf(y[0], y[1]); o.y = pk2bf(y[2], y[3]); *(u32x2*)(A + (size_t)row * DM + d) = o; }
    }
}
__device__ __forceinline__ void phase_final_norm(const Params& p, float* Y, int wave, int lane) {
    const int gw = wave * gridDim.x + blockIdx.x, ngw = gridDim.x * NWAVES;
    for (int row = gw; row < NTOK; row += ngw) {
        f32x4 v[4]; float ss = 0.f;
#pragma unroll
        for (int j = 0; j < 4; ++j) { v[j] = *(const f32x4*)(Y + (size_t)row * DM + 4 * lane + 256 * j); ss += v[j][0] * v[j][0] + v[j][1] * v[j][1] + v[j][2] * v[j][2] + v[j][3] * v[j][3]; }
        const float rstd = rsqrtf(wave_sum(ss) * (1.0f / 1024.0f) + 1e-6f);
#pragma unroll
        for (int j = 0; j < 4; ++j) { const f32x4 w = *(const f32x4*)(p.norm_f + 4 * lane + 256 * j); *(f32x4*)(Y + (size_t)row * DM + 4 * lane + 256 * j) = v[j] * rstd * w; }
    }
}

__device__ __forceinline__ void unpack8(const v4u r, float (&f)[8]) { f[0] = bflo(r.x); f[1] = bfhi(r.x); f[2] = bflo(r.y); f[3] = bfhi(r.y); f[4] = bflo(r.z); f[5] = bfhi(r.z); f[6] = bflo(r.w); f[7] = bfhi(r.w); }
__device__ __forceinline__ void load8f(const float* p, float (&f)[8]) { const f32x4 a = *(const f32x4*)p, b = *(const f32x4*)(p + 4); f[0] = a[0]; f[1] = a[1]; f[2] = a[2]; f[3] = a[3]; f[4] = b[0]; f[5] = b[1]; f[6] = b[2]; f[7] = b[3]; }
__device__ __forceinline__ void phase_qkv_naive(const Params& p, const bf16_t* PROJ, const float* EX, float* QF, float* KF, float* VF, float* BG, bf16_t* YA, int wave, int lane) {
    const int gw = wave * gridDim.x + blockIdx.x, ngw = gridDim.x * NWAVES;
    const v4u zero4 = {0u, 0u, 0u, 0u};
    for (int tok = gw; tok < NTOK; tok += ngw) {
        const int pos = tok < NCTX ? (tok & 255) : ((tok - NCTX) & 63); const int L = tok < NCTX ? 256 : 64;
        const bool hasL = pos != 0, hasR = pos != L - 1;
#pragma unroll 1
        for (int grp = 0; grp < 6; ++grp) {
            const int part = grp >> 1, ch0 = (grp & 1) * 512 + lane * 8;
            const bf16_t* src = PROJ + (size_t)(3 + part) * BLK + (size_t)tok * DM + ch0;
            float c[8], l[8], r[8], w0[8], w1[8], w2[8], y[8];
            unpack8(*(const v4u*)src, c); unpack8(hasL ? *(const v4u*)(src - DM) : zero4, l); unpack8(hasR ? *(const v4u*)(src + DM) : zero4, r);
            const float* cw = p.dn_conv_w + part * 1024 + ch0;
            load8f(cw, w0); load8f(cw + 3072, w1); load8f(cw + 6144, w2);
            float ss = 0.f;
#pragma unroll
            for (int e = 0; e < 8; ++e) { y[e] = siluf(w0[e] * l[e] + w1[e] * c[e] + w2[e] * r[e]); ss += y[e] * y[e]; }
            if (part < 2) { const float sc = rsqrtf(sum16(ss) + 1e-6f) * (part == 0 ? 0.08838834764831845f : 1.0f);
#pragma unroll
                for (int e = 0; e < 8; ++e) y[e] *= sc; }
            float* dst = (part == 0 ? QF : part == 1 ? KF : VF) + (size_t)tok * DM + ch0;
            f32x4 o0 = {y[0], y[1], y[2], y[3]}, o1 = {y[4], y[5], y[6], y[7]};
            *(f32x4*)dst = o0; *(f32x4*)(dst + 4) = o1;
        }
#pragma unroll 1
        for (int grp = 0; grp < 2; ++grp) {
            const int ch0 = grp * 512 + lane * 8; const size_t o = (size_t)tok * DM + ch0;
            float bg[8], cc[8], cl[8], cr[8], xc[8], xl[8], xr[8], w0[8], w1[8], w2[8];
            unpack8(*(const v4u*)(PROJ + o), bg);
            unpack8(*(const v4u*)(PROJ + BLK + o), cc); unpack8(hasL ? *(const v4u*)(PROJ + BLK + o - DM) : zero4, cl); unpack8(hasR ? *(const v4u*)(PROJ + BLK + o + DM) : zero4, cr);
            unpack8(*(const v4u*)(PROJ + 2 * BLK + o), xc); unpack8(hasL ? *(const v4u*)(PROJ + 2 * BLK + o - DM) : zero4, xl); unpack8(hasR ? *(const v4u*)(PROJ + 2 * BLK + o + DM) : zero4, xr);
            load8f(p.conv_w + ch0, w0); load8f(p.conv_w + 1024 + ch0, w1); load8f(p.conv_w + 2048 + ch0, w2);
            float y[8];
#pragma unroll
            for (int e = 0; e < 8; ++e) y[e] = bg[e] * (w0[e] * cl[e] * xl[e] + w1[e] * cc[e] * xc[e] + w2[e] * cr[e] * xr[e]);
            v4u ov; ov.x = pk2bf(y[0], y[1]); ov.y = pk2bf(y[2], y[3]); ov.z = pk2bf(y[4], y[5]); ov.w = pk2bf(y[6], y[7]);
            *(v4u*)(YA + o) = ov;
        }
        if (lane < 16) {
            const float b_raw = EX[(size_t)tok * 32 + lane], a_raw = EX[(size_t)tok * 32 + 16 + lane];
            const float xx = a_raw + p.dn_dt_bias[lane]; const float sp = xx > 20.f ? xx : log1pf(expf(xx));
            BG[(size_t)tok * 32 + lane] = 1.f / (1.f + expf(-b_raw));
            BG[(size_t)tok * 32 + 16 + lane] = -expf(p.dn_a_log[lane]) * sp;
        }
    }
}

__device__ __forceinline__ void dn_naive_item(const Params& p, const float* QF, const float* KF, const float* VF, const float* BG, float* OF, float* OBk, float* lds, int item) {
    const bool lat = item < 32; const int j = lat ? item : item - 32; const int b = j >> 4, h = (j >> 1) & 7, dir = j & 1;
    const int T = lat ? 1024 : 256; const int tok0 = lat ? NCTX + b * 1024 : b * 256;
    const int tid = threadIdx.x, v = tid & 127, kq = tid >> 7;
    float* qs = lds; float* ks = lds + 128; float* vs = lds + 256; float* gb = lds + 384; float* red = lds + 512; float* red2 = lds + 1024;
    float S[32];
    if (lat) { const float* s0 = (dir ? p.st_b : p.st_f) + ((size_t)(b * 8 + h) * 128) * 128;
#pragma unroll
        for (int i = 0; i < 32; ++i) S[i] = s0[(size_t)(kq * 32 + i) * 128 + v]; }
    else {
#pragma unroll
        for (int i = 0; i < 32; ++i) S[i] = 0.f; }
    float* Od = dir ? OBk : OF;
    for (int t = 0; t < T; ++t) {
        const int tok = tok0 + (dir ? T - 1 - t : t);
        __syncthreads();
        if (tid < 128) qs[tid] = QF[(size_t)tok * DM + h * 128 + tid];
        else if (tid < 256) ks[tid - 128] = KF[(size_t)tok * DM + h * 128 + tid - 128];
        else if (tid < 384) vs[tid - 256] = VF[(size_t)tok * DM + h * 128 + tid - 256];
        else if (tid == 384) gb[0] = BG[(size_t)tok * 32 + dir * 8 + h];
        else if (tid == 385) gb[1] = BG[(size_t)tok * 32 + 16 + dir * 8 + h];
        __syncthreads();
        float part = 0.f;
#pragma unroll
        for (int i = 0; i < 32; ++i) part += ks[kq * 32 + i] * S[i];
        red[kq * 128 + v] = part;
        __syncthreads();
        const float kS = red[v] + red[128 + v] + red[256 + v] + red[384 + v];
        const float eg = expf(gb[1]), beta = gb[0];
        const float delta = beta * (vs[v] - eg * kS);
        float op = 0.f;
#pragma unroll
        for (int i = 0; i < 32; ++i) { S[i] = eg * S[i] + ks[kq * 32 + i] * delta; op += qs[kq * 32 + i] * S[i]; }
        red2[kq * 128 + v] = op;
        __syncthreads();
        if (kq == 0) Od[(size_t)tok * DM + h * 128 + v] = red2[v] + red2[128 + v] + red2[256 + v] + red2[384 + v];
    }
    if (!lat) { float* so = p.out + (size_t)NTOK * DM + (size_t)dir * (16 * 8 * 128 * 128) + ((size_t)(b * 8 + h) * 128) * 128;
#pragma unroll
        for (int i = 0; i < 32; ++i) so[(size_t)(kq * 32 + i) * 128 + v] = S[i]; }
}
__device__ __forceinline__ void phase_dn_naive(const Params& p, const float* QF, const float* KF, const float* VF, const float* BG, float* OF, float* OBk, float* lds) {
    const int bx = blockIdx.x;
    if (gridDim.x >= 256) {
        if (bx < 32) dn_naive_item(p, QF, KF, VF, BG, OF, OBk, lds, bx);
        else if (bx < 256) { dn_naive_item(p, QF, KF, VF, BG, OF, OBk, lds, bx); if (bx < 64) dn_naive_item(p, QF, KF, VF, BG, OF, OBk, lds, 224 + bx); }
    } else { for (int it = bx; it < 288; it += gridDim.x) dn_naive_item(p, QF, KF, VF, BG, OF, OBk, lds, it); }
}

__device__ __forceinline__ void phase_ogate(const Params& p, const float* OF, const float* OBk, const bf16_t* Z, bf16_t* OG, int wave, int lane) {
    const int gw = wave * gridDim.x + blockIdx.x, ngw = gridDim.x * NWAVES;
    for (int tok = gw; tok < NTOK; tok += ngw) {
#pragma unroll
        for (int hf = 0; hf < 2; ++hf) {
            const int ch0 = hf * 512 + lane * 8; const size_t o = (size_t)tok * DM + ch0;
            float a[8], b2[8], z[8], nw[8];
            load8f(OF + o, a); load8f(OBk + o, b2); unpack8(*(const v4u*)(Z + o), z); load8f(p.dn_norm_w + (ch0 & 127), nw);
            float ss = 0.f;
#pragma unroll
            for (int e = 0; e < 8; ++e) { a[e] += b2[e]; ss += a[e] * a[e]; }
            const float r = rsqrtf(sum16(ss) * (1.0f / 128.0f) + 1e-6f);
            float y[8];
#pragma unroll
            for (int e = 0; e < 8; ++e) y[e] = a[e] * r * nw[e] * siluf(z[e]);
            v4u ov; ov.x = pk2bf(y[0], y[1]); ov.y = pk2bf(y[2], y[3]); ov.z = pk2bf(y[4], y[5]); ov.w = pk2bf(y[6], y[7]);
            *(v4u*)(OG + o) = ov;
        }
    }
}

template <class Epi> __device__ __forceinline__ void run_gemm(PG8_LAS unsigned char* lds, const bf16_t* A, const bf16_t* Bt, int N, int K, const Epi& E) {
    pg8::Gemm g; g.A = A; g.Bt = Bt; g.M = NTOK; g.N = N; g.K = K;
    pg8::StaticOrder S; S.init(NTOK, N, (int)gridDim.x, (int)blockIdx.x);
    pg8::gemm_phase<Epi, pg8::StaticOrder, false>(lds, g, S, E, nullptr);
    __syncthreads();
}

__global__ void __launch_bounds__(512) fwd_megakernel(Params p) {
    extern __shared__ __attribute__((aligned(16))) unsigned char shm[];
    cg::grid_group grid = cg::this_grid();
    PG8_LAS unsigned char* lds3 = (PG8_LAS unsigned char*)shm;
    const int wave = __builtin_amdgcn_readfirstlane(threadIdx.x >> 6), lane = threadIdx.x & 63;
    unsigned char* ws = p.ws;
    float* X0 = (float*)(ws + OFF_X0); float* X1 = (float*)(ws + OFF_X1); float* MOD = (float*)(ws + OFF_MOD);
    bf16_t* PROJ = (bf16_t*)(ws + OFF_PROJ); float* EX = (float*)(ws + OFF_EX);
    bf16_t* AM = (bf16_t*)p.out;
    bf16_t* HB = (bf16_t*)(ws + OFF_PROJ);
    float* QF = (float*)(ws + OFF_DN); float* KF = QF + BLK; float* VF = KF + BLK; float* BG = VF + BLK;
    float* OF = (float*)(ws + OFF_PROJ); float* OBk = OF + BLK;
    bf16_t* OG = PROJ + 4 * BLK; bf16_t* MRG = PROJ + 5 * BLK;

    phase_prep(p, shm, wave, lane);
    grid.sync();
    phase_norm<true>(p, nullptr, X0, p.norm_ffn1, 0, AM, wave, lane);
    grid.sync();
    { pg8::EpiSwiglu E; E.H = HB; run_gemm(lds3, AM, (const bf16_t*)(ws + OFF_WGU), 5632, 1024, E); }
    grid.sync();
    { pg8::EpiResid E; E.Xin = X0; E.Xout = X1; E.gate = MOD + 2 * 1024; E.scale = 0.5f; run_gemm(lds3, HB, (const bf16_t*)(ws + OFF_WD), 1024, FFH, E); }
    grid.sync();
    phase_norm<false>(p, X1, nullptr, p.norm_mix, 3, AM, wave, lane);
    grid.sync();
    { pg8::EpiProj E; E.P = PROJ; E.EX = EX; run_gemm(lds3, AM, (const bf16_t*)(ws + OFF_WIN), 9472, 1024, E); }
    grid.sync();
    phase_qkv_naive(p, PROJ, EX, QF, KF, VF, BG, AM, wave, lane);
    grid.sync();
    phase_dn_naive(p, QF, KF, VF, BG, OF, OBk, (float*)shm);
    grid.sync();
    phase_ogate(p, OF, OBk, PROJ + 6 * BLK, OG, wave, lane);
    {
        float* scr = (float*)shm + wave * (64 * 33); const int gw = wave * gridDim.x + blockIdx.x, ngw = gridDim.x * NWAVES;
        transpose_matrix(p.f2g, 1024, FFH, (bf16_t*)(ws + OFF_WGU), 1, gw, ngw, scr, lane);
        transpose_matrix(p.f2u, 1024, FFH, (bf16_t*)(ws + OFF_WGU), 2, gw, ngw, scr, lane);
        transpose_matrix(p.f2d, FFH, 1024, (bf16_t*)(ws + OFF_WD), 0, gw, ngw, scr, lane);
        __syncthreads();
    }
    grid.sync();
    { pg8::EpiGate<0> E; E.G = PROJ + 7 * BLK; E.T = X0; E.O = nullptr; run_gemm(lds3, AM, (const bf16_t*)(ws + OFF_WCO), 1024, 1024, E); }
    { pg8::EpiGate<1> E; E.G = PROJ + 8 * BLK; E.T = X0; E.O = MRG; run_gemm(lds3, OG, (const bf16_t*)(ws + OFF_WDNO), 1024, 1024, E); }
    grid.sync();
    { pg8::EpiResid E; E.Xin = X1; E.Xout = X0; E.gate = MOD + 5 * 1024; E.scale = 1.0f; run_gemm(lds3, MRG, (const bf16_t*)(ws + OFF_WO), 1024, 1024, E); }
    grid.sync();
    phase_norm<false>(p, X0, nullptr, p.norm_ffn2, 6, AM, wave, lane);
    grid.sync();
    { pg8::EpiSwiglu E; E.H = HB; run_gemm(lds3, AM, (const bf16_t*)(ws + OFF_WGU), 5632, 1024, E); }
    grid.sync();
    { pg8::EpiResid E; E.Xin = X0; E.Xout = p.out; E.gate = MOD + 8 * 1024; E.scale = 0.5f; run_gemm(lds3, HB, (const bf16_t*)(ws + OFF_WD), 1024, FFH, E); }
    grid.sync();
    phase_final_norm(p, p.out, wave, lane);
}

extern "C" void kernel_launch(void* const* d_in, const int* in_sizes, int n_in, void* d_out, int out_size, void* d_ws, size_t ws_size, hipStream_t stream) {
    static int grid_blocks = 0;
    if (grid_blocks == 0) {
        if (n_in != 27 || ws_size < WS_NEED) { fprintf(stderr, "kernel_launch: unexpected n_in %d / ws %zu\n", n_in, ws_size); grid_blocks = -1; return; }
        int dev = 0, cus = 0, per_cu = 0;
        hipGetDevice(&dev); hipDeviceGetAttribute(&cus, hipDeviceAttributeMultiprocessorCount, dev);
        hipFuncSetAttribute((const void*)fwd_megakernel, hipFuncAttributeMaxDynamicSharedMemorySize, LDS_BYTES);
        hipOccupancyMaxActiveBlocksPerMultiprocessor(&per_cu, (const void*)fwd_megakernel, 512, LDS_BYTES);
        if (per_cu < 1) { fprintf(stderr, "kernel_launch: occupancy query says %d blocks/CU\n", per_cu); per_cu = 1; }
        (void)hipGetLastError();
        grid_blocks = cus;
    }
    if (grid_blocks < 0) return;
    Params p{};
    const float** f = (const float**)&p;
    for (int i = 0; i < 27; ++i) f[i] = (const float*)d_in[i];
    p.out = (float*)d_out; p.ws = (unsigned char*)d_ws;
    void* args[] = {&p};
    hipError_t e = hipLaunchCooperativeKernel((const void*)fwd_megakernel, dim3(grid_blocks), dim3(512), args, LDS_BYTES, stream);
    if (e != hipSuccess) fprintf(stderr, "cooperative launch failed: %s (grid %d)\n", hipGetErrorString(e), grid_blocks);
}
```

```cpp
#include <hip/hip_runtime.h>
#include <hip/hip_cooperative_groups.h>
#include <cstdio>
#include <cstdint>
namespace cg = cooperative_groups;
namespace pg8 {
#define PG8_LAS __attribute__((address_space(3)))
typedef unsigned short bf16_t;
typedef short bf16x8 __attribute__((ext_vector_type(8)));
typedef float f32x4 __attribute__((ext_vector_type(4)));
typedef unsigned u32x4 __attribute__((ext_vector_type(4)));
constexpr int BM = 256, BK = 64, HALF = 128, HTB = HALF * BK * 2  , STAGE_BYTES = 8 * HTB, NXCD = 8, WGM = 8;

__host__ __device__ __forceinline__ int lds_byte(int r, int c) { const int st = (r >> 4) * 2 + (c >> 5), rr = r & 15, cc = c & 31, ob = rr * 64 + cc * 2; return st * 1024 + (ob ^ (((ob >> 9) & 1) << 5)); }
__host__ __device__ __forceinline__ void stage_rc(int b, int& R, int& C) { const int st = b / 1024, sb = b % 1024, swz = sb ^ (((sb >> 9) & 1) << 5); R = (st >> 1) * 16 + swz / 64; C = (st & 1) * 32 + (swz % 64) / 2; }
__host__ __device__ __forceinline__ int perm32(int rho) { const int n = rho >> 4, i = rho & 15; return 8 * (i >> 2) + 4 * n + (i & 3); }

struct Unit { int pm, pn; };
struct Gemm { const bf16_t* A; const bf16_t* Bt; int M, N, K; };

struct StaticOrder {
    int nM, nN, nwg, G, c;
    __host__ __device__ void init(int M, int N, int G_, int c_) { nM = M / BM; nN = N / BM; nwg = nM * nN; G = G_; c = c_; }
    __host__ __device__ bool next(int i, Unit& u) const {
        const long L = (long)i * G + c; if (L >= nwg) return false;
        int wgid = (int)L; { const int q = nwg / NXCD, r = nwg % NXCD, xcd = wgid % NXCD, off = wgid / NXCD; wgid = (xcd < r ? xcd * (q + 1) : r * (q + 1) + (xcd - r) * q) + off; }
        const int nig = WGM * nN, gid = wgid / nig, fm = gid * WGM, gsz = (nM - fm) < WGM ? (nM - fm) : WGM;
        u.pm = fm + ((wgid % nig) % gsz); u.pn = (wgid % nig) / gsz; return true;
    }
    __device__ __forceinline__ void a_ready(const Unit&) const {}
    __device__ __forceinline__ void done(const Unit&) const {}
};
__device__ __forceinline__ unsigned pk2bf(float a, float b) { typedef float f2v __attribute__((ext_vector_type(2))); typedef __bf16 b2v __attribute__((ext_vector_type(2))); f2v v = {a, b}; b2v r = __builtin_convertvector(v, b2v); return __builtin_bit_cast(unsigned, r); }
__device__ __forceinline__ float bflo(unsigned u) { return __uint_as_float(u << 16); }
__device__ __forceinline__ float bfhi(unsigned u) { return __uint_as_float(u & 0xffff0000u); }
__device__ __forceinline__ float siluf(float x) { return x / (1.f + __expf(-x)); }
__device__ __forceinline__ float sigmf(float x) { return 1.f / (1.f + __expf(-x)); }
__device__ __forceinline__ int cond_of_tile(int pm) { return pm < 16 ? 0 : 1 + ((pm - 16) >> 2); }
constexpr int NTOK = 6144, DM = 1024, FFH = 2816, NMOD = 9216;
typedef unsigned u32x2 __attribute__((ext_vector_type(2)));

struct EpiSwiglu {
    static constexpr bool PERM = false, AFTER_DRAIN = false;
    bf16_t* H;
    __device__ __forceinline__ void operator()(const f32x4 (&acc)[2][2][4][2], const Unit& u, int wr, int wc, int fr, int fq) const {
        const int row0 = u.pm * BM + wr * 64 + fr, col0 = u.pn * 128 + wc * 32 + 4 * fq;
#pragma unroll
        for (int ai = 0; ai < 2; ++ai)
#pragma unroll
            for (int m = 0; m < 4; ++m) { bf16_t* rowp = H + (size_t)(row0 + ai * HALF + m * 16) * FFH + col0;
#pragma unroll
                for (int n = 0; n < 2; ++n) { const f32x4 g = acc[ai][0][m][n], up = acc[ai][1][m][n];
                    u32x2 o; o.x = pk2bf(siluf(g[0]) * up[0], siluf(g[1]) * up[1]); o.y = pk2bf(siluf(g[2]) * up[2], siluf(g[3]) * up[3]);
                    *(u32x2*)(rowp + n * 16) = o; } }
    }
};
struct EpiResid {
    static constexpr bool PERM = false, AFTER_DRAIN = false;
    const float* Xin; float* Xout; const float* gate; float scale;
    __device__ __forceinline__ void operator()(const f32x4 (&acc)[2][2][4][2], const Unit& u, int wr, int wc, int fr, int fq) const {
        const int row0 = u.pm * BM + wr * 64 + fr, col0 = u.pn * BM + wc * 32 + 4 * fq;
        const float* gp = gate + (size_t)cond_of_tile(u.pm) * NMOD + col0;
        f32x4 gv[2][2];
#pragma unroll
        for (int bj = 0; bj < 2; ++bj)
#pragma unroll
            for (int n = 0; n < 2; ++n) gv[bj][n] = *(const f32x4*)(gp + bj * HALF + n * 16) * scale;
#pragma unroll
        for (int ai = 0; ai < 2; ++ai)
#pragma unroll
            for (int m = 0; m < 4; ++m) { const size_t off = (size_t)(row0 + ai * HALF + m * 16) * DM + col0;
#pragma unroll
                for (int bj = 0; bj < 2; ++bj)
#pragma unroll
                    for (int n = 0; n < 2; ++n) { const f32x4 x = *(const f32x4*)(Xin + off + bj * HALF + n * 16);
                        *(f32x4*)(Xout + off + bj * HALF + n * 16) = x + gv[bj][n] * acc[ai][bj][m][n]; } }
    }
};
struct EpiProj {
    static constexpr bool PERM = false, AFTER_DRAIN = false;
    bf16_t* P; float* EX;
    __device__ __forceinline__ void operator()(const f32x4 (&acc)[2][2][4][2], const Unit& u, int wr, int wc, int fr, int fq) const {
        const int row0 = u.pm * BM + wr * 64 + fr;
        if (u.pn < 36) {
            bf16_t* base = P + (size_t)(u.pn >> 2) * NTOK * DM; const int col0 = (u.pn & 3) * 256 + wc * 32 + 4 * fq;
#pragma unroll
            for (int ai = 0; ai < 2; ++ai)
#pragma unroll
                for (int m = 0; m < 4; ++m) { bf16_t* rowp = base + (size_t)(row0 + ai * HALF + m * 16) * DM + col0;
#pragma unroll
                    for (int bj = 0; bj < 2; ++bj)
#pragma unroll
                        for (int n = 0; n < 2; ++n) { const f32x4 v = acc[ai][bj][m][n]; u32x2 o; o.x = pk2bf(v[0], v[1]); o.y = pk2bf(v[2], v[3]); *(u32x2*)(rowp + bj * HALF + n * 16) = o; } }
        } else if (wc == 0) {
#pragma unroll
            for (int ai = 0; ai < 2; ++ai)
#pragma unroll
                for (int m = 0; m < 4; ++m)
#pragma unroll
                    for (int n = 0; n < 2; ++n) *(f32x4*)(EX + (size_t)(row0 + ai * HALF + m * 16) * 32 + n * 16 + 4 * fq) = acc[ai][0][m][n];
        }
    }
};
template <int SECOND> struct EpiGate {
    static constexpr bool PERM = false, AFTER_DRAIN = false;
    const bf16_t* G; float* T; bf16_t* O;
    __device__ __forceinline__ void operator()(const f32x4 (&acc)[2][2][4][2], const Unit& u, int wr, int wc, int fr, int fq) const {
        const int row0 = u.pm * BM + wr * 64 + fr, col0 = u.pn * BM + wc * 32 + 4 * fq;
#pragma unroll
        for (int ai = 0; ai < 2; ++ai)
#pragma unroll
            for (int m = 0; m < 4; ++m) { const size_t off = (size_t)(row0 + ai * HALF + m * 16) * DM + col0;
#pragma unroll
                for (int bj = 0; bj < 2; ++bj)
#pragma unroll
                    for (int n = 0; n < 2; ++n) { const size_t o = off + bj * HALF + n * 16; const u32x2 gr = *(const u32x2*)(G + o); const f32x4 a = acc[ai][bj][m][n];
                        f32x4 v; v[0] = sigmf(bflo(gr.x)) * a[0]; v[1] = sigmf(bfhi(gr.x)) * a[1]; v[2] = sigmf(bflo(gr.y)) * a[2]; v[3] = sigmf(bfhi(gr.y)) * a[3];
                        if (SECOND == 0) *(f32x4*)(T + o) = v;
                        else { const f32x4 t = *(const f32x4*)(T + o); v = v + t; u32x2 w; w.x = pk2bf(v[0], v[1]); w.y = pk2bf(v[2], v[3]); *(u32x2*)(O + o) = w; } } }
    }
};

template <class Epi, class Sched, bool STAMP = false>
__device__ __forceinline__ void gemm_phase(PG8_LAS unsigned char* lds, const Gemm g, const Sched& S, const Epi& E, unsigned long long* stamps) {
    const int tid = threadIdx.x, wid = __builtin_amdgcn_readfirstlane(tid >> 6), lane = tid & 63, wr = wid >> 2, wc = wid & 3, fr = lane & 15, fq = lane >> 4;
    const int K = g.K, nt = K / BK;
    int ts_lo = 0, ts_hi = 0, nts = 0; const unsigned long long rt_entry = STAMP ? (unsigned long long)wall_clock64() : 0ull;
#define PG8_STAMP() do { if (STAMP && wid == 0 && nts < 64) { const unsigned long long _c = (unsigned long long)clock64(); \
        ts_lo = (lane == nts) ? (int)(unsigned)_c : ts_lo; ts_hi = (lane == nts) ? (int)(unsigned)(_c >> 32) : ts_hi; ++nts; } } while (0)
    PG8_STAMP();
    unsigned voffA[2], voffB[2];
#pragma unroll
    for (int i = 0; i < 2; ++i) { int R, C; stage_rc(tid * 16 + i * 8192, R, C); const int Rb = Epi::PERM ? ((R & ~31) + perm32(R & 31)) : R;
        voffA[i] = (unsigned)(R * K + C) * 2u; voffB[i] = (unsigned)(Rb * K + C) * 2u; }
    const size_t kstep = (size_t)(BK * 2);
    const size_t hstep = (size_t)HALF * K * 2;
    const size_t tstep = 2 * hstep;
    const unsigned ldsw = (unsigned)wid * 1024u;
    const int aoff = lds_byte(wr * 64 + fr, fq * 8), boff = lds_byte(wc * 32 + fr, fq * 8);
#define PG8_SA(b, h) (((b) * 2 + (h)) * HTB)
#define PG8_SB(b, h) ((4 + (b) * 2 + (h)) * HTB)
#define PG8_STAGE(bufoff, gbase, voff) do { _Pragma("unroll") for (int _i = 0; _i < 2; ++_i) \
        __builtin_amdgcn_global_load_lds((const unsigned*)((const char*)(gbase) + (voff)[_i]), (PG8_LAS unsigned*)(lds + (bufoff) + ldsw + _i * 8192), 16, 0, 0); } while (0)
#define PG8_LDA(dst, b, h) do { _Pragma("unroll") for (int m = 0; m < 4; ++m) _Pragma("unroll") for (int k = 0; k < 2; ++k) dst[m][k] = *(const PG8_LAS bf16x8*)(lds + PG8_SA(b, h) + aoff + m * 2048 + k * 1024); } while (0)
#define PG8_LDB(dst, b, h) do { _Pragma("unroll") for (int n = 0; n < 2; ++n) _Pragma("unroll") for (int k = 0; k < 2; ++k) dst[n][k] = *(const PG8_LAS bf16x8*)(lds + PG8_SB(b, h) + boff + n * 2048 + k * 1024); } while (0)
#define PG8_MMA(ai, bj, At, Bt) do { __builtin_amdgcn_s_setprio(1); _Pragma("unroll") for (int m = 0; m < 4; ++m) _Pragma("unroll") for (int n = 0; n < 2; ++n) _Pragma("unroll") for (int k = 0; k < 2; ++k) \
        acc[ai][bj][m][n] = __builtin_amdgcn_mfma_f32_16x16x32_bf16(Bt[n][k], At[m][k], acc[ai][bj][m][n], 0, 0, 0); __builtin_amdgcn_s_setprio(0); } while (0)
#define PG8_WAIT_V(n) asm volatile("s_waitcnt vmcnt(" #n ")" ::: "memory")
#define PG8_WAIT_L(n) asm volatile("s_waitcnt lgkmcnt(" #n ")" ::: "memory")
#define PG8_BAR __builtin_amdgcn_s_barrier()
#define PG8_SCHED __builtin_amdgcn_sched_barrier(0)
    Unit cur, nxt; int ui = 0;
    if (!S.next(0, cur)) return;
    f32x4 acc[2][2][4][2];
#pragma unroll
    for (int a = 0; a < 2; ++a)
#pragma unroll
        for (int b = 0; b < 2; ++b)
#pragma unroll
            for (int m = 0; m < 4; ++m)
#pragma unroll
                for (int n = 0; n < 2; ++n) acc[a][b][m][n] = (f32x4){0.f, 0.f, 0.f, 0.f};
    bf16x8 At[4][2], B0[2][2], B1[2][2];
    const char* cA = (const char*)g.A + (size_t)cur.pm * tstep; const char* cB = (const char*)g.Bt + (size_t)cur.pn * tstep;
    S.a_ready(cur);
    PG8_STAGE(PG8_SB(0, 0), cB, voffB); PG8_STAGE(PG8_SA(0, 0), cA, voffA); PG8_STAGE(PG8_SB(0, 1), cB + hstep, voffB); PG8_STAGE(PG8_SA(0, 1), cA + hstep, voffA);
    if (wr == 1) PG8_BAR;
    PG8_WAIT_V(4); PG8_BAR;
    PG8_STAGE(PG8_SB(1, 0), cB + kstep, voffB); PG8_STAGE(PG8_SA(1, 0), cA + kstep, voffA); PG8_STAGE(PG8_SB(1, 1), cB + hstep + kstep, voffB);
    PG8_WAIT_V(6); PG8_BAR;
    PG8_STAMP();
    for (;;) {
        const bool has_next = S.next(ui + 1, nxt);
        const char* nA = has_next ? (const char*)g.A + (size_t)nxt.pm * tstep : cA; const char* nB = has_next ? (const char*)g.Bt + (size_t)nxt.pn * tstep : cB;
        for (int t = 0; t < nt; t += 2) {
            const bool last = (t == nt - 2);
            const char* a1 = cA + (size_t)(t + 1) * kstep;
            const char* a2 = last ? nA : cA + (size_t)(t + 2) * kstep; const char* b2 = last ? nB : cB + (size_t)(t + 2) * kstep;
            const char* a3 = a2 + kstep; const char* b3 = b2 + kstep;
            if (last && has_next) S.a_ready(nxt);
            PG8_LDB(B0, 0, 0); PG8_SCHED; PG8_LDA(At, 0, 0); PG8_STAGE(PG8_SA(1, 1), a1 + hstep, voffA);
            PG8_WAIT_L(8); PG8_BAR; PG8_WAIT_L(0); PG8_MMA(0, 0, At, B0); PG8_BAR; PG8_SCHED;
            PG8_LDB(B1, 0, 1); PG8_STAGE(PG8_SB(0, 0), b2, voffB);
            PG8_BAR; PG8_WAIT_L(0); PG8_MMA(0, 1, At, B1); PG8_BAR;
            PG8_LDA(At, 0, 1); PG8_STAGE(PG8_SA(0, 0), a2, voffA);
            PG8_BAR; PG8_WAIT_L(0); PG8_MMA(1, 0, At, B0); PG8_BAR; PG8_SCHED;
            PG8_STAGE(PG8_SB(0, 1), b2 + hstep, voffB);
            PG8_WAIT_V(6); PG8_BAR; PG8_MMA(1, 1, At, B1); PG8_BAR;
            PG8_LDB(B0, 1, 0); PG8_SCHED; PG8_LDA(At, 1, 0); PG8_STAGE(PG8_SA(0, 1), a2 + hstep, voffA);
            PG8_WAIT_L(8); PG8_BAR; PG8_WAIT_L(0); PG8_MMA(0, 0, At, B0); PG8_BAR; PG8_SCHED;
            PG8_LDB(B1, 1, 1); PG8_STAGE(PG8_SB(1, 0), b3, voffB);
            PG8_BAR; PG8_WAIT_L(0); PG8_MMA(0, 1, At, B1); PG8_BAR;
            PG8_LDA(At, 1, 1); PG8_STAGE(PG8_SA(1, 0), a3, voffA);
            PG8_BAR; PG8_WAIT_L(0); PG8_MMA(1, 0, At, B0); PG8_BAR; PG8_SCHED;
            PG8_STAGE(PG8_SB(1, 1), b3 + hstep, voffB);
            PG8_WAIT_V(6); PG8_BAR; PG8_MMA(1, 1, At, B1); PG8_BAR;
        }
        PG8_STAMP();
        if constexpr (!Epi::AFTER_DRAIN) { E(acc, cur, wr, wc, fr, fq); S.done(cur); }
        PG8_STAMP();
        if (!has_next) break;
#pragma unroll
        for (int a = 0; a < 2; ++a)
#pragma unroll
            for (int b = 0; b < 2; ++b)
#pragma unroll
                for (int m = 0; m < 4; ++m)
#pragma unroll
                    for (int n = 0; n < 2; ++n) acc[a][b][m][n] = (f32x4){0.f, 0.f, 0.f, 0.f};
        cur = nxt; cA = nA; cB = nB; ++ui;
    }
    PG8_WAIT_V(0);
    if (wr == 0) PG8_BAR;
    PG8_BAR;
    if constexpr (Epi::AFTER_DRAIN) { E.fused(acc, cur, wr, wc, fr, fq, lds, wid, lane); S.done(cur); }
    PG8_STAMP();
    if (STAMP && wid == 0) { stamps[lane] = lane < nts ? (((unsigned long long)(unsigned)ts_hi << 32) | (unsigned)ts_lo) : 0ull;
        if (lane == 62) stamps[62] = rt_entry; if (lane == 63) stamps[63] = (unsigned long long)wall_clock64(); }
#undef PG8_STAMP
#undef PG8_SA
#undef PG8_SB
#undef PG8_STAGE
#undef PG8_LDA
#undef PG8_LDB
#undef PG8_MMA
#undef PG8_WAIT_V
#undef PG8_WAIT_L
#undef PG8_BAR
#undef PG8_SCHED
}
}
using pg8::bf16_t; using pg8::f32x4; using pg8::pk2bf; using pg8::bflo; using pg8::bfhi; using pg8::siluf; using pg8::sigmf; using pg8::u32x2;
using pg8::NTOK; using pg8::DM; using pg8::FFH; using pg8::NMOD;
typedef unsigned v4u __attribute__((ext_vector_type(4)));
#define LDS_WAIT() asm volatile("s_waitcnt lgkmcnt(0)" ::: "memory")
constexpr int NCTX = 4096, NWAVES = 8, LDS_BYTES = 139264;
constexpr size_t MiB = 1048576;
constexpr size_t OFF_WCO = 0, OFF_WDNO = 2 * MiB, OFF_WO = 4 * MiB;
constexpr size_t OFF_WGU = 6 * MiB;
constexpr size_t OFF_WD = 17 * MiB;
constexpr size_t OFF_WIN = 23 * MiB;
constexpr size_t OFF_X0 = 42 * MiB;
constexpr size_t OFF_DN = 6 * MiB;
constexpr size_t OFF_X1 = 114 * MiB;
constexpr size_t OFF_PROJ = 138 * MiB;
constexpr size_t OFF_EX = 246 * MiB;
constexpr size_t OFF_MOD = 247 * MiB;
constexpr size_t WS_NEED = 248 * MiB;
constexpr size_t BLK = (size_t)NTOK * DM;

struct Params {
    const float *x_prompt, *x_sample, *st_f, *st_b, *c, *c_ctx, *ada_w, *ada_b, *norm_ffn1, *f1g, *f1u, *f1d, *norm_mix, *w_in, *conv_w, *conv_out_w,
        *dn_conv_w, *dn_a_log, *dn_dt_bias, *dn_norm_w, *dn_out_w, *w_o, *norm_ffn2, *f2g, *f2u, *f2d, *norm_f;
    float* out; unsigned char* ws;
};

__device__ __forceinline__ float wave_sum(float v) {
#pragma unroll
    for (int o = 1; o < 64; o <<= 1) v += __shfl_xor(v, o);
    return v;
}
__device__ __forceinline__ float sum16(float v) {
#pragma unroll
    for (int o = 1; o < 16; o <<= 1) v += __shfl_xor(v, o);
    return v;
}
__device__ __forceinline__ void transpose_item(const float* W, int N, int k0, int n0, bf16_t* WT, int Kd, int dst_row0, float* scr, int lane) {
#pragma unroll 8
    for (int i = 0; i < 32; ++i) { const int kk = 2 * i + (lane >> 5); scr[kk * 33 + (lane & 31)] = W[(size_t)(k0 + kk) * N + n0 + (lane & 31)]; }
    LDS_WAIT();
    const int c = lane & 7;
#pragma unroll
    for (int j = 0; j < 4; ++j) { const int n = (lane >> 3) + 8 * j; const float* s = scr + (8 * c) * 33 + n;
        v4u o; o.x = pk2bf(s[0 * 33], s[1 * 33]); o.y = pk2bf(s[2 * 33], s[3 * 33]); o.z = pk2bf(s[4 * 33], s[5 * 33]); o.w = pk2bf(s[6 * 33], s[7 * 33]);
        *(v4u*)(WT + (size_t)(dst_row0 + n) * Kd + k0 + 8 * c) = o; }
    LDS_WAIT();
}
__device__ __forceinline__ void transpose_matrix(const float* W, int K, int N, bf16_t* WT, int mode, int gw, int ngw, float* scr, int lane) {
    const int nblk = N / 32, nitems = (K / 64) * nblk;
    for (int it = gw; it < nitems; it += ngw) {
        const int kb = it / nblk, nb = it % nblk, n0 = nb * 32;
        const int dr = mode == 0 ? n0 : ((n0 >> 7) * 256 + (n0 & 127) + (mode == 2 ? 128 : 0));
        transpose_item(W, N, kb * 64, n0, WT, K, dr, scr, lane);
    }
}

__device__ __forceinline__ void phase_prep(const Params& p, unsigned char* lds, int wave, int lane) {
    unsigned char* ws = p.ws;
    float* scr = (float*)lds + wave * (64 * 33);
    const int gw = wave * gridDim.x + blockIdx.x, ngw = gridDim.x * NWAVES;
    transpose_matrix(p.w_in, 1024, 9248, (bf16_t*)(ws + OFF_WIN), 0, gw, ngw, scr, lane);
    transpose_matrix(p.f1g, 1024, FFH, (bf16_t*)(ws + OFF_WGU), 1, gw, ngw, scr, lane);
    transpose_matrix(p.f1u, 1024, FFH, (bf16_t*)(ws + OFF_WGU), 2, gw, ngw, scr, lane);
    transpose_matrix(p.f1d, FFH, 1024, (bf16_t*)(ws + OFF_WD), 0, gw, ngw, scr, lane);
    transpose_matrix(p.conv_out_w, 1024, 1024, (bf16_t*)(ws + OFF_WCO), 0, gw, ngw, scr, lane);
    transpose_matrix(p.dn_out_w, 1024, 1024, (bf16_t*)(ws + OFF_WDNO), 0, gw, ngw, scr, lane);
    transpose_matrix(p.w_o, 1024, 1024, (bf16_t*)(ws + OFF_WO), 0, gw, ngw, scr, lane);
    {
        v4u z = {0u, 0u, 0u, 0u}; v4u* zp = (v4u*)((bf16_t*)(ws + OFF_WIN) + (size_t)9248 * 1024);
        const int nz = 224 * 1024 * 2 / 16;
        for (int i = blockIdx.x * 512 + threadIdx.x; i < nz; i += gridDim.x * 512) zp[i] = z;
    }
    __syncthreads();
    float* sc = (float*)lds;
    float* red = (float*)lds + 3072;
    if ((int)blockIdx.x < 144) {
        for (int i = threadIdx.x; i < 3072; i += 512) { const int cc = i >> 10, k = i & 1023; const float v = cc == 0 ? p.c_ctx[k] : p.c[(cc - 1) * 1024 + k]; sc[i] = siluf(v); }
        __syncthreads();
        for (int it = blockIdx.x; it < 144; it += gridDim.x) {
            const int n = it * 64 + lane; float a0 = 0.f, a1 = 0.f, a2 = 0.f;
            const float* wp = p.ada_w + (size_t)(wave * 128) * NMOD + n;
#pragma unroll 8
            for (int k = 0; k < 128; ++k) { const float wv = wp[(size_t)k * NMOD]; const int kk = wave * 128 + k; a0 += sc[kk] * wv; a1 += sc[1024 + kk] * wv; a2 += sc[2048 + kk] * wv; }
            red[(wave * 3 + 0) * 64 + lane] = a0; red[(wave * 3 + 1) * 64 + lane] = a1; red[(wave * 3 + 2) * 64 + lane] = a2;
            __syncthreads();
            if (threadIdx.x < 192) { const int cc = threadIdx.x >> 6, l = threadIdx.x & 63; float s = 0.f;
#pragma unroll
                for (int w = 0; w < 8; ++w) s += red[(w * 3 + cc) * 64 + l];
                ((float*)(ws + OFF_MOD))[cc * NMOD + it * 64 + l] = s + p.ada_b[it * 64 + l]; }
            __syncthreads();
        }
    }
}

template <bool FIRST> __device__ __forceinline__ void phase_norm(const Params& p, const float* X, float* X0, const float* nw, int modi, bf16_t* A, int wave, int lane) {
    const float* mod = (const float*)(p.ws + OFF_MOD);
    const int gw = wave * gridDim.x + blockIdx.x, ngw = gridDim.x * NWAVES;
    for (int row = gw; row < NTOK; row += ngw) {
        const int cond = row < NCTX ? 0 : 1 + ((row - NCTX) >> 10);
        f32x4 v[4];
        if (FIRST) {
            const float* src = row < NCTX ? p.x_prompt + (size_t)row * DM : p.x_sample + (size_t)(row - NCTX) * DM;
#pragma unroll
            for (int j = 0; j < 4; ++j) v[j] = *(const f32x4*)(src + 4 * lane + 256 * j);
            if (row >= NCTX) {
                const int t = (row - NCTX) & 1023; const float r = (float)(t >> 6), cl = (float)(t & 63);
#pragma unroll
                for (int e = 0; e < 4; ++e) { const int i = 4 * lane + e; const float om = 1.0f / powf(10000.0f, (float)i * (1.0f / 256.0f));
                    v[0][e] += sinf(r * om); v[1][e] += cosf(r * om); v[2][e] += sinf(cl * om); v[3][e] += cosf(cl * om); }
            }
#pragma unroll
            for (int j = 0; j < 4; ++j) *(f32x4*)(X0 + (size_t)row * DM + 4 * lane + 256 * j) = v[j];
        } else {
#pragma unroll
            for (int j = 0; j < 4; ++j) v[j] = *(const f32x4*)(X + (size_t)row * DM + 4 * lane + 256 * j);
        }
        float ss = 0.f;
#pragma unroll
        for (int j = 0; j < 4; ++j) ss += v[j][0] * v[j][0] + v[j][1] * v[j][1] + v[j][2] * v[j][2] + v[j][3] * v[j][3];
        const float rstd = rsqrtf(wave_sum(ss) * (1.0f / 1024.0f) + 1e-6f);
        const float* sh = mod + (size_t)cond * NMOD + modi * 1024; const float* scp = sh + 1024;
#pragma unroll
        for (int j = 0; j < 4; ++j) { const int d = 4 * lane + 256 * j; const f32x4 w = *(const f32x4*)(nw + d), s1 = *(const f32x4*)(scp + d), s0 = *(const f32x4*)(sh + d);
            f32x4 y;
#pragma unroll
            for (int e = 0; e < 4; ++e) y[e] = v[j][e] * rstd * w[e] * (1.f + s1[e]) + s0[e];
            u32x2 o; o.x = pk2bf(y[0], y[1]); o.y = pk2bf(y[2], y[3]); *(u32x2*)(A + (size_t)row * DM + d) = o; }
    }
}
__device__ __forceinline__ void phase_final_norm(const Params& p, float* Y, int wave, int lane) {
    const int gw = wave * gridDim.x + blockIdx.x, ngw = gridDim.x * NWAVES;
    for (int row = gw; row < NTOK; row += ngw) {
        f32x4 v[4]; float ss = 0.f;
#pragma unroll
        for (int j = 0; j < 4; ++j) { v[j] = *(const f32x4*)(Y + (size_t)row * DM + 4 * lane + 256 * j); ss += v[j][0] * v[j][0] + v[j][1] * v[j][1] + v[j][2] * v[j][2] + v[j][3] * v[j][3]; }
        const float rstd = rsqrtf(wave_sum(ss) * (1.0f / 1024.0f) + 1e-6f);
#pragma unroll
        for (int j = 0; j < 4; ++j) { const f32x4 w = *(const f32x4*)(p.norm_f + 4 * lane + 256 * j); *(f32x4*)(Y + (size_t)row * DM + 4 * lane + 256 * j) = v[j] * rstd * w; }
    }
}

__device__ __forceinline__ void unpack8(const v4u r, float (&f)[8]) { f[0] = bflo(r.x); f[1] = bfhi(r.x); f[2] = bflo(r.y); f[3] = bfhi(r.y); f[4] = bflo(r.z); f[5] = bfhi(r.z); f[6] = bflo(r.w); f[7] = bfhi(r.w); }
__device__ __forceinline__ void load8f(const float* p, float (&f)[8]) { const f32x4 a = *(const f32x4*)p, b = *(const f32x4*)(p + 4); f[0] = a[0]; f[1] = a[1]; f[2] = a[2]; f[3] = a[3]; f[4] = b[0]; f[5] = b[1]; f[6] = b[2]; f[7] = b[3]; }
__device__ __forceinline__ void phase_qkv_naive(const Params& p, const bf16_t* PROJ, const float* EX, float* QF, float* KF, float* VF, float* BG, bf16_t* YA, int wave, int lane) {
    const int gw = wave * gridDim.x + blockIdx.x, ngw = gridDim.x * NWAVES;
    const v4u zero4 = {0u, 0u, 0u, 0u};
    for (int tok = gw; tok < NTOK; tok += ngw) {
        const int pos = tok < NCTX ? (tok & 255) : ((tok - NCTX) & 63); const int L = tok < NCTX ? 256 : 64;
        const bool hasL = pos != 0, hasR = pos != L - 1;
#pragma unroll 1
        for (int grp = 0; grp < 6; ++grp) {
            const int part = grp >> 1, ch0 = (grp & 1) * 512 + lane * 8;
            const bf16_t* src = PROJ + (size_t)(3 + part) * BLK + (size_t)tok * DM + ch0;
            float c[8], l[8], r[8], w0[8], w1[8], w2[8], y[8];
            unpack8(*(const v4u*)src, c); unpack8(hasL ? *(const v4u*)(src - DM) : zero4, l); unpack8(hasR ? *(const v4u*)(src + DM) : zero4, r);
            const float* cw = p.dn_conv_w + part * 1024 + ch0;
            load8f(cw, w0); load8f(cw + 3072, w1); load8f(cw + 6144, w2);
            float ss = 0.f;
#pragma unroll
            for (int e = 0; e < 8; ++e) { y[e] = siluf(w0[e] * l[e] + w1[e] * c[e] + w2[e] * r[e]); ss += y[e] * y[e]; }
            if (part < 2) { const float sc = rsqrtf(sum16(ss) + 1e-6f) * (part == 0 ? 0.08838834764831845f : 1.0f);
#pragma unroll
                for (int e = 0; e < 8; ++e) y[e] *= sc; }
            float* dst = (part == 0 ? QF : part == 1 ? KF : VF) + (size_t)tok * DM + ch0;
            f32x4 o0 = {y[0], y[1], y[2], y[3]}, o1 = {y[4], y[5], y[6], y[7]};
            *(f32x4*)dst = o0; *(f32x4*)(dst + 4) = o1;
        }
#pragma unroll 1
        for (int grp = 0; grp < 2; ++grp) {
            const int ch0 = grp * 512 + lane * 8; const size_t o = (size_t)tok * DM + ch0;
            float bg[8], cc[8], cl[8], cr[8], xc[8], xl[8], xr[8], w0[8], w1[8], w2[8];
            unpack8(*(const v4u*)(PROJ + o), bg);
            unpack8(*(const v4u*)(PROJ + BLK + o), cc); unpack8(hasL ? *(const v4u*)(PROJ + BLK + o - DM) : zero4, cl); unpack8(hasR ? *(const v4u*)(PROJ + BLK + o + DM) : zero4, cr);
            unpack8(*(const v4u*)(PROJ + 2 * BLK + o), xc); unpack8(hasL ? *(const v4u*)(PROJ + 2 * BLK + o - DM) : zero4, xl); unpack8(hasR ? *(const v4u*)(PROJ + 2 * BLK + o + DM) : zero4, xr);
            load8f(p.conv_w + ch0, w0); load8f(p.conv_w + 1024 + ch0, w1); load8f(p.conv_w + 2048 + ch0, w2);
            float y[8];
#pragma unroll
            for (int e = 0; e < 8; ++e) y[e] = bg[e] * (w0[e] * cl[e] * xl[e] + w1[e] * cc[e] * xc[e] + w2[e] * cr[e] * xr[e]);
            v4u ov; ov.x = pk2bf(y[0], y[1]); ov.y = pk2bf(y[2], y[3]); ov.z = pk2bf(y[4], y[5]); ov.w = pk2bf(y[6], y[7]);
            *(v4u*)(YA + o) = ov;
        }
        if (lane < 16) {
            const float b_raw = EX[(size_t)tok * 32 + lane], a_raw = EX[(size_t)tok * 32 + 16 + lane];
            const float xx = a_raw + p.dn_dt_bias[lane]; const float sp = xx > 20.f ? xx : log1pf(expf(xx));
            BG[(size_t)tok * 32 + lane] = 1.f / (1.f + expf(-b_raw));
            BG[(size_t)tok * 32 + 16 + lane] = -expf(p.dn_a_log[lane]) * sp;
        }
    }
}

__device__ __forceinline__ void dn_naive_item(const Params& p, const float* QF, const float* KF, const float* VF, const float* BG, float* OF, float* OBk, float* lds, int item) {
    const bool lat = item < 32; const int j = lat ? item : item - 32; const int b = j >> 4, h = (j >> 1) & 7, dir = j & 1;
    const int T = lat ? 1024 : 256; const int tok0 = lat ? NCTX + b * 1024 : b * 256;
    const int tid = threadIdx.x, v = tid & 127, kq = tid >> 7;
    float* qs = lds; float* ks = lds + 128; float* vs = lds + 256; float* gb = lds + 384; float* red = lds + 512; float* red2 = lds + 1024;
    float S[32];
    if (lat) { const float* s0 = (dir ? p.st_b : p.st_f) + ((size_t)(b * 8 + h) * 128) * 128;
#pragma unroll
        for (int i = 0; i < 32; ++i) S[i] = s0[(size_t)(kq * 32 + i) * 128 + v]; }
    else {
#pragma unroll
        for (int i = 0; i < 32; ++i) S[i] = 0.f; }
    float* Od = dir ? OBk : OF;
    for (int t = 0; t < T; ++t) {
        const int tok = tok0 + (dir ? T - 1 - t : t);
        __syncthreads();
        if (tid < 128) qs[tid] = QF[(size_t)tok * DM + h * 128 + tid];
        else if (tid < 256) ks[tid - 128] = KF[(size_t)tok * DM + h * 128 + tid - 128];
        else if (tid < 384) vs[tid - 256] = VF[(size_t)tok * DM + h * 128 + tid - 256];
        else if (tid == 384) gb[0] = BG[(size_t)tok * 32 + dir * 8 + h];
        else if (tid == 385) gb[1] = BG[(size_t)tok * 32 + 16 + dir * 8 + h];
        __syncthreads();
        float part = 0.f;
#pragma unroll
        for (int i = 0; i < 32; ++i) part += ks[kq * 32 + i] * S[i];
        red[kq * 128 + v] = part;
        __syncthreads();
        const float kS = red[v] + red[128 + v] + red[256 + v] + red[384 + v];
        const float eg = expf(gb[1]), beta = gb[0];
        const float delta = beta * (vs[v] - eg * kS);
        float op = 0.f;
#pragma unroll
        for (int i = 0; i < 32; ++i) { S[i] = eg * S[i] + ks[kq * 32 + i] * delta; op += qs[kq * 32 + i] * S[i]; }
        red2[kq * 128 + v] = op;
        __syncthreads();
        if (kq == 0) Od[(size_t)tok * DM + h * 128 + v] = red2[v] + red2[128 + v] + red2[256 + v] + red2[384 + v];
    }
    if (!lat) { float* so = p.out + (size_t)NTOK * DM + (size_t)dir * (16 * 8 * 128 * 128) + ((size_t)(b * 8 + h) * 128) * 128;
#pragma unroll
        for (int i = 0; i < 32; ++i) so[(size_t)(kq * 32 + i) * 128 + v] = S[i]; }
}
__device__ __forceinline__ void phase_dn_naive(const Params& p, const float* QF, const float* KF, const float* VF, const float* BG, float* OF, float* OBk, float* lds) {
    const int bx = blockIdx.x;
    if (gridDim.x >= 256) {
        if (bx < 32) dn_naive_item(p, QF, KF, VF, BG, OF, OBk, lds, bx);
        else if (bx < 256) { dn_naive_item(p, QF, KF, VF, BG, OF, OBk, lds, bx); if (bx < 64) dn_naive_item(p, QF, KF, VF, BG, OF, OBk, lds, 224 + bx); }
    } else { for (int it = bx; it < 288; it += gridDim.x) dn_naive_item(p, QF, KF, VF, BG, OF, OBk, lds, it); }
}

typedef short bf16x8 __attribute__((ext_vector_type(8)));
typedef float f32x16 __attribute__((ext_vector_type(16)));
#define MFMA32(a, b, c) __builtin_amdgcn_mfma_f32_32x32x16_bf16((a), (b), (c), 0, 0, 0)
constexpr int DN_ITEM_BYTES = 73728, DN_W = 0, DN_QD = 16384, DN_KD = 32768, DN_A = 49152, DN_U = 57344;
constexpr int LS = 132;
constexpr int L_QF = 0, L_KF = 33792, L_VF = 67584, L_LM = 101376, L_CO = 134144;
__device__ __forceinline__ int crow16(int i, int hh) { return (i & 3) + 8 * (i >> 2) + 4 * hh; }
__device__ __forceinline__ bf16x8 frag_from_f32(const float* p) { const f32x4 a = *(const f32x4*)p, b = *(const f32x4*)(p + 4);
    v4u r; r.x = pk2bf(a[0], a[1]); r.y = pk2bf(a[2], a[3]); r.z = pk2bf(b[0], b[1]); r.w = pk2bf(b[2], b[3]); return __builtin_bit_cast(bf16x8, r); }
template <int S> __device__ __forceinline__ bf16x8 pack_step(const f32x16& x) {
    v4u r; r.x = pk2bf(x[8 * S + 0], x[8 * S + 1]); r.y = pk2bf(x[8 * S + 2], x[8 * S + 3]); r.z = pk2bf(x[8 * S + 4], x[8 * S + 5]); r.w = pk2bf(x[8 * S + 6], x[8 * S + 7]); return __builtin_bit_cast(bf16x8, r); }

__device__ __forceinline__ void dn_pre_item(const Params& p, const bf16_t* PROJ, const float* EX, unsigned char* DN, float* GL, unsigned char* lds, int sc, int h) {
    const int tid = threadIdx.x, lane = tid & 63, wave = tid >> 6;
    const bool ctx = sc < 64; const int nn = ctx ? (sc & 3) : ((sc - 64) & 15);
    const int tok0 = ctx ? (sc >> 2) * 256 + 64 * nn : NCTX + ((sc - 64) >> 4) * 1024 + 64 * nn;
    float* QFl = (float*)(lds + L_QF); float* KFl = (float*)(lds + L_KF); float* VFl = (float*)(lds + L_VF); float* LM = (float*)(lds + L_LM);
    float* CB = (float*)(lds + L_CO);
    float* CG = CB + 128;
    float* CW = CB + 256;
    float* CE = CB + 384;
    float* CK = CB + 512;
    const v4u zero4 = {0u, 0u, 0u, 0u};
#pragma unroll 1
    for (int jj = 0; jj < 6; ++jj) {
        const int pr = tid + 512 * jj, c = pr / 48, cg = pr % 48, part = cg >> 4, d0 = (cg & 15) * 8;
        const bool hasL = c > 0 || (ctx && nn > 0), hasR = c < 63 || (ctx && nn < 3);
        const bf16_t* src = PROJ + (size_t)(3 + part) * BLK + (size_t)(tok0 + c) * DM + h * 128 + d0;
        float cc[8], l[8], r[8], w0[8], w1[8], w2[8], y[8];
        unpack8(*(const v4u*)src, cc); unpack8(hasL ? *(const v4u*)(src - DM) : zero4, l); unpack8(hasR ? *(const v4u*)(src + DM) : zero4, r);
        const float* cw = p.dn_conv_w + part * 1024 + h * 128 + d0;
        load8f(cw, w0); load8f(cw + 3072, w1); load8f(cw + 6144, w2);
        float ss = 0.f;
#pragma unroll
        for (int e = 0; e < 8; ++e) { y[e] = siluf(w0[e] * l[e] + w1[e] * cc[e] + w2[e] * r[e]); ss += y[e] * y[e]; }
        const float tot = sum16(ss);
        if (part < 2) { const float scl = rsqrtf(tot + 1e-6f) * (part == 0 ? 0.08838834764831845f : 1.0f);
#pragma unroll
            for (int e = 0; e < 8; ++e) y[e] *= scl; }
        float* dst = (part == 0 ? QFl : part == 1 ? KFl : VFl) + c * LS + d0;
        f32x4 o0 = {y[0], y[1], y[2], y[3]}, o1 = {y[4], y[5], y[6], y[7]};
        *(f32x4*)dst = o0; *(f32x4*)(dst + 4) = o1;
    }
    if (wave < 2) {
        const int d = wave, oc = d ? 63 - lane : lane; const size_t tk = (size_t)(tok0 + oc) * 32;
        const float b_raw = EX[tk + d * 8 + h], a_raw = EX[tk + 16 + d * 8 + h];
        const float xx = a_raw + p.dn_dt_bias[d * 8 + h]; const float sp = xx > 20.f ? xx : log1pf(expf(xx));
        const float beta = 1.f / (1.f + expf(-b_raw)); float g = -expf(p.dn_a_log[d * 8 + h]) * sp;
#pragma unroll
        for (int o = 1; o < 64; o <<= 1) { const float t = __shfl_up(g, o); if (lane >= o) g += t; }
        const float glast = __shfl(g, 63); const float eg = expf(g);
        CB[d * 64 + lane] = beta; CG[d * 64 + lane] = g; CW[d * 64 + lane] = beta * eg; CE[d * 64 + lane] = eg; CK[d * 64 + lane] = expf(glast - g);
        if (lane == 0) GL[(sc * 8 + h) * 2 + d] = expf(glast);
    }
    __syncthreads();
    const int dir = wave >> 2;
    unsigned char* item = DN + (size_t)((sc * 8 + h) * 2 + dir) * DN_ITEM_BYTES;
    {
        const int w4 = wave & 3, mt = w4 >> 1, nt = w4 & 1, r = lane & 31, hh = lane >> 5;
        const int ia = 32 * mt + r, ib = 32 * nt + r; const int ca = dir ? 63 - ia : ia, cb = dir ? 63 - ib : ib;
        f32x16 kk, pp;
#pragma unroll
        for (int i = 0; i < 16; ++i) { kk[i] = 0.f; pp[i] = 0.f; }
#pragma unroll
        for (int ks = 0; ks < 8; ++ks) {
            const bf16x8 ka = frag_from_f32(KFl + ca * LS + 16 * ks + 8 * hh), kb = frag_from_f32(KFl + cb * LS + 16 * ks + 8 * hh), qb = frag_from_f32(QFl + cb * LS + 16 * ks + 8 * hh);
            kk = MFMA32(ka, kb, kk); pp = MFMA32(ka, qb, pp);
        }
        const float* gcd = CG + dir * 64; const float* btd = CB + dir * 64;
        const float g_col = gcd[ib];
        f32x16 pv;
#pragma unroll
        for (int i = 0; i < 16; ++i) {
            const int row = 32 * mt + crow16(i, hh); const float g_row = gcd[row];
            LM[dir * 4096 + row * 64 + ib] = (ib < row) ? btd[row] * kk[i] * expf(g_row - g_col) : 0.f;
            pv[i] = (row <= ib) ? pp[i] * expf(g_col - g_row) : 0.f;
        }
        v4u* af = (v4u*)(item + DN_A);
        af[(nt * 4 + mt * 2 + 0) * 64 + lane] = __builtin_bit_cast(v4u, pack_step<0>(pv));
        af[(nt * 4 + mt * 2 + 1) * 64 + lane] = __builtin_bit_cast(v4u, pack_step<1>(pv));
    }
    __syncthreads();
    const int col = tid & 255, cc = col & 127; const bool isw = col >= 128;
    float x[64];
    {
        const float* srcm = isw ? KFl : VFl; const float* coef = (isw ? CW : CB) + dir * 64; const float* Lm = LM + dir * 4096;
#pragma unroll
        for (int c = 0; c < 64; ++c) {
            const int oc = dir ? 63 - c : c;
            float acc = srcm[oc * LS + cc] * coef[c];
#pragma unroll
            for (int s = 0; s < c; ++s) acc -= Lm[c * 64 + s] * x[s];
            x[c] = acc;
        }
        if (!isw) {
            const int jj = cc >> 5, n = cc & 31;
#pragma unroll
            for (int mt = 0; mt < 2; ++mt)
#pragma unroll
                for (int hh = 0; hh < 2; ++hh) {
                    v4u lo, hi;
                    lo.x = pk2bf(x[32 * mt + 4 * hh + 0], x[32 * mt + 4 * hh + 1]); lo.y = pk2bf(x[32 * mt + 4 * hh + 2], x[32 * mt + 4 * hh + 3]);
                    lo.z = pk2bf(x[32 * mt + 4 * hh + 8], x[32 * mt + 4 * hh + 9]); lo.w = pk2bf(x[32 * mt + 4 * hh + 10], x[32 * mt + 4 * hh + 11]);
                    hi.x = pk2bf(x[32 * mt + 4 * hh + 16], x[32 * mt + 4 * hh + 17]); hi.y = pk2bf(x[32 * mt + 4 * hh + 18], x[32 * mt + 4 * hh + 19]);
                    hi.z = pk2bf(x[32 * mt + 4 * hh + 24], x[32 * mt + 4 * hh + 25]); hi.w = pk2bf(x[32 * mt + 4 * hh + 26], x[32 * mt + 4 * hh + 27]);
                    v4u* dst = (v4u*)(item + DN_U + (size_t)(((jj * 2 + mt) * 64 + hh * 32 + n) * 32));
                    dst[0] = lo; dst[1] = hi;
                }
        }
    }
    __syncthreads();
    bf16_t* WL = (bf16_t*)(lds + L_VF);
    if (isw) {
#pragma unroll
        for (int c = 0; c < 64; ++c) WL[(dir * 64 + c) * LS + cc] = (bf16_t)(pk2bf(x[c], 0.f) & 0xffffu);
    }
    __syncthreads();
    {
        const int t = tid & 255; const float* ce = CE + dir * 64; const float* ck = CK + dir * 64;
#pragma unroll 1
        for (int q = 0; q < 4; ++q) {
            const int fl = t + 256 * q, f = fl >> 6, ln = fl & 63, r = ln & 31, hh = ln >> 5;
            {
                const int mt = f >> 3, ks8 = f & 7, cp = 32 * mt + r, oc = dir ? 63 - cp : cp, dkb = 16 * ks8 + 4 * hh;
                const u32x2 lo = *(const u32x2*)(WL + (dir * 64 + cp) * LS + dkb), hi = *(const u32x2*)(WL + (dir * 64 + cp) * LS + dkb + 8);
                v4u wv; wv.x = lo.x; wv.y = lo.y; wv.z = hi.x; wv.w = hi.y;
                ((v4u*)(item + DN_W))[f * 64 + ln] = wv;
                const f32x4 qa = *(const f32x4*)(QFl + oc * LS + dkb), qb = *(const f32x4*)(QFl + oc * LS + dkb + 8); const float e = ce[cp];
                v4u qv; qv.x = pk2bf(qa[0] * e, qa[1] * e); qv.y = pk2bf(qa[2] * e, qa[3] * e); qv.z = pk2bf(qb[0] * e, qb[1] * e); qv.w = pk2bf(qb[2] * e, qb[3] * e);
                ((v4u*)(item + DN_QD))[f * 64 + ln] = qv;
            }
            {
                const int mtK = f >> 2, kst = f & 3, dk = 32 * mtK + r, sb = 16 * kst + 4 * hh;
                float kv[8];
#pragma unroll
                for (int j = 0; j < 8; ++j) { const int sp = sb + (j & 3) + 8 * (j >> 2); const int os = dir ? 63 - sp : sp; kv[j] = KFl[os * LS + dk] * ck[sp]; }
                v4u kq; kq.x = pk2bf(kv[0], kv[1]); kq.y = pk2bf(kv[2], kv[3]); kq.z = pk2bf(kv[4], kv[5]); kq.w = pk2bf(kv[6], kv[7]);
                ((v4u*)(item + DN_KD))[f * 64 + ln] = kq;
            }
        }
    }
    __syncthreads();
}

__device__ __forceinline__ void phase_branch_a(const Params& p, const bf16_t* PROJ, bf16_t* YA, int wave, int lane) {
    const int gw = wave * gridDim.x + blockIdx.x, ngw = gridDim.x * NWAVES;
    const v4u zero4 = {0u, 0u, 0u, 0u};
    for (int tok = gw; tok < NTOK; tok += ngw) {
        const int pos = tok < NCTX ? (tok & 255) : ((tok - NCTX) & 63); const int L = tok < NCTX ? 256 : 64;
        const bool hasL = pos != 0, hasR = pos != L - 1;
#pragma unroll 1
        for (int grp = 0; grp < 2; ++grp) {
            const int ch0 = grp * 512 + lane * 8; const size_t o = (size_t)tok * DM + ch0;
            float bg[8], cc[8], cl[8], cr[8], xc[8], xl[8], xr[8], w0[8], w1[8], w2[8];
            unpack8(*(const v4u*)(PROJ + o), bg);
            unpack8(*(const v4u*)(PROJ + BLK + o), cc); unpack8(hasL ? *(const v4u*)(PROJ + BLK + o - DM) : zero4, cl); unpack8(hasR ? *(const v4u*)(PROJ + BLK + o + DM) : zero4, cr);
            unpack8(*(const v4u*)(PROJ + 2 * BLK + o), xc); unpack8(hasL ? *(const v4u*)(PROJ + 2 * BLK + o - DM) : zero4, xl); unpack8(hasR ? *(const v4u*)(PROJ + 2 * BLK + o + DM) : zero4, xr);
            load8f(p.conv_w + ch0, w0); load8f(p.conv_w + 1024 + ch0, w1); load8f(p.conv_w + 2048 + ch0, w2);
            float y[8];
#pragma unroll
            for (int e = 0; e < 8; ++e) y[e] = bg[e] * (w0[e] * cl[e] * xl[e] + w1[e] * cc[e] * xc[e] + w2[e] * cr[e] * xr[e]);
            v4u ov; ov.x = pk2bf(y[0], y[1]); ov.y = pk2bf(y[2], y[3]); ov.z = pk2bf(y[4], y[5]); ov.w = pk2bf(y[6], y[7]);
            *(v4u*)(YA + o) = ov;
        }
    }
}

__device__ __forceinline__ void dn_scan_item(const Params& p, const unsigned char* DN, const float* GL, float* OF, float* OBk, int it, int lane) {
    const bool lat = it < 128; const int q = lat ? it : it - 128;
    const int jj = q & 3, dir = (q >> 2) & 1, h = (q >> 3) & 7, b = q >> 6;
    const int nch = lat ? 16 : 4, scb = lat ? 64 + 16 * b : 4 * b, tokb = lat ? NCTX + b * 1024 : b * 256;
    const int n = lane & 31, hh = lane >> 5;
    f32x16 S[4];
    if (lat) { const float* s0 = (dir ? p.st_b : p.st_f) + (size_t)(b * 8 + h) * 16384 + 32 * jj + n;
#pragma unroll
        for (int m = 0; m < 4; ++m)
#pragma unroll
            for (int i = 0; i < 16; ++i) S[m][i] = s0[(size_t)(32 * m + crow16(i, hh)) * 128]; }
    else {
#pragma unroll
        for (int m = 0; m < 4; ++m)
#pragma unroll
            for (int i = 0; i < 16; ++i) S[m][i] = 0.f; }
    float* Od = (dir ? OBk : OF) + h * 128 + 32 * jj + n;
#pragma unroll 1
    for (int ci = 0; ci < nch; ++ci) {
        const int no = dir ? nch - 1 - ci : ci; const int id = ((scb + no) * 8 + h) * 2 + dir;
        const unsigned char* item = DN + (size_t)id * DN_ITEM_BYTES;
        const v4u* Wf = (const v4u*)(item + DN_W) + lane; const v4u* Qf = (const v4u*)(item + DN_QD) + lane; const v4u* Kf = (const v4u*)(item + DN_KD) + lane; const v4u* Af = (const v4u*)(item + DN_A) + lane;
        const float gl = GL[id];
        bf16x8 Sb[8];
        Sb[0] = pack_step<0>(S[0]); Sb[1] = pack_step<1>(S[0]); Sb[2] = pack_step<0>(S[1]); Sb[3] = pack_step<1>(S[1]);
        Sb[4] = pack_step<0>(S[2]); Sb[5] = pack_step<1>(S[2]); Sb[6] = pack_step<0>(S[3]); Sb[7] = pack_step<1>(S[3]);
        f32x16 vn[2], o[2];
#pragma unroll
        for (int mt = 0; mt < 2; ++mt) {
            f32x16 ws;
#pragma unroll
            for (int i = 0; i < 16; ++i) { ws[i] = 0.f; o[mt][i] = 0.f; }
#pragma unroll
            for (int ks = 0; ks < 8; ++ks) { ws = MFMA32(__builtin_bit_cast(bf16x8, Wf[(mt * 8 + ks) * 64]), Sb[ks], ws); o[mt] = MFMA32(__builtin_bit_cast(bf16x8, Qf[(mt * 8 + ks) * 64]), Sb[ks], o[mt]); }
            const v4u* up = (const v4u*)(item + DN_U + (size_t)(((jj * 2 + mt) * 64 + lane) * 32));
            const v4u u0 = up[0], u1 = up[1];
            vn[mt][0] = bflo(u0.x) - ws[0]; vn[mt][1] = bfhi(u0.x) - ws[1]; vn[mt][2] = bflo(u0.y) - ws[2]; vn[mt][3] = bfhi(u0.y) - ws[3];
            vn[mt][4] = bflo(u0.z) - ws[4]; vn[mt][5] = bfhi(u0.z) - ws[5]; vn[mt][6] = bflo(u0.w) - ws[6]; vn[mt][7] = bfhi(u0.w) - ws[7];
            vn[mt][8] = bflo(u1.x) - ws[8]; vn[mt][9] = bfhi(u1.x) - ws[9]; vn[mt][10] = bflo(u1.y) - ws[10]; vn[mt][11] = bfhi(u1.y) - ws[11];
            vn[mt][12] = bflo(u1.z) - ws[12]; vn[mt][13] = bfhi(u1.z) - ws[13]; vn[mt][14] = bflo(u1.w) - ws[14]; vn[mt][15] = bfhi(u1.w) - ws[15];
        }
        bf16x8 Vb[4];
        Vb[0] = pack_step<0>(vn[0]); Vb[1] = pack_step<1>(vn[0]); Vb[2] = pack_step<0>(vn[1]); Vb[3] = pack_step<1>(vn[1]);
#pragma unroll
        for (int mt = 0; mt < 2; ++mt)
#pragma unroll
            for (int kst = 0; kst < 4; ++kst) o[mt] = MFMA32(__builtin_bit_cast(bf16x8, Af[(mt * 4 + kst) * 64]), Vb[kst], o[mt]);
#pragma unroll
        for (int m = 0; m < 4; ++m) {
#pragma unroll
            for (int i = 0; i < 16; ++i) S[m][i] *= gl;
#pragma unroll
            for (int kst = 0; kst < 4; ++kst) S[m] = MFMA32(__builtin_bit_cast(bf16x8, Kf[(m * 4 + kst) * 64]), Vb[kst], S[m]);
        }
        const int tok0 = tokb + 64 * no;
#pragma unroll
        for (int mt = 0; mt < 2; ++mt)
#pragma unroll
            for (int i = 0; i < 16; ++i) { const int cp = 32 * mt + crow16(i, hh); const int oc = dir ? 63 - cp : cp; Od[(size_t)(tok0 + oc) * DM] = o[mt][i]; }
    }
    if (!lat) { float* so = p.out + (size_t)NTOK * DM + (size_t)dir * (16 * 8 * 128 * 128) + (size_t)(b * 8 + h) * 16384 + 32 * jj + n;
#pragma unroll
        for (int m = 0; m < 4; ++m)
#pragma unroll
            for (int i = 0; i < 16; ++i) so[(size_t)(32 * m + crow16(i, hh)) * 128] = S[m][i]; }
}

__device__ __forceinline__ void phase_ogate(const Params& p, const float* OF, const float* OBk, const bf16_t* Z, bf16_t* OG, int wave, int lane) {
    const int gw = wave * gridDim.x + blockIdx.x, ngw = gridDim.x * NWAVES;
    for (int tok = gw; tok < NTOK; tok += ngw) {
#pragma unroll
        for (int hf = 0; hf < 2; ++hf) {
            const int ch0 = hf * 512 + lane * 8; const size_t o = (size_t)tok * DM + ch0;
            float a[8], b2[8], z[8], nw[8];
            load8f(OF + o, a); load8f(OBk + o, b2); unpack8(*(const v4u*)(Z + o), z); load8f(p.dn_norm_w + (ch0 & 127), nw);
            float ss = 0.f;
#pragma unroll
            for (int e = 0; e < 8; ++e) { a[e] += b2[e]; ss += a[e] * a[e]; }
            const float r = rsqrtf(sum16(ss) * (1.0f / 128.0f) + 1e-6f);
            float y[8];
#pragma unroll
            for (int e = 0; e < 8; ++e) y[e] = a[e] * r * nw[e] * siluf(z[e]);
            v4u ov; ov.x = pk2bf(y[0], y[1]); ov.y = pk2bf(y[2], y[3]); ov.z = pk2bf(y[4], y[5]); ov.w = pk2bf(y[6], y[7]);
            *(v4u*)(OG + o) = ov;
        }
    }
}

template <class Epi> __device__ __forceinline__ void run_gemm(PG8_LAS unsigned char* lds, const bf16_t* A, const bf16_t* Bt, int N, int K, const Epi& E) {
    pg8::Gemm g; g.A = A; g.Bt = Bt; g.M = NTOK; g.N = N; g.K = K;
    pg8::StaticOrder S; S.init(NTOK, N, (int)gridDim.x, (int)blockIdx.x);
    pg8::gemm_phase<Epi, pg8::StaticOrder, false>(lds, g, S, E, nullptr);
    __syncthreads();
}

__global__ void __launch_bounds__(512) fwd_megakernel(Params p) {
    extern __shared__ __attribute__((aligned(16))) unsigned char shm[];
    cg::grid_group grid = cg::this_grid();
    PG8_LAS unsigned char* lds3 = (PG8_LAS unsigned char*)shm;
    const int wave = __builtin_amdgcn_readfirstlane(threadIdx.x >> 6), lane = threadIdx.x & 63;
    unsigned char* ws = p.ws;
    float* X0 = (float*)(ws + OFF_X0); float* X1 = (float*)(ws + OFF_X1); float* MOD = (float*)(ws + OFF_MOD);
    bf16_t* PROJ = (bf16_t*)(ws + OFF_PROJ); float* EX = (float*)(ws + OFF_EX);
    bf16_t* AM = (bf16_t*)p.out;
    bf16_t* HB = (bf16_t*)(ws + OFF_PROJ);
    float* QF = (float*)(ws + OFF_DN); float* KF = QF + BLK; float* VF = KF + BLK; float* BG = VF + BLK;
    float* OF = (float*)(ws + OFF_PROJ); float* OBk = OF + BLK;
    bf16_t* OG = PROJ + 4 * BLK; bf16_t* MRG = PROJ + 5 * BLK; float* GLp = (float*)(ws + OFF_EX + 786432);

    phase_prep(p, shm, wave, lane);
    grid.sync();
    phase_norm<true>(p, nullptr, X0, p.norm_ffn1, 0, AM, wave, lane);
    grid.sync();
    { pg8::EpiSwiglu E; E.H = HB; run_gemm(lds3, AM, (const bf16_t*)(ws + OFF_WGU), 5632, 1024, E); }
    grid.sync();
    { pg8::EpiResid E; E.Xin = X0; E.Xout = X1; E.gate = MOD + 2 * 1024; E.scale = 0.5f; run_gemm(lds3, HB, (const bf16_t*)(ws + OFF_WD), 1024, FFH, E); }
    grid.sync();
    phase_norm<false>(p, X1, nullptr, p.norm_mix, 3, AM, wave, lane);
    grid.sync();
    { pg8::EpiProj E; E.P = PROJ; E.EX = EX; run_gemm(lds3, AM, (const bf16_t*)(ws + OFF_WIN), 9472, 1024, E); }
    grid.sync();
    for (int it = blockIdx.x; it < 768; it += gridDim.x) dn_pre_item(p, PROJ, EX, ws + OFF_DN, GLp, shm, it >> 3, it & 7);
    phase_branch_a(p, PROJ, AM, wave, lane);
    grid.sync();
    for (int it = wave * gridDim.x + blockIdx.x; it < 1152; it += gridDim.x * NWAVES) dn_scan_item(p, ws + OFF_DN, GLp, OF, OBk, it, lane);
    grid.sync();
    phase_ogate(p, OF, OBk, PROJ + 6 * BLK, OG, wave, lane);
    {
        float* scr = (float*)shm + wave * (64 * 33); const int gw = wave * gridDim.x + blockIdx.x, ngw = gridDim.x * NWAVES;
        transpose_matrix(p.f2g, 1024, FFH, (bf16_t*)(ws + OFF_WGU), 1, gw, ngw, scr, lane);
        transpose_matrix(p.f2u, 1024, FFH, (bf16_t*)(ws + OFF_WGU), 2, gw, ngw, scr, lane);
        transpose_matrix(p.f2d, FFH, 1024, (bf16_t*)(ws + OFF_WD), 0, gw, ngw, scr, lane);
        __syncthreads();
    }
    grid.sync();
    { pg8::EpiGate<0> E; E.G = PROJ + 7 * BLK; E.T = X0; E.O = nullptr; run_gemm(lds3, AM, (const bf16_t*)(ws + OFF_WCO), 1024, 1024, E); }
    { pg8::EpiGate<1> E; E.G = PROJ + 8 * BLK; E.T = X0; E.O = MRG; run_gemm(lds3, OG, (const bf16_t*)(ws + OFF_WDNO), 1024, 1024, E); }
    grid.sync();
    { pg8::EpiResid E; E.Xin = X1; E.Xout = X0; E.gate = MOD + 5 * 1024; E.scale = 1.0f; run_gemm(lds3, MRG, (const bf16_t*)(ws + OFF_WO), 1024, 1024, E); }
    grid.sync();
    phase_norm<false>(p, X0, nullptr, p.norm_ffn2, 6, AM, wave, lane);
    grid.sync();
    { pg8::EpiSwiglu E; E.H = HB; run_gemm(lds3, AM, (const bf16_t*)(ws + OFF_WGU), 5632, 1024, E); }
    grid.sync();
    { pg8::EpiResid E; E.Xin = X0; E.Xout = p.out; E.gate = MOD + 8 * 1024; E.scale = 0.5f; run_gemm(lds3, HB, (const bf16_t*)(ws + OFF_WD), 1024, FFH, E); }
    grid.sync();
    phase_final_norm(p, p.out, wave, lane);
}

extern "C" void kernel_launch(void* const* d_in, const int* in_sizes, int n_in, void* d_out, int out_size, void* d_ws, size_t ws_size, hipStream_t stream) {
    static int grid_blocks = 0;
    if (grid_blocks == 0) {
        if (n_in != 27 || ws_size < WS_NEED) { fprintf(stderr, "kernel_launch: unexpected n_in %d / ws %zu\n", n_in, ws_size); grid_blocks = -1; return; }
        int dev = 0, cus = 0, per_cu = 0;
        hipGetDevice(&dev); hipDeviceGetAttribute(&cus, hipDeviceAttributeMultiprocessorCount, dev);
        hipFuncSetAttribute((const void*)fwd_megakernel, hipFuncAttributeMaxDynamicSharedMemorySize, LDS_BYTES);
        hipOccupancyMaxActiveBlocksPerMultiprocessor(&per_cu, (const void*)fwd_megakernel, 512, LDS_BYTES);
        if (per_cu < 1) { fprintf(stderr, "kernel_launch: occupancy query says %d blocks/CU\n", per_cu); per_cu = 1; }
        (void)hipGetLastError();
        grid_blocks = cus;
    }
    if (grid_blocks < 0) return;
    Params p{};
    const float** f = (const float**)&p;
    for (int i = 0; i < 27; ++i) f[i] = (const float*)d_in[i];
    p.out = (float*)d_out; p.ws = (unsigned char*)d_ws;
    void* args[] = {&p};
    hipError_t e = hipLaunchCooperativeKernel((const void*)fwd_megakernel, dim3(grid_blocks), dim3(512), args, LDS_BYTES, stream);
    if (e != hipSuccess) fprintf(stderr, "cooperative launch failed: %s (grid %d)\n", hipGetErrorString(e), grid_blocks);
}
```

```cpp
#include <hip/hip_runtime.h>
#include <hip/hip_cooperative_groups.h>
#include <cstdio>
#include <cstdint>
namespace cg = cooperative_groups;
#define REP_PREP 1
#define REP_GEMM 1
#define REP_DNPRE 1
#define REP_SCAN 1
#define REP_THIN 1
#define REP_SYNC 0
namespace pg8 {
#define PG8_LAS __attribute__((address_space(3)))
typedef unsigned short bf16_t;
typedef short bf16x8 __attribute__((ext_vector_type(8)));
typedef float f32x4 __attribute__((ext_vector_type(4)));
typedef unsigned u32x4 __attribute__((ext_vector_type(4)));
constexpr int BM = 256, BK = 64, HALF = 128, HTB = HALF * BK * 2  , STAGE_BYTES = 8 * HTB, NXCD = 8, WGM = 8;

__host__ __device__ __forceinline__ int lds_byte(int r, int c) { const int st = (r >> 4) * 2 + (c >> 5), rr = r & 15, cc = c & 31, ob = rr * 64 + cc * 2; return st * 1024 + (ob ^ (((ob >> 9) & 1) << 5)); }
__host__ __device__ __forceinline__ void stage_rc(int b, int& R, int& C) { const int st = b / 1024, sb = b % 1024, swz = sb ^ (((sb >> 9) & 1) << 5); R = (st >> 1) * 16 + swz / 64; C = (st & 1) * 32 + (swz % 64) / 2; }
__host__ __device__ __forceinline__ int perm32(int rho) { const int n = rho >> 4, i = rho & 15; return 8 * (i >> 2) + 4 * n + (i & 3); }

struct Unit { int pm, pn; };
struct Gemm { const bf16_t* A; const bf16_t* Bt; int M, N, K; };

struct StaticOrder {
    int nM, nN, nwg, G, c;
    __host__ __device__ void init(int M, int N, int G_, int c_) { nM = M / BM; nN = N / BM; nwg = nM * nN; G = G_; c = c_; }
    __host__ __device__ bool next(int i, Unit& u) const {
        const long L = (long)i * G + c; if (L >= nwg) return false;
        int wgid = (int)L; { const int q = nwg / NXCD, r = nwg % NXCD, xcd = wgid % NXCD, off = wgid / NXCD; wgid = (xcd < r ? xcd * (q + 1) : r * (q + 1) + (xcd - r) * q) + off; }
        const int nig = WGM * nN, gid = wgid / nig, fm = gid * WGM, gsz = (nM - fm) < WGM ? (nM - fm) : WGM;
        u.pm = fm + ((wgid % nig) % gsz); u.pn = (wgid % nig) / gsz; return true;
    }
    __device__ __forceinline__ void a_ready(const Unit&) const {}
    __device__ __forceinline__ void done(const Unit&) const {}
};
__device__ __forceinline__ unsigned pk2bf(float a, float b) { typedef float f2v __attribute__((ext_vector_type(2))); typedef __bf16 b2v __attribute__((ext_vector_type(2))); f2v v = {a, b}; b2v r = __builtin_convertvector(v, b2v); return __builtin_bit_cast(unsigned, r); }
__device__ __forceinline__ float bflo(unsigned u) { return __uint_as_float(u << 16); }
__device__ __forceinline__ float bfhi(unsigned u) { return __uint_as_float(u & 0xffff0000u); }
__device__ __forceinline__ float siluf(float x) { return x / (1.f + __expf(-x)); }
__device__ __forceinline__ float sigmf(float x) { return 1.f / (1.f + __expf(-x)); }
__device__ __forceinline__ int cond_of_tile(int pm) { return pm < 16 ? 0 : 1 + ((pm - 16) >> 2); }
constexpr int NTOK = 6144, DM = 1024, FFH = 2816, NMOD = 9216;
typedef unsigned u32x2 __attribute__((ext_vector_type(2)));

struct EpiSwiglu {
    static constexpr bool PERM = false, AFTER_DRAIN = false;
    bf16_t* H;
    __device__ __forceinline__ void operator()(const f32x4 (&acc)[2][2][4][2], const Unit& u, int wr, int wc, int fr, int fq) const {
        const int row0 = u.pm * BM + wr * 64 + fr, col0 = u.pn * 128 + wc * 32 + 4 * fq;
#pragma unroll
        for (int ai = 0; ai < 2; ++ai)
#pragma unroll
            for (int m = 0; m < 4; ++m) { bf16_t* rowp = H + (size_t)(row0 + ai * HALF + m * 16) * FFH + col0;
#pragma unroll
                for (int n = 0; n < 2; ++n) { const f32x4 g = acc[ai][0][m][n], up = acc[ai][1][m][n];
                    u32x2 o; o.x = pk2bf(siluf(g[0]) * up[0], siluf(g[1]) * up[1]); o.y = pk2bf(siluf(g[2]) * up[2], siluf(g[3]) * up[3]);
                    *(u32x2*)(rowp + n * 16) = o; } }
    }
};
struct EpiResid {
    static constexpr bool PERM = false, AFTER_DRAIN = false;
    const float* Xin; float* Xout; const float* gate; float scale;
    __device__ __forceinline__ void operator()(const f32x4 (&acc)[2][2][4][2], const Unit& u, int wr, int wc, int fr, int fq) const {
        const int row0 = u.pm * BM + wr * 64 + fr, col0 = u.pn * BM + wc * 32 + 4 * fq;
        const float* gp = gate + (size_t)cond_of_tile(u.pm) * NMOD + col0;
        f32x4 gv[2][2];
#pragma unroll
        for (int bj = 0; bj < 2; ++bj)
#pragma unroll
            for (int n = 0; n < 2; ++n) gv[bj][n] = *(const f32x4*)(gp + bj * HALF + n * 16) * scale;
#pragma unroll
        for (int ai = 0; ai < 2; ++ai)
#pragma unroll
            for (int m = 0; m < 4; ++m) { const size_t off = (size_t)(row0 + ai * HALF + m * 16) * DM + col0;
#pragma unroll
                for (int bj = 0; bj < 2; ++bj)
#pragma unroll
                    for (int n = 0; n < 2; ++n) { const f32x4 x = *(const f32x4*)(Xin + off + bj * HALF + n * 16);
                        *(f32x4*)(Xout + off + bj * HALF + n * 16) = x + gv[bj][n] * acc[ai][bj][m][n]; } }
    }
};
struct EpiProj {
    static constexpr bool PERM = false, AFTER_DRAIN = false;
    bf16_t* P; float* EX;
    __device__ __forceinline__ void operator()(const f32x4 (&acc)[2][2][4][2], const Unit& u, int wr, int wc, int fr, int fq) const {
        const int row0 = u.pm * BM + wr * 64 + fr;
        if (u.pn < 36) {
            bf16_t* base = P + (size_t)(u.pn >> 2) * NTOK * DM; const int col0 = (u.pn & 3) * 256 + wc * 32 + 4 * fq;
#pragma unroll
            for (int ai = 0; ai < 2; ++ai)
#pragma unroll
                for (int m = 0; m < 4; ++m) { bf16_t* rowp = base + (size_t)(row0 + ai * HALF + m * 16) * DM + col0;
#pragma unroll
                    for (int bj = 0; bj < 2; ++bj)
#pragma unroll
                        for (int n = 0; n < 2; ++n) { const f32x4 v = acc[ai][bj][m][n]; u32x2 o; o.x = pk2bf(v[0], v[1]); o.y = pk2bf(v[2], v[3]); *(u32x2*)(rowp + bj * HALF + n * 16) = o; } }
        } else if (wc == 0) {
#pragma unroll
            for (int ai = 0; ai < 2; ++ai)
#pragma unroll
                for (int m = 0; m < 4; ++m)
#pragma unroll
                    for (int n = 0; n < 2; ++n) *(f32x4*)(EX + (size_t)(row0 + ai * HALF + m * 16) * 32 + n * 16 + 4 * fq) = acc[ai][0][m][n];
        }
    }
};
template <int SECOND> struct EpiGate {
    static constexpr bool PERM = false, AFTER_DRAIN = false;
    const bf16_t* G; float* T; bf16_t* O;
    __device__ __forceinline__ void operator()(const f32x4 (&acc)[2][2][4][2], const Unit& u, int wr, int wc, int fr, int fq) const {
        const int row0 = u.pm * BM + wr * 64 + fr, col0 = u.pn * BM + wc * 32 + 4 * fq;
#pragma unroll
        for (int ai = 0; ai < 2; ++ai)
#pragma unroll
            for (int m = 0; m < 4; ++m) { const size_t off = (size_t)(row0 + ai * HALF + m * 16) * DM + col0;
#pragma unroll
                for (int bj = 0; bj < 2; ++bj)
#pragma unroll
                    for (int n = 0; n < 2; ++n) { const size_t o = off + bj * HALF + n * 16; const u32x2 gr = *(const u32x2*)(G + o); const f32x4 a = acc[ai][bj][m][n];
                        f32x4 v; v[0] = sigmf(bflo(gr.x)) * a[0]; v[1] = sigmf(bfhi(gr.x)) * a[1]; v[2] = sigmf(bflo(gr.y)) * a[2]; v[3] = sigmf(bfhi(gr.y)) * a[3];
                        if (SECOND == 0) *(f32x4*)(T + o) = v;
                        else { const f32x4 t = *(const f32x4*)(T + o); v = v + t; u32x2 w; w.x = pk2bf(v[0], v[1]); w.y = pk2bf(v[2], v[3]); *(u32x2*)(O + o) = w; } } }
    }
};

template <class Epi, class Sched, bool STAMP = false>
__device__ __forceinline__ void gemm_phase(PG8_LAS unsigned char* lds, const Gemm g, const Sched& S, const Epi& E, unsigned long long* stamps) {
    const int tid = threadIdx.x, wid = __builtin_amdgcn_readfirstlane(tid >> 6), lane = tid & 63, wr = wid >> 2, wc = wid & 3, fr = lane & 15, fq = lane >> 4;
    const int K = g.K, nt = K / BK;
    int ts_lo = 0, ts_hi = 0, nts = 0; const unsigned long long rt_entry = STAMP ? (unsigned long long)wall_clock64() : 0ull;
#define PG8_STAMP() do { if (STAMP && wid == 0 && nts < 64) { const unsigned long long _c = (unsigned long long)clock64(); \
        ts_lo = (lane == nts) ? (int)(unsigned)_c : ts_lo; ts_hi = (lane == nts) ? (int)(unsigned)(_c >> 32) : ts_hi; ++nts; } } while (0)
    PG8_STAMP();
    unsigned voffA[2], voffB[2];
#pragma unroll
    for (int i = 0; i < 2; ++i) { int R, C; stage_rc(tid * 16 + i * 8192, R, C); const int Rb = Epi::PERM ? ((R & ~31) + perm32(R & 31)) : R;
        voffA[i] = (unsigned)(R * K + C) * 2u; voffB[i] = (unsigned)(Rb * K + C) * 2u; }
    const size_t kstep = (size_t)(BK * 2);
    const size_t hstep = (size_t)HALF * K * 2;
    const size_t tstep = 2 * hstep;
    const unsigned ldsw = (unsigned)wid * 1024u;
    const int aoff = lds_byte(wr * 64 + fr, fq * 8), boff = lds_byte(wc * 32 + fr, fq * 8);
#define PG8_SA(b, h) (((b) * 2 + (h)) * HTB)
#define PG8_SB(b, h) ((4 + (b) * 2 + (h)) * HTB)
#define PG8_STAGE(bufoff, gbase, voff) do { _Pragma("unroll") for (int _i = 0; _i < 2; ++_i) \
        __builtin_amdgcn_global_load_lds((const unsigned*)((const char*)(gbase) + (voff)[_i]), (PG8_LAS unsigned*)(lds + (bufoff) + ldsw + _i * 8192), 16, 0, 0); } while (0)
#define PG8_LDA(dst, b, h) do { _Pragma("unroll") for (int m = 0; m < 4; ++m) _Pragma("unroll") for (int k = 0; k < 2; ++k) dst[m][k] = *(const PG8_LAS bf16x8*)(lds + PG8_SA(b, h) + aoff + m * 2048 + k * 1024); } while (0)
#define PG8_LDB(dst, b, h) do { _Pragma("unroll") for (int n = 0; n < 2; ++n) _Pragma("unroll") for (int k = 0; k < 2; ++k) dst[n][k] = *(const PG8_LAS bf16x8*)(lds + PG8_SB(b, h) + boff + n * 2048 + k * 1024); } while (0)
#define PG8_MMA(ai, bj, At, Bt) do { __builtin_amdgcn_s_setprio(1); _Pragma("unroll") for (int m = 0; m < 4; ++m) _Pragma("unroll") for (int n = 0; n < 2; ++n) _Pragma("unroll") for (int k = 0; k < 2; ++k) \
        acc[ai][bj][m][n] = __builtin_amdgcn_mfma_f32_16x16x32_bf16(Bt[n][k], At[m][k], acc[ai][bj][m][n], 0, 0, 0); __builtin_amdgcn_s_setprio(0); } while (0)
#define PG8_WAIT_V(n) asm volatile("s_waitcnt vmcnt(" #n ")" ::: "memory")
#define PG8_WAIT_L(n) asm volatile("s_waitcnt lgkmcnt(" #n ")" ::: "memory")
#define PG8_BAR __builtin_amdgcn_s_barrier()
#define PG8_SCHED __builtin_amdgcn_sched_barrier(0)
    Unit cur, nxt; int ui = 0;
    if (!S.next(0, cur)) return;
    f32x4 acc[2][2][4][2];
#pragma unroll
    for (int a = 0; a < 2; ++a)
#pragma unroll
        for (int b = 0; b < 2; ++b)
#pragma unroll
            for (int m = 0; m < 4; ++m)
#pragma unroll
                for (int n = 0; n < 2; ++n) acc[a][b][m][n] = (f32x4){0.f, 0.f, 0.f, 0.f};
    bf16x8 At[4][2], B0[2][2], B1[2][2];
    const char* cA = (const char*)g.A + (size_t)cur.pm * tstep; const char* cB = (const char*)g.Bt + (size_t)cur.pn * tstep;
    S.a_ready(cur);
    PG8_STAGE(PG8_SB(0, 0), cB, voffB); PG8_STAGE(PG8_SA(0, 0), cA, voffA); PG8_STAGE(PG8_SB(0, 1), cB + hstep, voffB); PG8_STAGE(PG8_SA(0, 1), cA + hstep, voffA);
    if (wr == 1) PG8_BAR;
    PG8_WAIT_V(4); PG8_BAR;
    PG8_STAGE(PG8_SB(1, 0), cB + kstep, voffB); PG8_STAGE(PG8_SA(1, 0), cA + kstep, voffA); PG8_STAGE(PG8_SB(1, 1), cB + hstep + kstep, voffB);
    PG8_WAIT_V(6); PG8_BAR;
    PG8_STAMP();
    for (;;) {
        const bool has_next = S.next(ui + 1, nxt);
        const char* nA = has_next ? (const char*)g.A + (size_t)nxt.pm * tstep : cA; const char* nB = has_next ? (const char*)g.Bt + (size_t)nxt.pn * tstep : cB;
        for (int t = 0; t < nt; t += 2) {
            const bool last = (t == nt - 2);
            const char* a1 = cA + (size_t)(t + 1) * kstep;
            const char* a2 = last ? nA : cA + (size_t)(t + 2) * kstep; const char* b2 = last ? nB : cB + (size_t)(t + 2) * kstep;
            const char* a3 = a2 + kstep; const char* b3 = b2 + kstep;
            if (last && has_next) S.a_ready(nxt);
            PG8_LDB(B0, 0, 0); PG8_SCHED; PG8_LDA(At, 0, 0); PG8_STAGE(PG8_SA(1, 1), a1 + hstep, voffA);
            PG8_WAIT_L(8); PG8_BAR; PG8_WAIT_L(0); PG8_MMA(0, 0, At, B0); PG8_BAR; PG8_SCHED;
            PG8_LDB(B1, 0, 1); PG8_STAGE(PG8_SB(0, 0), b2, voffB);
            PG8_BAR; PG8_WAIT_L(0); PG8_MMA(0, 1, At, B1); PG8_BAR;
            PG8_LDA(At, 0, 1); PG8_STAGE(PG8_SA(0, 0), a2, voffA);
            PG8_BAR; PG8_WAIT_L(0); PG8_MMA(1, 0, At, B0); PG8_BAR; PG8_SCHED;
            PG8_STAGE(PG8_SB(0, 1), b2 + hstep, voffB);
            PG8_WAIT_V(6); PG8_BAR; PG8_MMA(1, 1, At, B1); PG8_BAR;
            PG8_LDB(B0, 1, 0); PG8_SCHED; PG8_LDA(At, 1, 0); PG8_STAGE(PG8_SA(0, 1), a2 + hstep, voffA);
            PG8_WAIT_L(8); PG8_BAR; PG8_WAIT_L(0); PG8_MMA(0, 0, At, B0); PG8_BAR; PG8_SCHED;
            PG8_LDB(B1, 1, 1); PG8_STAGE(PG8_SB(1, 0), b3, voffB);
            PG8_BAR; PG8_WAIT_L(0); PG8_MMA(0, 1, At, B1); PG8_BAR;
            PG8_LDA(At, 1, 1); PG8_STAGE(PG8_SA(1, 0), a3, voffA);
            PG8_BAR; PG8_WAIT_L(0); PG8_MMA(1, 0, At, B0); PG8_BAR; PG8_SCHED;
            PG8_STAGE(PG8_SB(1, 1), b3 + hstep, voffB);
            PG8_WAIT_V(6); PG8_BAR; PG8_MMA(1, 1, At, B1); PG8_BAR;
        }
        PG8_STAMP();
        if constexpr (!Epi::AFTER_DRAIN) { E(acc, cur, wr, wc, fr, fq); S.done(cur); }
        PG8_STAMP();
        if (!has_next) break;
#pragma unroll
        for (int a = 0; a < 2; ++a)
#pragma unroll
            for (int b = 0; b < 2; ++b)
#pragma unroll
                for (int m = 0; m < 4; ++m)
#pragma unroll
                    for (int n = 0; n < 2; ++n) acc[a][b][m][n] = (f32x4){0.f, 0.f, 0.f, 0.f};
        cur = nxt; cA = nA; cB = nB; ++ui;
    }
    PG8_WAIT_V(0);
    if (wr == 0) PG8_BAR;
    PG8_BAR;
    if constexpr (Epi::AFTER_DRAIN) { E.fused(acc, cur, wr, wc, fr, fq, lds, wid, lane); S.done(cur); }
    PG8_STAMP();
    if (STAMP && wid == 0) { stamps[lane] = lane < nts ? (((unsigned long long)(unsigned)ts_hi << 32) | (unsigned)ts_lo) : 0ull;
        if (lane == 62) stamps[62] = rt_entry; if (lane == 63) stamps[63] = (unsigned long long)wall_clock64(); }
#undef PG8_STAMP
#undef PG8_SA
#undef PG8_SB
#undef PG8_STAGE
#undef PG8_LDA
#undef PG8_LDB
#undef PG8_MMA
#undef PG8_WAIT_V
#undef PG8_WAIT_L
#undef PG8_BAR
#undef PG8_SCHED
}
}
#define XB_TMO      128
#define XB_XCNT(j)  (256  + 64 * (j))
#define XB_XSUB(j)  (1280 + 64 * (j))
#define XB_XGEN(j)  (2304 + 64 * (j))
#define XB_TOP      3328
#define XB_TOPGEN   3392
#define XCD_BAR_WORDS 3456
#define XB_SPIN_CAP (1u << 18)
#define XLAS __attribute__((address_space(3)))

__device__ __forceinline__ unsigned xb_ld(unsigned* p)              { return __hip_atomic_load(p, __ATOMIC_RELAXED, __HIP_MEMORY_SCOPE_AGENT); }
__device__ __forceinline__ unsigned xb_add(unsigned* p, unsigned v) { return __hip_atomic_fetch_add(p, v, __ATOMIC_RELAXED, __HIP_MEMORY_SCOPE_AGENT); }
__device__ __forceinline__ unsigned xb_xcc_id() { return (unsigned)__builtin_amdgcn_s_getreg((3 << 11) | 20) & 0xFu; }
#define XB_SPIN(cond, bar) do { unsigned _sp = 0; while (cond) { __builtin_amdgcn_s_sleep(1); \
    if ((++_sp & 255u) == 0u) { if (xb_ld(&(bar)[XB_TMO])) break; if (_sp > XB_SPIN_CAP) { atomicAdd(&(bar)[XB_TMO], 1u); break; } } } } while (0)

struct XcdBarrier {
    unsigned* bar; unsigned x;
    volatile XLAS unsigned* st;
};

__device__ __forceinline__ XcdBarrier xcd_barrier_post(unsigned* bar, volatile XLAS unsigned* st) {
    XcdBarrier b; b.bar = bar; b.x = xb_xcc_id(); b.st = st;
    if (threadIdx.x == 0) (void)xb_add(&bar[XB_XCNT(b.x)], 1u);
    return b;
}
__device__ __forceinline__ void xcd_barrier_complete(unsigned* bar, unsigned x, unsigned& nloc, unsigned& nx) {
    const unsigned G = gridDim.x * gridDim.y * gridDim.z;
    unsigned sum, cnt, mine, sp = 0u;
    for (;;) {
        sum = 0u; cnt = 0u; mine = 0u;
#pragma unroll
        for (unsigned j = 0; j < 16; ++j) { const unsigned c = xb_ld(&bar[XB_XCNT(j)]); sum += c; cnt += (c > 0u) ? 1u : 0u; mine = (j == x) ? c : mine; }
        if (sum == G) break;
        __builtin_amdgcn_s_sleep(1);
        if ((++sp & 255u) == 0u) { if (xb_ld(&bar[XB_TMO])) break; if (sp > XB_SPIN_CAP) { atomicAdd(&bar[XB_TMO], 1u); break; } }
    }
    nloc = mine > 0u ? mine : 1u; nx = cnt > 0u ? cnt : 1u;
}

__device__ __forceinline__ void xcd_barrier(const XcdBarrier& b) {
    asm volatile("s_waitcnt vmcnt(0)" ::: "memory");
    __syncthreads();
    if (threadIdx.x == 0) {
        unsigned* bar = b.bar;
        __builtin_amdgcn_s_waitcnt(0);
        unsigned nloc = b.st[0], nx = b.st[1];
        if (nloc == 0u) { xcd_barrier_complete(bar, b.x, nloc, nx); b.st[0] = nloc; b.st[1] = nx; }
        const unsigned old = xb_add(&bar[XB_XSUB(b.x)], 1u);
        const unsigned gen = old / nloc;
        if (old + 1u == (gen + 1u) * nloc) {
            __builtin_amdgcn_fence(__ATOMIC_RELEASE, "agent");
            asm volatile("s_waitcnt vmcnt(0)" ::: "memory");
            const unsigned og = xb_add(&bar[XB_TOP], 1u);
            const unsigned tg = og / nx;
            if (og + 1u == (tg + 1u) * nx) xb_add(&bar[XB_TOPGEN], 1u);
            else XB_SPIN(xb_ld(&bar[XB_TOPGEN]) == tg, bar);
            __builtin_amdgcn_fence(__ATOMIC_ACQUIRE, "agent");
            xb_add(&bar[XB_XGEN(b.x)], 1u);
            asm volatile("s_waitcnt vmcnt(0)" ::: "memory");
        } else {
            XB_SPIN(xb_ld(&bar[XB_XGEN(b.x)]) == gen, bar);
            __builtin_amdgcn_fence(__ATOMIC_ACQUIRE, "agent");
            asm volatile("s_waitcnt vmcnt(0)" ::: "memory");
        }
    }
    __syncthreads();
}


using pg8::bf16_t; using pg8::f32x4; using pg8::pk2bf; using pg8::bflo; using pg8::bfhi; using pg8::siluf; using pg8::sigmf; using pg8::u32x2;
using pg8::NTOK; using pg8::DM; using pg8::FFH; using pg8::NMOD;
typedef unsigned v4u __attribute__((ext_vector_type(4)));
#define LDS_WAIT() asm volatile("s_waitcnt lgkmcnt(0)" ::: "memory")
constexpr int NCTX = 4096, NWAVES = 8, LDS_BYTES = 139264;
constexpr size_t MiB = 1048576;
constexpr size_t OFF_WCO = 0, OFF_WDNO = 2 * MiB, OFF_WO = 4 * MiB;
constexpr size_t OFF_WGU = 6 * MiB;
constexpr size_t OFF_WD = 17 * MiB;
constexpr size_t OFF_WIN = 23 * MiB;
constexpr size_t OFF_X0 = 42 * MiB;
constexpr size_t OFF_DN = 6 * MiB;
constexpr size_t OFF_X1 = 114 * MiB;
constexpr size_t OFF_PROJ = 138 * MiB;
constexpr size_t OFF_EX = 246 * MiB;
constexpr size_t OFF_MOD = 247 * MiB;
constexpr size_t OFF_BAR = 247 * MiB + 512 * 1024;
constexpr size_t WS_NEED = 248 * MiB;
constexpr size_t BLK = (size_t)NTOK * DM;

struct Params {
    const float *x_prompt, *x_sample, *st_f, *st_b, *c, *c_ctx, *ada_w, *ada_b, *norm_ffn1, *f1g, *f1u, *f1d, *norm_mix, *w_in, *conv_w, *conv_out_w,
        *dn_conv_w, *dn_a_log, *dn_dt_bias, *dn_norm_w, *dn_out_w, *w_o, *norm_ffn2, *f2g, *f2u, *f2d, *norm_f;
    float* out; unsigned char* ws; int rep_prep, rep_gemm, rep_dnpre, rep_scan, rep_thin, rep_sync;
};

__device__ __forceinline__ float wave_sum(float v) {
#pragma unroll
    for (int o = 1; o < 64; o <<= 1) v += __shfl_xor(v, o);
    return v;
}
__device__ __forceinline__ float sum16(float v) {
#pragma unroll
    for (int o = 1; o < 16; o <<= 1) v += __shfl_xor(v, o);
    return v;
}
__device__ __forceinline__ void transpose_item(const float* W, int N, int k0, int n0, bf16_t* WT, int Kd, int dst_row0, float* scr, int lane) {
#pragma unroll 8
    for (int i = 0; i < 32; ++i) { const int kk = 2 * i + (lane >> 5); scr[kk * 33 + (lane & 31)] = W[(size_t)(k0 + kk) * N + n0 + (lane & 31)]; }
    LDS_WAIT();
    const int c = lane & 7;
#pragma unroll
    for (int j = 0; j < 4; ++j) { const int n = (lane >> 3) + 8 * j; const float* s = scr + (8 * c) * 33 + n;
        v4u o; o.x = pk2bf(s[0 * 33], s[1 * 33]); o.y = pk2bf(s[2 * 33], s[3 * 33]); o.z = pk2bf(s[4 * 33], s[5 * 33]); o.w = pk2bf(s[6 * 33], s[7 * 33]);
        *(v4u*)(WT + (size_t)(dst_row0 + n) * Kd + k0 + 8 * c) = o; }
    LDS_WAIT();
}
__device__ __forceinline__ void transpose_matrix(const float* W, int K, int N, bf16_t* WT, int mode, int gw, int ngw, float* scr, int lane) {
    const int nblk = N / 32, nitems = (K / 64) * nblk;
    for (int it = gw; it < nitems; it += ngw) {
        const int kb = it / nblk, nb = it % nblk, n0 = nb * 32;
        const int dr = mode == 0 ? n0 : ((n0 >> 7) * 256 + (n0 & 127) + (mode == 2 ? 128 : 0));
        transpose_item(W, N, kb * 64, n0, WT, K, dr, scr, lane);
    }
}

__device__ __forceinline__ void phase_prep(const Params& p, unsigned char* lds, int wave, int lane) {
    unsigned char* ws = p.ws;
    float* scr = (float*)lds + wave * (64 * 33);
    const int gw = wave * gridDim.x + blockIdx.x, ngw = gridDim.x * NWAVES;
    transpose_matrix(p.w_in, 1024, 9248, (bf16_t*)(ws + OFF_WIN), 0, gw, ngw, scr, lane);
    transpose_matrix(p.f1g, 1024, FFH, (bf16_t*)(ws + OFF_WGU), 1, gw, ngw, scr, lane);
    transpose_matrix(p.f1u, 1024, FFH, (bf16_t*)(ws + OFF_WGU), 2, gw, ngw, scr, lane);
    transpose_matrix(p.f1d, FFH, 1024, (bf16_t*)(ws + OFF_WD), 0, gw, ngw, scr, lane);
    transpose_matrix(p.conv_out_w, 1024, 1024, (bf16_t*)(ws + OFF_WCO), 0, gw, ngw, scr, lane);
    transpose_matrix(p.dn_out_w, 1024, 1024, (bf16_t*)(ws + OFF_WDNO), 0, gw, ngw, scr, lane);
    transpose_matrix(p.w_o, 1024, 1024, (bf16_t*)(ws + OFF_WO), 0, gw, ngw, scr, lane);
    {
        v4u z = {0u, 0u, 0u, 0u}; v4u* zp = (v4u*)((bf16_t*)(ws + OFF_WIN) + (size_t)9248 * 1024);
        const int nz = 224 * 1024 * 2 / 16;
        for (int i = blockIdx.x * 512 + threadIdx.x; i < nz; i += gridDim.x * 512) zp[i] = z;
    }
    __syncthreads();
    float* sc = (float*)lds;
    float* red = (float*)lds + 3072;
    if ((int)blockIdx.x < 144) {
        for (int i = threadIdx.x; i < 3072; i += 512) { const int cc = i >> 10, k = i & 1023; const float v = cc == 0 ? p.c_ctx[k] : p.c[(cc - 1) * 1024 + k]; sc[i] = siluf(v); }
        __syncthreads();
        for (int it = blockIdx.x; it < 144; it += gridDim.x) {
            const int n = it * 64 + lane; float a0 = 0.f, a1 = 0.f, a2 = 0.f;
            const float* wp = p.ada_w + (size_t)(wave * 128) * NMOD + n;
#pragma unroll 8
            for (int k = 0; k < 128; ++k) { const float wv = wp[(size_t)k * NMOD]; const int kk = wave * 128 + k; a0 += sc[kk] * wv; a1 += sc[1024 + kk] * wv; a2 += sc[2048 + kk] * wv; }
            red[(wave * 3 + 0) * 64 + lane] = a0; red[(wave * 3 + 1) * 64 + lane] = a1; red[(wave * 3 + 2) * 64 + lane] = a2;
            __syncthreads();
            if (threadIdx.x < 192) { const int cc = threadIdx.x >> 6, l = threadIdx.x & 63; float s = 0.f;
#pragma unroll
                for (int w = 0; w < 8; ++w) s += red[(w * 3 + cc) * 64 + l];
                ((float*)(ws + OFF_MOD))[cc * NMOD + it * 64 + l] = s + p.ada_b[it * 64 + l]; }
            __syncthreads();
        }
    }
}

template <bool FIRST> __device__ __forceinline__ void phase_norm(const Params& p, const float* X, float* X0, const float* nw, int modi, bf16_t* A, int wave, int lane) {
    const float* mod = (const float*)(p.ws + OFF_MOD);
    const int gw = wave * gridDim.x + blockIdx.x, ngw = gridDim.x * NWAVES;
    for (int row = gw; row < NTOK; row += ngw) {
        const int cond = row < NCTX ? 0 : 1 + ((row - NCTX) >> 10);
        f32x4 v[4];
        if (FIRST) {
            const float* src = row < NCTX ? p.x_prompt + (size_t)row * DM : p.x_sample + (size_t)(row - NCTX) * DM;
#pragma unroll
            for (int j = 0; j < 4; ++j) v[j] = *(const f32x4*)(src + 4 * lane + 256 * j);
            if (row >= NCTX) {
                const int t = (row - NCTX) & 1023; const float r = (float)(t >> 6), cl = (float)(t & 63);
#pragma unroll
                for (int e = 0; e < 4; ++e) { const int i = 4 * lane + e; const float om = 1.0f / powf(10000.0f, (float)i * (1.0f / 256.0f));
                    v[0][e] += sinf(r * om); v[1][e] += cosf(r * om); v[2][e] += sinf(cl * om); v[3][e] += cosf(cl * om); }
            }
#pragma unroll
            for (int j = 0; j < 4; ++j) *(f32x4*)(X0 + (size_t)row * DM + 4 * lane + 256 * j) = v[j];
        } else {
#pragma unroll
            for (int j = 0; j < 4; ++j) v[j] = *(const f32x4*)(X + (size_t)row * DM + 4 * lane + 256 * j);
        }
        float ss = 0.f;
#pragma unroll
        for (int j = 0; j < 4; ++j) ss += v[j][0] * v[j][0] + v[j][1] * v[j][1] + v[j][2] * v[j][2] + v[j][3] * v[j][3];
        const float rstd = rsqrtf(wave_sum(ss) * (1.0f / 1024.0f) + 1e-6f);
        const float* sh = mod + (size_t)cond * NMOD + modi * 1024; const float* scp = sh + 1024;
#pragma unroll
        for (int j = 0; j < 4; ++j) { const int d = 4 * lane + 256 * j; const f32x4 w = *(const f32x4*)(nw + d), s1 = *(const f32x4*)(scp + d), s0 = *(const f32x4*)(sh + d);
            f32x4 y;
#pragma unroll
            for (int e = 0; e < 4; ++e) y[e] = v[j][e] * rstd * w[e] * (1.f + s1[e]) + s0[e];
            u32x2 o; o.x = pk2bf(y[0], y[1]); o.y = pk2bf(y[2], y[3]); *(u32x2*)(A + (size_t)row * DM + d) = o; }
    }
}
__device__ __forceinline__ void phase_final_norm(const Params& p, float* Y, int wave, int lane) {
    const int gw = wave * gridDim.x + blockIdx.x, ngw = gridDim.x * NWAVES;
    for (int row = gw; row < NTOK; row += ngw) {
        f32x4 v[4]; float ss = 0.f;
#pragma unroll
        for (int j = 0; j < 4; ++j) { v[j] = *(const f32x4*)(Y + (size_t)row * DM + 4 * lane + 256 * j); ss += v[j][0] * v[j][0] + v[j][1] * v[j][1] + v[j][2] * v[j][2] + v[j][3] * v[j][3]; }
        const float rstd = rsqrtf(wave_sum(ss) * (1.0f / 1024.0f) + 1e-6f);
#pragma unroll
        for (int j = 0; j < 4; ++j) { const f32x4 w = *(const f32x4*)(p.norm_f + 4 * lane + 256 * j); *(f32x4*)(Y + (size_t)row * DM + 4 * lane + 256 * j) = v[j] * rstd * w; }
    }
}

__device__ __forceinline__ void unpack8(const v4u r, float (&f)[8]) { f[0] = bflo(r.x); f[1] = bfhi(r.x); f[2] = bflo(r.y); f[3] = bfhi(r.y); f[4] = bflo(r.z); f[5] = bfhi(r.z); f[6] = bflo(r.w); f[7] = bfhi(r.w); }
__device__ __forceinline__ void load8f(const float* p, float (&f)[8]) { const f32x4 a = *(const f32x4*)p, b = *(const f32x4*)(p + 4); f[0] = a[0]; f[1] = a[1]; f[2] = a[2]; f[3] = a[3]; f[4] = b[0]; f[5] = b[1]; f[6] = b[2]; f[7] = b[3]; }
__device__ __forceinline__ void phase_qkv_naive(const Params& p, const bf16_t* PROJ, const float* EX, float* QF, float* KF, float* VF, float* BG, bf16_t* YA, int wave, int lane) {
    const int gw = wave * gridDim.x + blockIdx.x, ngw = gridDim.x * NWAVES;
    const v4u zero4 = {0u, 0u, 0u, 0u};
    for (int tok = gw; tok < NTOK; tok += ngw) {
        const int pos = tok < NCTX ? (tok & 255) : ((tok - NCTX) & 63); const int L = tok < NCTX ? 256 : 64;
        const bool hasL = pos != 0, hasR = pos != L - 1;
#pragma unroll 1
        for (int grp = 0; grp < 6; ++grp) {
            const int part = grp >> 1, ch0 = (grp & 1) * 512 + lane * 8;
            const bf16_t* src = PROJ + (size_t)(3 + part) * BLK + (size_t)tok * DM + ch0;
            float c[8], l[8], r[8], w0[8], w1[8], w2[8], y[8];
            unpack8(*(const v4u*)src, c); unpack8(hasL ? *(const v4u*)(src - DM) : zero4, l); unpack8(hasR ? *(const v4u*)(src + DM) : zero4, r);
            const float* cw = p.dn_conv_w + part * 1024 + ch0;
            load8f(cw, w0); load8f(cw + 3072, w1); load8f(cw + 6144, w2);
            float ss = 0.f;
#pragma unroll
            for (int e = 0; e < 8; ++e) { y[e] = siluf(w0[e] * l[e] + w1[e] * c[e] + w2[e] * r[e]); ss += y[e] * y[e]; }
            if (part < 2) { const float sc = rsqrtf(sum16(ss) + 1e-6f) * (part == 0 ? 0.08838834764831845f : 1.0f);
#pragma unroll
                for (int e = 0; e < 8; ++e) y[e] *= sc; }
            float* dst = (part == 0 ? QF : part == 1 ? KF : VF) + (size_t)tok * DM + ch0;
            f32x4 o0 = {y[0], y[1], y[2], y[3]}, o1 = {y[4], y[5], y[6], y[7]};
            *(f32x4*)dst = o0; *(f32x4*)(dst + 4) = o1;
        }
#pragma unroll 1
        for (int grp = 0; grp < 2; ++grp) {
            const int ch0 = grp * 512 + lane * 8; const size_t o = (size_t)tok * DM + ch0;
            float bg[8], cc[8], cl[8], cr[8], xc[8], xl[8], xr[8], w0[8], w1[8], w2[8];
            unpack8(*(const v4u*)(PROJ + o), bg);
            unpack8(*(const v4u*)(PROJ + BLK + o), cc); unpack8(hasL ? *(const v4u*)(PROJ + BLK + o - DM) : zero4, cl); unpack8(hasR ? *(const v4u*)(PROJ + BLK + o + DM) : zero4, cr);
            unpack8(*(const v4u*)(PROJ + 2 * BLK + o), xc); unpack8(hasL ? *(const v4u*)(PROJ + 2 * BLK + o - DM) : zero4, xl); unpack8(hasR ? *(const v4u*)(PROJ + 2 * BLK + o + DM) : zero4, xr);
            load8f(p.conv_w + ch0, w0); load8f(p.conv_w + 1024 + ch0, w1); load8f(p.conv_w + 2048 + ch0, w2);
            float y[8];
#pragma unroll
            for (int e = 0; e < 8; ++e) y[e] = bg[e] * (w0[e] * cl[e] * xl[e] + w1[e] * cc[e] * xc[e] + w2[e] * cr[e] * xr[e]);
            v4u ov; ov.x = pk2bf(y[0], y[1]); ov.y = pk2bf(y[2], y[3]); ov.z = pk2bf(y[4], y[5]); ov.w = pk2bf(y[6], y[7]);
            *(v4u*)(YA + o) = ov;
        }
        if (lane < 16) {
            const float b_raw = EX[(size_t)tok * 32 + lane], a_raw = EX[(size_t)tok * 32 + 16 + lane];
            const float xx = a_raw + p.dn_dt_bias[lane]; const float sp = xx > 20.f ? xx : log1pf(expf(xx));
            BG[(size_t)tok * 32 + lane] = 1.f / (1.f + expf(-b_raw));
            BG[(size_t)tok * 32 + 16 + lane] = -expf(p.dn_a_log[lane]) * sp;
        }
    }
}

__device__ __forceinline__ void dn_naive_item(const Params& p, const float* QF, const float* KF, const float* VF, const float* BG, float* OF, float* OBk, float* lds, int item) {
    const bool lat = item < 32; const int j = lat ? item : item - 32; const int b = j >> 4, h = (j >> 1) & 7, dir = j & 1;
    const int T = lat ? 1024 : 256; const int tok0 = lat ? NCTX + b * 1024 : b * 256;
    const int tid = threadIdx.x, v = tid & 127, kq = tid >> 7;
    float* qs = lds; float* ks = lds + 128; float* vs = lds + 256; float* gb = lds + 384; float* red = lds + 512; float* red2 = lds + 1024;
    float S[32];
    if (lat) { const float* s0 = (dir ? p.st_b : p.st_f) + ((size_t)(b * 8 + h) * 128) * 128;
#pragma unroll
        for (int i = 0; i < 32; ++i) S[i] = s0[(size_t)(kq * 32 + i) * 128 + v]; }
    else {
#pragma unroll
        for (int i = 0; i < 32; ++i) S[i] = 0.f; }
    float* Od = dir ? OBk : OF;
    for (int t = 0; t < T; ++t) {
        const int tok = tok0 + (dir ? T - 1 - t : t);
        __syncthreads();
        if (tid < 128) qs[tid] = QF[(size_t)tok * DM + h * 128 + tid];
        else if (tid < 256) ks[tid - 128] = KF[(size_t)tok * DM + h * 128 + tid - 128];
        else if (tid < 384) vs[tid - 256] = VF[(size_t)tok * DM + h * 128 + tid - 256];
        else if (tid == 384) gb[0] = BG[(size_t)tok * 32 + dir * 8 + h];
        else if (tid == 385) gb[1] = BG[(size_t)tok * 32 + 16 + dir * 8 + h];
        __syncthreads();
        float part = 0.f;
#pragma unroll
        for (int i = 0; i < 32; ++i) part += ks[kq * 32 + i] * S[i];
        red[kq * 128 + v] = part;
        __syncthreads();
        const float kS = red[v] + red[128 + v] + red[256 + v] + red[384 + v];
        const float eg = expf(gb[1]), beta = gb[0];
        const float delta = beta * (vs[v] - eg * kS);
        float op = 0.f;
#pragma unroll
        for (int i = 0; i < 32; ++i) { S[i] = eg * S[i] + ks[kq * 32 + i] * delta; op += qs[kq * 32 + i] * S[i]; }
        red2[kq * 128 + v] = op;
        __syncthreads();
        if (kq == 0) Od[(size_t)tok * DM + h * 128 + v] = red2[v] + red2[128 + v] + red2[256 + v] + red2[384 + v];
    }
    if (!lat) { float* so = p.out + (size_t)NTOK * DM + (size_t)dir * (16 * 8 * 128 * 128) + ((size_t)(b * 8 + h) * 128) * 128;
#pragma unroll
        for (int i = 0; i < 32; ++i) so[(size_t)(kq * 32 + i) * 128 + v] = S[i]; }
}
__device__ __forceinline__ void phase_dn_naive(const Params& p, const float* QF, const float* KF, const float* VF, const float* BG, float* OF, float* OBk, float* lds) {
    const int bx = blockIdx.x;
    if (gridDim.x >= 256) {
        if (bx < 32) dn_naive_item(p, QF, KF, VF, BG, OF, OBk, lds, bx);
        else if (bx < 256) { dn_naive_item(p, QF, KF, VF, BG, OF, OBk, lds, bx); if (bx < 64) dn_naive_item(p, QF, KF, VF, BG, OF, OBk, lds, 224 + bx); }
    } else { for (int it = bx; it < 288; it += gridDim.x) dn_naive_item(p, QF, KF, VF, BG, OF, OBk, lds, it); }
}

typedef short bf16x8 __attribute__((ext_vector_type(8)));
typedef float f32x16 __attribute__((ext_vector_type(16)));
#define MFMA32(a, b, c) __builtin_amdgcn_mfma_f32_32x32x16_bf16((a), (b), (c), 0, 0, 0)
constexpr int DN_ITEM_BYTES = 73728, DN_W = 0, DN_QD = 16384, DN_KD = 32768, DN_A = 49152, DN_U = 57344;
constexpr int LS = 132;
constexpr int L_QF = 0, L_KF = 33792, L_VF = 67584, L_LM = 101376, L_CO = 134144;
__device__ __forceinline__ int crow16(int i, int hh) { return (i & 3) + 8 * (i >> 2) + 4 * hh; }
__device__ __forceinline__ bf16x8 frag_from_f32(const float* p) { const f32x4 a = *(const f32x4*)p, b = *(const f32x4*)(p + 4);
    v4u r; r.x = pk2bf(a[0], a[1]); r.y = pk2bf(a[2], a[3]); r.z = pk2bf(b[0], b[1]); r.w = pk2bf(b[2], b[3]); return __builtin_bit_cast(bf16x8, r); }
template <int S> __device__ __forceinline__ bf16x8 pack_step(const f32x16& x) {
    v4u r; r.x = pk2bf(x[8 * S + 0], x[8 * S + 1]); r.y = pk2bf(x[8 * S + 2], x[8 * S + 3]); r.z = pk2bf(x[8 * S + 4], x[8 * S + 5]); r.w = pk2bf(x[8 * S + 6], x[8 * S + 7]); return __builtin_bit_cast(bf16x8, r); }

__device__ __forceinline__ void dn_pre_item(const Params& p, const bf16_t* PROJ, const float* EX, unsigned char* DN, float* GL, unsigned char* lds, int sc, int h) {
    const int tid = threadIdx.x, lane = tid & 63, wave = tid >> 6;
    const bool ctx = sc < 64; const int nn = ctx ? (sc & 3) : ((sc - 64) & 15);
    const int tok0 = ctx ? (sc >> 2) * 256 + 64 * nn : NCTX + ((sc - 64) >> 4) * 1024 + 64 * nn;
    float* QFl = (float*)(lds + L_QF); float* KFl = (float*)(lds + L_KF); float* VFl = (float*)(lds + L_VF); float* LM = (float*)(lds + L_LM);
    float* CB = (float*)(lds + L_CO);
    float* CG = CB + 128;
    float* CW = CB + 256;
    float* CE = CB + 384;
    float* CK = CB + 512;
    const v4u zero4 = {0u, 0u, 0u, 0u};
#pragma unroll 1
    for (int jj = 0; jj < 6; ++jj) {
        const int pr = tid + 512 * jj, c = pr / 48, cg = pr % 48, part = cg >> 4, d0 = (cg & 15) * 8;
        const bool hasL = c > 0 || (ctx && nn > 0), hasR = c < 63 || (ctx && nn < 3);
        const bf16_t* src = PROJ + (size_t)(3 + part) * BLK + (size_t)(tok0 + c) * DM + h * 128 + d0;
        float cc[8], l[8], r[8], w0[8], w1[8], w2[8], y[8];
        unpack8(*(const v4u*)src, cc); unpack8(hasL ? *(const v4u*)(src - DM) : zero4, l); unpack8(hasR ? *(const v4u*)(src + DM) : zero4, r);
        const float* cw = p.dn_conv_w + part * 1024 + h * 128 + d0;
        load8f(cw, w0); load8f(cw + 3072, w1); load8f(cw + 6144, w2);
        float ss = 0.f;
#pragma unroll
        for (int e = 0; e < 8; ++e) { y[e] = siluf(w0[e] * l[e] + w1[e] * cc[e] + w2[e] * r[e]); ss += y[e] * y[e]; }
        const float tot = sum16(ss);
        if (part < 2) { const float scl = rsqrtf(tot + 1e-6f) * (part == 0 ? 0.08838834764831845f : 1.0f);
#pragma unroll
            for (int e = 0; e < 8; ++e) y[e] *= scl; }
        float* dst = (part == 0 ? QFl : part == 1 ? KFl : VFl) + c * LS + d0;
        f32x4 o0 = {y[0], y[1], y[2], y[3]}, o1 = {y[4], y[5], y[6], y[7]};
        *(f32x4*)dst = o0; *(f32x4*)(dst + 4) = o1;
    }
    if (wave < 2) {
        const int d = wave, oc = d ? 63 - lane : lane; const size_t tk = (size_t)(tok0 + oc) * 32;
        const float b_raw = EX[tk + d * 8 + h], a_raw = EX[tk + 16 + d * 8 + h];
        const float xx = a_raw + p.dn_dt_bias[d * 8 + h]; const float sp = xx > 20.f ? xx : log1pf(expf(xx));
        const float beta = 1.f / (1.f + expf(-b_raw)); float g = -expf(p.dn_a_log[d * 8 + h]) * sp;
#pragma unroll
        for (int o = 1; o < 64; o <<= 1) { const float t = __shfl_up(g, o); if (lane >= o) g += t; }
        const float glast = __shfl(g, 63); const float eg = expf(g);
        CB[d * 64 + lane] = beta; CG[d * 64 + lane] = g; CW[d * 64 + lane] = beta * eg; CE[d * 64 + lane] = eg; CK[d * 64 + lane] = expf(glast - g);
        if (lane == 0) GL[(sc * 8 + h) * 2 + d] = expf(glast);
    }
    __syncthreads();
    const int dir = wave >> 2;
    unsigned char* item = DN + (size_t)((sc * 8 + h) * 2 + dir) * DN_ITEM_BYTES;
    {
        const int w4 = wave & 3, mt = w4 >> 1, nt = w4 & 1, r = lane & 31, hh = lane >> 5;
        const int ia = 32 * mt + r, ib = 32 * nt + r; const int ca = dir ? 63 - ia : ia, cb = dir ? 63 - ib : ib;
        f32x16 kk, pp;
#pragma unroll
        for (int i = 0; i < 16; ++i) { kk[i] = 0.f; pp[i] = 0.f; }
#pragma unroll
        for (int ks = 0; ks < 8; ++ks) {
            const bf16x8 ka = frag_from_f32(KFl + ca * LS + 16 * ks + 8 * hh), kb = frag_from_f32(KFl + cb * LS + 16 * ks + 8 * hh), qb = frag_from_f32(QFl + cb * LS + 16 * ks + 8 * hh);
            kk = MFMA32(ka, kb, kk); pp = MFMA32(ka, qb, pp);
        }
        const float* gcd = CG + dir * 64; const float* btd = CB + dir * 64;
        const float g_col = gcd[ib];
        f32x16 pv;
#pragma unroll
        for (int i = 0; i < 16; ++i) {
            const int row = 32 * mt + crow16(i, hh); const float g_row = gcd[row];
            LM[dir * 4096 + row * 64 + ib] = (ib < row) ? btd[row] * kk[i] * expf(g_row - g_col) : 0.f;
            pv[i] = (row <= ib) ? pp[i] * expf(g_col - g_row) : 0.f;
        }
        v4u* af = (v4u*)(item + DN_A);
        af[(nt * 4 + mt * 2 + 0) * 64 + lane] = __builtin_bit_cast(v4u, pack_step<0>(pv));
        af[(nt * 4 + mt * 2 + 1) * 64 + lane] = __builtin_bit_cast(v4u, pack_step<1>(pv));
    }
    __syncthreads();
    const int col = tid & 255, cc = col & 127; const bool isw = col >= 128;
    float x[64];
    {
        const float* srcm = isw ? KFl : VFl; const float* coef = (isw ? CW : CB) + dir * 64; const float* Lm = LM + dir * 4096;
#pragma unroll
        for (int c = 0; c < 64; ++c) {
            const int oc = dir ? 63 - c : c;
            float acc = srcm[oc * LS + cc] * coef[c];
#pragma unroll
            for (int s = 0; s < c; ++s) acc -= Lm[c * 64 + s] * x[s];
            x[c] = acc;
        }
        if (!isw) {
            const int jj = cc >> 5, n = cc & 31;
#pragma unroll
            for (int mt = 0; mt < 2; ++mt)
#pragma unroll
                for (int hh = 0; hh < 2; ++hh) {
                    v4u lo, hi;
                    lo.x = pk2bf(x[32 * mt + 4 * hh + 0], x[32 * mt + 4 * hh + 1]); lo.y = pk2bf(x[32 * mt + 4 * hh + 2], x[32 * mt + 4 * hh + 3]);
                    lo.z = pk2bf(x[32 * mt + 4 * hh + 8], x[32 * mt + 4 * hh + 9]); lo.w = pk2bf(x[32 * mt + 4 * hh + 10], x[32 * mt + 4 * hh + 11]);
                    hi.x = pk2bf(x[32 * mt + 4 * hh + 16], x[32 * mt + 4 * hh + 17]); hi.y = pk2bf(x[32 * mt + 4 * hh + 18], x[32 * mt + 4 * hh + 19]);
                    hi.z = pk2bf(x[32 * mt + 4 * hh + 24], x[32 * mt + 4 * hh + 25]); hi.w = pk2bf(x[32 * mt + 4 * hh + 26], x[32 * mt + 4 * hh + 27]);
                    v4u* dst = (v4u*)(item + DN_U + (size_t)(((jj * 2 + mt) * 64 + hh * 32 + n) * 32));
                    dst[0] = lo; dst[1] = hi;
                }
        }
    }
    __syncthreads();
    bf16_t* WL = (bf16_t*)(lds + L_VF);
    if (isw) {
#pragma unroll
        for (int c = 0; c < 64; ++c) WL[(dir * 64 + c) * LS + cc] = (bf16_t)(pk2bf(x[c], 0.f) & 0xffffu);
    }
    __syncthreads();
    {
        const int t = tid & 255; const float* ce = CE + dir * 64; const float* ck = CK + dir * 64;
#pragma unroll 1
        for (int q = 0; q < 4; ++q) {
            const int fl = t + 256 * q, f = fl >> 6, ln = fl & 63, r = ln & 31, hh = ln >> 5;
            {
                const int mt = f >> 3, ks8 = f & 7, cp = 32 * mt + r, oc = dir ? 63 - cp : cp, dkb = 16 * ks8 + 4 * hh;
                const u32x2 lo = *(const u32x2*)(WL + (dir * 64 + cp) * LS + dkb), hi = *(const u32x2*)(WL + (dir * 64 + cp) * LS + dkb + 8);
                v4u wv; wv.x = lo.x; wv.y = lo.y; wv.z = hi.x; wv.w = hi.y;
                ((v4u*)(item + DN_W))[f * 64 + ln] = wv;
                const f32x4 qa = *(const f32x4*)(QFl + oc * LS + dkb), qb = *(const f32x4*)(QFl + oc * LS + dkb + 8); const float e = ce[cp];
                v4u qv; qv.x = pk2bf(qa[0] * e, qa[1] * e); qv.y = pk2bf(qa[2] * e, qa[3] * e); qv.z = pk2bf(qb[0] * e, qb[1] * e); qv.w = pk2bf(qb[2] * e, qb[3] * e);
                ((v4u*)(item + DN_QD))[f * 64 + ln] = qv;
            }
            {
                const int mtK = f >> 2, kst = f & 3, dk = 32 * mtK + r, sb = 16 * kst + 4 * hh;
                float kv[8];
#pragma unroll
                for (int j = 0; j < 8; ++j) { const int sp = sb + (j & 3) + 8 * (j >> 2); const int os = dir ? 63 - sp : sp; kv[j] = KFl[os * LS + dk] * ck[sp]; }
                v4u kq; kq.x = pk2bf(kv[0], kv[1]); kq.y = pk2bf(kv[2], kv[3]); kq.z = pk2bf(kv[4], kv[5]); kq.w = pk2bf(kv[6], kv[7]);
                ((v4u*)(item + DN_KD))[f * 64 + ln] = kq;
            }
        }
    }
    __syncthreads();
}

__device__ __forceinline__ void phase_branch_a(const Params& p, const bf16_t* PROJ, bf16_t* YA, int wave, int lane) {
    const int gw = wave * gridDim.x + blockIdx.x, ngw = gridDim.x * NWAVES;
    const v4u zero4 = {0u, 0u, 0u, 0u};
    for (int tok = gw; tok < NTOK; tok += ngw) {
        const int pos = tok < NCTX ? (tok & 255) : ((tok - NCTX) & 63); const int L = tok < NCTX ? 256 : 64;
        const bool hasL = pos != 0, hasR = pos != L - 1;
#pragma unroll 1
        for (int grp = 0; grp < 2; ++grp) {
            const int ch0 = grp * 512 + lane * 8; const size_t o = (size_t)tok * DM + ch0;
            float bg[8], cc[8], cl[8], cr[8], xc[8], xl[8], xr[8], w0[8], w1[8], w2[8];
            unpack8(*(const v4u*)(PROJ + o), bg);
            unpack8(*(const v4u*)(PROJ + BLK + o), cc); unpack8(hasL ? *(const v4u*)(PROJ + BLK + o - DM) : zero4, cl); unpack8(hasR ? *(const v4u*)(PROJ + BLK + o + DM) : zero4, cr);
            unpack8(*(const v4u*)(PROJ + 2 * BLK + o), xc); unpack8(hasL ? *(const v4u*)(PROJ + 2 * BLK + o - DM) : zero4, xl); unpack8(hasR ? *(const v4u*)(PROJ + 2 * BLK + o + DM) : zero4, xr);
            load8f(p.conv_w + ch0, w0); load8f(p.conv_w + 1024 + ch0, w1); load8f(p.conv_w + 2048 + ch0, w2);
            float y[8];
#pragma unroll
            for (int e = 0; e < 8; ++e) y[e] = bg[e] * (w0[e] * cl[e] * xl[e] + w1[e] * cc[e] * xc[e] + w2[e] * cr[e] * xr[e]);
            v4u ov; ov.x = pk2bf(y[0], y[1]); ov.y = pk2bf(y[2], y[3]); ov.z = pk2bf(y[4], y[5]); ov.w = pk2bf(y[6], y[7]);
            *(v4u*)(YA + o) = ov;
        }
    }
}

__device__ __forceinline__ void dn_scan_item(const Params& p, const unsigned char* DN, const float* GL, float* OF, float* OBk, int it, int lane) {
    const bool lat = it < 128; const int q = lat ? it : it - 128;
    const int jj = q & 3, dir = (q >> 2) & 1, h = (q >> 3) & 7, b = q >> 6;
    const int nch = lat ? 16 : 4, scb = lat ? 64 + 16 * b : 4 * b, tokb = lat ? NCTX + b * 1024 : b * 256;
    const int n = lane & 31, hh = lane >> 5;
    f32x16 S[4];
    if (lat) { const float* s0 = (dir ? p.st_b : p.st_f) + (size_t)(b * 8 + h) * 16384 + 32 * jj + n;
#pragma unroll
        for (int m = 0; m < 4; ++m)
#pragma unroll
            for (int i = 0; i < 16; ++i) S[m][i] = s0[(size_t)(32 * m + crow16(i, hh)) * 128]; }
    else {
#pragma unroll
        for (int m = 0; m < 4; ++m)
#pragma unroll
            for (int i = 0; i < 16; ++i) S[m][i] = 0.f; }
    float* Od = (dir ? OBk : OF) + h * 128 + 32 * jj + n;
#pragma unroll 1
    for (int ci = 0; ci < nch; ++ci) {
        const int no = dir ? nch - 1 - ci : ci; const int id = ((scb + no) * 8 + h) * 2 + dir;
        const unsigned char* item = DN + (size_t)id * DN_ITEM_BYTES;
        const v4u* Wf = (const v4u*)(item + DN_W) + lane; const v4u* Qf = (const v4u*)(item + DN_QD) + lane; const v4u* Kf = (const v4u*)(item + DN_KD) + lane; const v4u* Af = (const v4u*)(item + DN_A) + lane;
        const float gl = GL[id];
        bf16x8 Sb[8];
        Sb[0] = pack_step<0>(S[0]); Sb[1] = pack_step<1>(S[0]); Sb[2] = pack_step<0>(S[1]); Sb[3] = pack_step<1>(S[1]);
        Sb[4] = pack_step<0>(S[2]); Sb[5] = pack_step<1>(S[2]); Sb[6] = pack_step<0>(S[3]); Sb[7] = pack_step<1>(S[3]);
        f32x16 vn[2], o[2];
#pragma unroll
        for (int mt = 0; mt < 2; ++mt) {
            f32x16 ws;
#pragma unroll
            for (int i = 0; i < 16; ++i) { ws[i] = 0.f; o[mt][i] = 0.f; }
#pragma unroll
            for (int ks = 0; ks < 8; ++ks) { ws = MFMA32(__builtin_bit_cast(bf16x8, Wf[(mt * 8 + ks) * 64]), Sb[ks], ws); o[mt] = MFMA32(__builtin_bit_cast(bf16x8, Qf[(mt * 8 + ks) * 64]), Sb[ks], o[mt]); }
            const v4u* up = (const v4u*)(item + DN_U + (size_t)(((jj * 2 + mt) * 64 + lane) * 32));
            const v4u u0 = up[0], u1 = up[1];
            vn[mt][0] = bflo(u0.x) - ws[0]; vn[mt][1] = bfhi(u0.x) - ws[1]; vn[mt][2] = bflo(u0.y) - ws[2]; vn[mt][3] = bfhi(u0.y) - ws[3];
            vn[mt][4] = bflo(u0.z) - ws[4]; vn[mt][5] = bfhi(u0.z) - ws[5]; vn[mt][6] = bflo(u0.w) - ws[6]; vn[mt][7] = bfhi(u0.w) - ws[7];
            vn[mt][8] = bflo(u1.x) - ws[8]; vn[mt][9] = bfhi(u1.x) - ws[9]; vn[mt][10] = bflo(u1.y) - ws[10]; vn[mt][11] = bfhi(u1.y) - ws[11];
            vn[mt][12] = bflo(u1.z) - ws[12]; vn[mt][13] = bfhi(u1.z) - ws[13]; vn[mt][14] = bflo(u1.w) - ws[14]; vn[mt][15] = bfhi(u1.w) - ws[15];
        }
        bf16x8 Vb[4];
        Vb[0] = pack_step<0>(vn[0]); Vb[1] = pack_step<1>(vn[0]); Vb[2] = pack_step<0>(vn[1]); Vb[3] = pack_step<1>(vn[1]);
#pragma unroll
        for (int mt = 0; mt < 2; ++mt)
#pragma unroll
            for (int kst = 0; kst < 4; ++kst) o[mt] = MFMA32(__builtin_bit_cast(bf16x8, Af[(mt * 4 + kst) * 64]), Vb[kst], o[mt]);
#pragma unroll
        for (int m = 0; m < 4; ++m) {
#pragma unroll
            for (int i = 0; i < 16; ++i) S[m][i] *= gl;
#pragma unroll
            for (int kst = 0; kst < 4; ++kst) S[m] = MFMA32(__builtin_bit_cast(bf16x8, Kf[(m * 4 + kst) * 64]), Vb[kst], S[m]);
        }
        const int tok0 = tokb + 64 * no;
#pragma unroll
        for (int mt = 0; mt < 2; ++mt)
#pragma unroll
            for (int i = 0; i < 16; ++i) { const int cp = 32 * mt + crow16(i, hh); const int oc = dir ? 63 - cp : cp; Od[(size_t)(tok0 + oc) * DM] = o[mt][i]; }
    }
    if (!lat) { float* so = p.out + (size_t)NTOK * DM + (size_t)dir * (16 * 8 * 128 * 128) + (size_t)(b * 8 + h) * 16384 + 32 * jj + n;
#pragma unroll
        for (int m = 0; m < 4; ++m)
#pragma unroll
            for (int i = 0; i < 16; ++i) so[(size_t)(32 * m + crow16(i, hh)) * 128] = S[m][i]; }
}

__device__ __forceinline__ void phase_ogate(const Params& p, const float* OF, const float* OBk, const bf16_t* Z, bf16_t* OG, int wave, int lane) {
    const int gw = wave * gridDim.x + blockIdx.x, ngw = gridDim.x * NWAVES;
    for (int tok = gw; tok < NTOK; tok += ngw) {
#pragma unroll
        for (int hf = 0; hf < 2; ++hf) {
            const int ch0 = hf * 512 + lane * 8; const size_t o = (size_t)tok * DM + ch0;
            float a[8], b2[8], z[8], nw[8];
            load8f(OF + o, a); load8f(OBk + o, b2); unpack8(*(const v4u*)(Z + o), z); load8f(p.dn_norm_w + (ch0 & 127), nw);
            float ss = 0.f;
#pragma unroll
            for (int e = 0; e < 8; ++e) { a[e] += b2[e]; ss += a[e] * a[e]; }
            const float r = rsqrtf(sum16(ss) * (1.0f / 128.0f) + 1e-6f);
            float y[8];
#pragma unroll
            for (int e = 0; e < 8; ++e) y[e] = a[e] * r * nw[e] * siluf(z[e]);
            v4u ov; ov.x = pk2bf(y[0], y[1]); ov.y = pk2bf(y[2], y[3]); ov.z = pk2bf(y[4], y[5]); ov.w = pk2bf(y[6], y[7]);
            *(v4u*)(OG + o) = ov;
        }
    }
}

template <class Epi> __device__ __forceinline__ void run_gemm(PG8_LAS unsigned char* lds, const bf16_t* A, const bf16_t* Bt, int N, int K, const Epi& E, int nrep) {
    pg8::Gemm g; g.A = A; g.Bt = Bt; g.M = NTOK; g.N = N; g.K = K;
    pg8::StaticOrder S; S.init(NTOK, N, (int)gridDim.x, (int)blockIdx.x);
    pg8::gemm_phase<Epi, pg8::StaticOrder, false>(lds, g, S, E, nullptr);
    __syncthreads();
}

__global__ void __launch_bounds__(512) fwd_megakernel(Params p) {
    extern __shared__ __attribute__((aligned(16))) unsigned char shm[];
    cg::grid_group grid = cg::this_grid();
    PG8_LAS unsigned char* lds3 = (PG8_LAS unsigned char*)shm;
    const int wave = __builtin_amdgcn_readfirstlane(threadIdx.x >> 6), lane = threadIdx.x & 63;
    unsigned char* ws = p.ws;
    volatile XLAS unsigned* xst = (volatile XLAS unsigned*)(lds3 + (LDS_BYTES - 16));
    if (threadIdx.x == 0) { xst[0] = 0u; xst[1] = 0u; }
    __syncthreads();
    XcdBarrier xb = xcd_barrier_post((unsigned*)(ws + OFF_BAR), xst);
    float* X0 = (float*)(ws + OFF_X0); float* X1 = (float*)(ws + OFF_X1); float* MOD = (float*)(ws + OFF_MOD);
    bf16_t* PROJ = (bf16_t*)(ws + OFF_PROJ); float* EX = (float*)(ws + OFF_EX);
    bf16_t* AM = (bf16_t*)p.out;
    bf16_t* HB = (bf16_t*)(ws + OFF_PROJ);
    float* QF = (float*)(ws + OFF_DN); float* KF = QF + BLK; float* VF = KF + BLK; float* BG = VF + BLK;
    float* OF = (float*)(ws + OFF_PROJ); float* OBk = OF + BLK;
    bf16_t* OG = PROJ + 4 * BLK; bf16_t* MRG = PROJ + 5 * BLK; float* GLp = (float*)(ws + OFF_EX + 786432);

#pragma unroll 1
    for (int rep = 0; rep < p.rep_prep; ++rep) { phase_prep(p, shm, wave, lane); __syncthreads(); }
    xcd_barrier(xb);
#pragma unroll 1
    for (int rep = 0; rep < p.rep_thin; ++rep) phase_norm<true>(p, nullptr, X0, p.norm_ffn1, 0, AM, wave, lane);
    xcd_barrier(xb);
    { pg8::EpiSwiglu E; E.H = HB; run_gemm(lds3, AM, (const bf16_t*)(ws + OFF_WGU), 5632, 1024, E, p.rep_gemm); }
    xcd_barrier(xb);
    { pg8::EpiResid E; E.Xin = X0; E.Xout = X1; E.gate = MOD + 2 * 1024; E.scale = 0.5f; run_gemm(lds3, HB, (const bf16_t*)(ws + OFF_WD), 1024, FFH, E, p.rep_gemm); }
    xcd_barrier(xb);
#pragma unroll 1
    for (int rep = 0; rep < p.rep_thin; ++rep) phase_norm<false>(p, X1, nullptr, p.norm_mix, 3, AM, wave, lane);
    xcd_barrier(xb);
    { pg8::EpiProj E; E.P = PROJ; E.EX = EX; run_gemm(lds3, AM, (const bf16_t*)(ws + OFF_WIN), 9472, 1024, E, p.rep_gemm); }
    xcd_barrier(xb);
#pragma unroll 1
    for (int rep = 0; rep < p.rep_dnpre; ++rep) for (int it = blockIdx.x; it < 768; it += gridDim.x) dn_pre_item(p, PROJ, EX, ws + OFF_DN, GLp, shm, it >> 3, it & 7);
#pragma unroll 1
    for (int rep = 0; rep < p.rep_thin; ++rep) phase_branch_a(p, PROJ, AM, wave, lane);
    xcd_barrier(xb);
#pragma unroll 1
    for (int rep = 0; rep < p.rep_scan; ++rep) for (int it = wave * gridDim.x + blockIdx.x; it < 1152; it += gridDim.x * NWAVES) dn_scan_item(p, ws + OFF_DN, GLp, OF, OBk, it, lane);
    xcd_barrier(xb);
#pragma unroll 1
    for (int rep = 0; rep < p.rep_thin; ++rep) phase_ogate(p, OF, OBk, PROJ + 6 * BLK, OG, wave, lane);
    {
        float* scr = (float*)shm + wave * (64 * 33); const int gw = wave * gridDim.x + blockIdx.x, ngw = gridDim.x * NWAVES;
        transpose_matrix(p.f2g, 1024, FFH, (bf16_t*)(ws + OFF_WGU), 1, gw, ngw, scr, lane);
        transpose_matrix(p.f2u, 1024, FFH, (bf16_t*)(ws + OFF_WGU), 2, gw, ngw, scr, lane);
        transpose_matrix(p.f2d, FFH, 1024, (bf16_t*)(ws + OFF_WD), 0, gw, ngw, scr, lane);
        __syncthreads();
    }
    xcd_barrier(xb);
    { pg8::EpiGate<0> E; E.G = PROJ + 7 * BLK; E.T = X0; E.O = nullptr; run_gemm(lds3, AM, (const bf16_t*)(ws + OFF_WCO), 1024, 1024, E, p.rep_gemm); }
    { pg8::EpiGate<1> E; E.G = PROJ + 8 * BLK; E.T = X0; E.O = MRG; run_gemm(lds3, OG, (const bf16_t*)(ws + OFF_WDNO), 1024, 1024, E, p.rep_gemm); }
    xcd_barrier(xb);
    { pg8::EpiResid E; E.Xin = X1; E.Xout = X0; E.gate = MOD + 5 * 1024; E.scale = 1.0f; run_gemm(lds3, MRG, (const bf16_t*)(ws + OFF_WO), 1024, 1024, E, p.rep_gemm); }
    xcd_barrier(xb);
#pragma unroll 1
    for (int rep = 0; rep < p.rep_thin; ++rep) phase_norm<false>(p, X0, nullptr, p.norm_ffn2, 6, AM, wave, lane);
    xcd_barrier(xb);
    { pg8::EpiSwiglu E; E.H = HB; run_gemm(lds3, AM, (const bf16_t*)(ws + OFF_WGU), 5632, 1024, E, p.rep_gemm); }
    xcd_barrier(xb);
    { pg8::EpiResid E; E.Xin = X0; E.Xout = p.out; E.gate = MOD + 8 * 1024; E.scale = 0.5f; run_gemm(lds3, HB, (const bf16_t*)(ws + OFF_WD), 1024, FFH, E, p.rep_gemm); }
    xcd_barrier(xb);
#pragma unroll 1
    for (int rep = 0; rep < p.rep_sync; ++rep) grid.sync();
    phase_final_norm(p, p.out, wave, lane);
}

extern "C" void kernel_launch(void* const* d_in, const int* in_sizes, int n_in, void* d_out, int out_size, void* d_ws, size_t ws_size, hipStream_t stream) {
    static int grid_blocks = 0;
    if (grid_blocks == 0) {
        if (n_in != 27 || ws_size < WS_NEED) { fprintf(stderr, "kernel_launch: unexpected n_in %d / ws %zu\n", n_in, ws_size); grid_blocks = -1; return; }
        int dev = 0, cus = 0, per_cu = 0;
        hipGetDevice(&dev); hipDeviceGetAttribute(&cus, hipDeviceAttributeMultiprocessorCount, dev);
        hipFuncSetAttribute((const void*)fwd_megakernel, hipFuncAttributeMaxDynamicSharedMemorySize, LDS_BYTES);
        hipOccupancyMaxActiveBlocksPerMultiprocessor(&per_cu, (const void*)fwd_megakernel, 512, LDS_BYTES);
        if (per_cu < 1) { fprintf(stderr, "kernel_launch: occupancy query says %d blocks/CU\n", per_cu); per_cu = 1; }
        (void)hipGetLastError();
        grid_blocks = cus;
    }
    if (grid_blocks < 0) return;
    Params p{};
    const float** f = (const float**)&p;
    for (int i = 0; i < 27; ++i) f[i] = (const float*)d_in[i];
    p.out = (float*)d_out; p.ws = (unsigned char*)d_ws; p.rep_prep = REP_PREP; p.rep_gemm = REP_GEMM; p.rep_dnpre = REP_DNPRE; p.rep_scan = REP_SCAN; p.rep_thin = REP_THIN; p.rep_sync = REP_SYNC;
    (void)hipMemsetAsync((unsigned char*)d_ws + OFF_BAR, 0, XCD_BAR_WORDS * sizeof(unsigned), stream);
    void* args[] = {&p};
    hipError_t e = hipLaunchCooperativeKernel((const void*)fwd_megakernel, dim3(grid_blocks), dim3(512), args, LDS_BYTES, stream);
    if (e != hipSuccess) fprintf(stderr, "cooperative launch failed: %s (grid %d)\n", hipGetErrorString(e), grid_blocks);
}
```

```cpp
#include <hip/hip_runtime.h>
#include <hip/hip_cooperative_groups.h>
#include <cstdio>
#include <cstdint>
namespace cg = cooperative_groups;
#define REP_PREP 1
#define REP_GEMM 1
#define REP_DNPRE 1
#define REP_SCAN 1
#define REP_THIN 1
#define REP_SYNC 0
namespace pg8 {
#define PG8_LAS __attribute__((address_space(3)))
typedef unsigned short bf16_t;
typedef short bf16x8 __attribute__((ext_vector_type(8)));
typedef float f32x4 __attribute__((ext_vector_type(4)));
typedef unsigned u32x4 __attribute__((ext_vector_type(4)));
constexpr int BM = 256, BK = 64, HALF = 128, HTB = HALF * BK * 2  , STAGE_BYTES = 8 * HTB, NXCD = 8, WGM = 8;

__host__ __device__ __forceinline__ int lds_byte(int r, int c) { const int st = (r >> 4) * 2 + (c >> 5), rr = r & 15, cc = c & 31, ob = rr * 64 + cc * 2; return st * 1024 + (ob ^ (((ob >> 9) & 1) << 5)); }
__host__ __device__ __forceinline__ void stage_rc(int b, int& R, int& C) { const int st = b / 1024, sb = b % 1024, swz = sb ^ (((sb >> 9) & 1) << 5); R = (st >> 1) * 16 + swz / 64; C = (st & 1) * 32 + (swz % 64) / 2; }
__host__ __device__ __forceinline__ int perm32(int rho) { const int n = rho >> 4, i = rho & 15; return 8 * (i >> 2) + 4 * n + (i & 3); }

struct Unit { int pm, pn; };
struct Gemm { const bf16_t* A; const bf16_t* Bt; int M, N, K; };

struct StaticOrder {
    int nM, nN, nwg, G, c;
    __host__ __device__ void init(int M, int N, int G_, int c_) { nM = M / BM; nN = N / BM; nwg = nM * nN; G = G_; c = c_; }
    __host__ __device__ bool next(int i, Unit& u) const {
        const long L = (long)i * G + c; if (L >= nwg) return false;
        int wgid = (int)L; { const int q = nwg / NXCD, r = nwg % NXCD, xcd = wgid % NXCD, off = wgid / NXCD; wgid = (xcd < r ? xcd * (q + 1) : r * (q + 1) + (xcd - r) * q) + off; }
        const int nig = WGM * nN, gid = wgid / nig, fm = gid * WGM, gsz = (nM - fm) < WGM ? (nM - fm) : WGM;
        u.pm = fm + ((wgid % nig) % gsz); u.pn = (wgid % nig) / gsz; return true;
    }
    __device__ __forceinline__ void a_ready(const Unit&) const {}
    __device__ __forceinline__ void done(const Unit&) const {}
};
__device__ __forceinline__ unsigned pk2bf(float a, float b) { typedef float f2v __attribute__((ext_vector_type(2))); typedef __bf16 b2v __attribute__((ext_vector_type(2))); f2v v = {a, b}; b2v r = __builtin_convertvector(v, b2v); return __builtin_bit_cast(unsigned, r); }
__device__ __forceinline__ float bflo(unsigned u) { return __uint_as_float(u << 16); }
__device__ __forceinline__ float bfhi(unsigned u) { return __uint_as_float(u & 0xffff0000u); }
__device__ __forceinline__ float siluf(float x) { return x / (1.f + __expf(-x)); }
__device__ __forceinline__ float sigmf(float x) { return 1.f / (1.f + __expf(-x)); }
__device__ __forceinline__ int cond_of_tile(int pm) { return pm < 16 ? 0 : 1 + ((pm - 16) >> 2); }
constexpr int NTOK = 6144, DM = 1024, FFH = 2816, NMOD = 9216;
typedef unsigned u32x2 __attribute__((ext_vector_type(2)));

struct EpiSwiglu {
    static constexpr bool PERM = false, AFTER_DRAIN = false;
    bf16_t* H;
    __device__ __forceinline__ void operator()(const f32x4 (&acc)[2][2][4][2], const Unit& u, int wr, int wc, int fr, int fq) const {
        const int row0 = u.pm * BM + wr * 64 + fr, col0 = u.pn * 128 + wc * 32 + 4 * fq;
#pragma unroll
        for (int ai = 0; ai < 2; ++ai)
#pragma unroll
            for (int m = 0; m < 4; ++m) { bf16_t* rowp = H + (size_t)(row0 + ai * HALF + m * 16) * FFH + col0;
#pragma unroll
                for (int n = 0; n < 2; ++n) { const f32x4 g = acc[ai][0][m][n], up = acc[ai][1][m][n];
                    u32x2 o; o.x = pk2bf(siluf(g[0]) * up[0], siluf(g[1]) * up[1]); o.y = pk2bf(siluf(g[2]) * up[2], siluf(g[3]) * up[3]);
                    *(u32x2*)(rowp + n * 16) = o; } }
    }
};
struct EpiResid {
    static constexpr bool PERM = false, AFTER_DRAIN = false;
    const float* Xin; float* Xout; const float* gate; float scale;
    __device__ __forceinline__ void operator()(const f32x4 (&acc)[2][2][4][2], const Unit& u, int wr, int wc, int fr, int fq) const {
        const int row0 = u.pm * BM + wr * 64 + fr, col0 = u.pn * BM + wc * 32 + 4 * fq;
        const float* gp = gate + (size_t)cond_of_tile(u.pm) * NMOD + col0;
        f32x4 gv[2][2];
#pragma unroll
        for (int bj = 0; bj < 2; ++bj)
#pragma unroll
            for (int n = 0; n < 2; ++n) gv[bj][n] = *(const f32x4*)(gp + bj * HALF + n * 16) * scale;
#pragma unroll
        for (int ai = 0; ai < 2; ++ai)
#pragma unroll
            for (int m = 0; m < 4; ++m) { const size_t off = (size_t)(row0 + ai * HALF + m * 16) * DM + col0;
#pragma unroll
                for (int bj = 0; bj < 2; ++bj)
#pragma unroll
                    for (int n = 0; n < 2; ++n) { const f32x4 x = *(const f32x4*)(Xin + off + bj * HALF + n * 16);
                        *(f32x4*)(Xout + off + bj * HALF + n * 16) = x + gv[bj][n] * acc[ai][bj][m][n]; } }
    }
};
struct EpiProj {
    static constexpr bool PERM = false, AFTER_DRAIN = false;
    bf16_t* P; float* EX;
    __device__ __forceinline__ void operator()(const f32x4 (&acc)[2][2][4][2], const Unit& u, int wr, int wc, int fr, int fq) const {
        const int row0 = u.pm * BM + wr * 64 + fr;
        if (u.pn < 36) {
            bf16_t* base = P + (size_t)(u.pn >> 2) * NTOK * DM; const int col0 = (u.pn & 3) * 256 + wc * 32 + 4 * fq;
#pragma unroll
            for (int ai = 0; ai < 2; ++ai)
#pragma unroll
                for (int m = 0; m < 4; ++m) { bf16_t* rowp = base + (size_t)(row0 + ai * HALF + m * 16) * DM + col0;
#pragma unroll
                    for (int bj = 0; bj < 2; ++bj)
#pragma unroll
                        for (int n = 0; n < 2; ++n) { const f32x4 v = acc[ai][bj][m][n]; u32x2 o; o.x = pk2bf(v[0], v[1]); o.y = pk2bf(v[2], v[3]); *(u32x2*)(rowp + bj * HALF + n * 16) = o; } }
        } else if (wc == 0) {
#pragma unroll
            for (int ai = 0; ai < 2; ++ai)
#pragma unroll
                for (int m = 0; m < 4; ++m)
#pragma unroll
                    for (int n = 0; n < 2; ++n) *(f32x4*)(EX + (size_t)(row0 + ai * HALF + m * 16) * 32 + n * 16 + 4 * fq) = acc[ai][0][m][n];
        }
    }
};
template <int SECOND> struct EpiGate {
    static constexpr bool PERM = false, AFTER_DRAIN = false;
    const bf16_t* G; float* T; bf16_t* O;
    __device__ __forceinline__ void operator()(const f32x4 (&acc)[2][2][4][2], const Unit& u, int wr, int wc, int fr, int fq) const {
        const int row0 = u.pm * BM + wr * 64 + fr, col0 = u.pn * BM + wc * 32 + 4 * fq;
#pragma unroll
        for (int ai = 0; ai < 2; ++ai)
#pragma unroll
            for (int m = 0; m < 4; ++m) { const size_t off = (size_t)(row0 + ai * HALF + m * 16) * DM + col0;
#pragma unroll
                for (int bj = 0; bj < 2; ++bj)
#pragma unroll
                    for (int n = 0; n < 2; ++n) { const size_t o = off + bj * HALF + n * 16; const u32x2 gr = *(const u32x2*)(G + o); const f32x4 a = acc[ai][bj][m][n];
                        f32x4 v; v[0] = sigmf(bflo(gr.x)) * a[0]; v[1] = sigmf(bfhi(gr.x)) * a[1]; v[2] = sigmf(bflo(gr.y)) * a[2]; v[3] = sigmf(bfhi(gr.y)) * a[3];
                        if (SECOND == 0) *(f32x4*)(T + o) = v;
                        else { const f32x4 t = *(const f32x4*)(T + o); v = v + t; u32x2 w; w.x = pk2bf(v[0], v[1]); w.y = pk2bf(v[2], v[3]); *(u32x2*)(O + o) = w; } } }
    }
};

template <class Epi, class Sched, bool STAMP = false>
__device__ __forceinline__ void gemm_phase(PG8_LAS unsigned char* lds, const Gemm g, const Sched& S, const Epi& E, unsigned long long* stamps) {
    int tid_l = threadIdx.x; asm volatile("" : "+v"(tid_l));
    const int tid = tid_l, wid = __builtin_amdgcn_readfirstlane(tid >> 6), lane = tid & 63, wr = wid >> 2, wc = wid & 3, fr = lane & 15, fq = lane >> 4;
    const int K = g.K, nt = K / BK;
    int ts_lo = 0, ts_hi = 0, nts = 0; const unsigned long long rt_entry = STAMP ? (unsigned long long)wall_clock64() : 0ull;
#define PG8_STAMP() do { if (STAMP && wid == 0 && nts < 64) { const unsigned long long _c = (unsigned long long)clock64(); \
        ts_lo = (lane == nts) ? (int)(unsigned)_c : ts_lo; ts_hi = (lane == nts) ? (int)(unsigned)(_c >> 32) : ts_hi; ++nts; } } while (0)
    PG8_STAMP();
    unsigned voffA[2], voffB[2];
#pragma unroll
    for (int i = 0; i < 2; ++i) { int R, C; stage_rc(tid * 16 + i * 8192, R, C); const int Rb = Epi::PERM ? ((R & ~31) + perm32(R & 31)) : R;
        voffA[i] = (unsigned)(R * K + C) * 2u; voffB[i] = (unsigned)(Rb * K + C) * 2u; }
    const size_t kstep = (size_t)(BK * 2);
    const size_t hstep = (size_t)HALF * K * 2;
    const size_t tstep = 2 * hstep;
    const unsigned ldsw = (unsigned)wid * 1024u;
    const int aoff = lds_byte(wr * 64 + fr, fq * 8), boff = lds_byte(wc * 32 + fr, fq * 8);
#define PG8_SA(b, h) (((b) * 2 + (h)) * HTB)
#define PG8_SB(b, h) ((4 + (b) * 2 + (h)) * HTB)
#define PG8_STAGE(bufoff, gbase, voff) do { _Pragma("unroll") for (int _i = 0; _i < 2; ++_i) \
        __builtin_amdgcn_global_load_lds((const unsigned*)((const char*)(gbase) + (voff)[_i]), (PG8_LAS unsigned*)(lds + (bufoff) + ldsw + _i * 8192), 16, 0, 0); } while (0)
#define PG8_LDA(dst, b, h) do { _Pragma("unroll") for (int m = 0; m < 4; ++m) _Pragma("unroll") for (int k = 0; k < 2; ++k) dst[m][k] = *(const PG8_LAS bf16x8*)(lds + PG8_SA(b, h) + aoff + m * 2048 + k * 1024); } while (0)
#define PG8_LDB(dst, b, h) do { _Pragma("unroll") for (int n = 0; n < 2; ++n) _Pragma("unroll") for (int k = 0; k < 2; ++k) dst[n][k] = *(const PG8_LAS bf16x8*)(lds + PG8_SB(b, h) + boff + n * 2048 + k * 1024); } while (0)
#define PG8_MMA(ai, bj, At, Bt) do { __builtin_amdgcn_s_setprio(1); _Pragma("unroll") for (int m = 0; m < 4; ++m) _Pragma("unroll") for (int n = 0; n < 2; ++n) _Pragma("unroll") for (int k = 0; k < 2; ++k) \
        acc[ai][bj][m][n] = __builtin_amdgcn_mfma_f32_16x16x32_bf16(Bt[n][k], At[m][k], acc[ai][bj][m][n], 0, 0, 0); __builtin_amdgcn_s_setprio(0); } while (0)
#define PG8_WAIT_V(n) asm volatile("s_waitcnt vmcnt(" #n ")" ::: "memory")
#define PG8_WAIT_L(n) asm volatile("s_waitcnt lgkmcnt(" #n ")" ::: "memory")
#define PG8_BAR __builtin_amdgcn_s_barrier()
#define PG8_SCHED __builtin_amdgcn_sched_barrier(0)
    Unit cur, nxt; int ui = 0;
    if (!S.next(0, cur)) return;
    f32x4 acc[2][2][4][2];
#pragma unroll
    for (int a = 0; a < 2; ++a)
#pragma unroll
        for (int b = 0; b < 2; ++b)
#pragma unroll
            for (int m = 0; m < 4; ++m)
#pragma unroll
                for (int n = 0; n < 2; ++n) acc[a][b][m][n] = (f32x4){0.f, 0.f, 0.f, 0.f};
    bf16x8 At[4][2], B0[2][2], B1[2][2];
    const char* cA = (const char*)g.A + (size_t)cur.pm * tstep; const char* cB = (const char*)g.Bt + (size_t)cur.pn * tstep;
    S.a_ready(cur);
    PG8_STAGE(PG8_SB(0, 0), cB, voffB); PG8_STAGE(PG8_SA(0, 0), cA, voffA); PG8_STAGE(PG8_SB(0, 1), cB + hstep, voffB); PG8_STAGE(PG8_SA(0, 1), cA + hstep, voffA);
    if (wr == 1) PG8_BAR;
    PG8_WAIT_V(4); PG8_BAR;
    PG8_STAGE(PG8_SB(1, 0), cB + kstep, voffB); PG8_STAGE(PG8_SA(1, 0), cA + kstep, voffA); PG8_STAGE(PG8_SB(1, 1), cB + hstep + kstep, voffB);
    PG8_WAIT_V(6); PG8_BAR;
    PG8_STAMP();
    for (;;) {
        const bool has_next = S.next(ui + 1, nxt);
        const char* nA = has_next ? (const char*)g.A + (size_t)nxt.pm * tstep : cA; const char* nB = has_next ? (const char*)g.Bt + (size_t)nxt.pn * tstep : cB;
        for (int t = 0; t < nt; t += 2) {
            const bool last = (t == nt - 2);
            const char* a1 = cA + (size_t)(t + 1) * kstep;
            const char* a2 = last ? nA : cA + (size_t)(t + 2) * kstep; const char* b2 = last ? nB : cB + (size_t)(t + 2) * kstep;
            const char* a3 = a2 + kstep; const char* b3 = b2 + kstep;
            if (last && has_next) S.a_ready(nxt);
            PG8_LDB(B0, 0, 0); PG8_SCHED; PG8_LDA(At, 0, 0); PG8_STAGE(PG8_SA(1, 1), a1 + hstep, voffA);
            PG8_WAIT_L(8); PG8_BAR; PG8_WAIT_L(0); PG8_MMA(0, 0, At, B0); PG8_BAR; PG8_SCHED;
            PG8_LDB(B1, 0, 1); PG8_STAGE(PG8_SB(0, 0), b2, voffB);
            PG8_BAR; PG8_WAIT_L(0); PG8_MMA(0, 1, At, B1); PG8_BAR;
            PG8_LDA(At, 0, 1); PG8_STAGE(PG8_SA(0, 0), a2, voffA);
            PG8_BAR; PG8_WAIT_L(0); PG8_MMA(1, 0, At, B0); PG8_BAR; PG8_SCHED;
            PG8_STAGE(PG8_SB(0, 1), b2 + hstep, voffB);
            PG8_WAIT_V(6); PG8_BAR; PG8_MMA(1, 1, At, B1); PG8_BAR;
            PG8_LDB(B0, 1, 0); PG8_SCHED; PG8_LDA(At, 1, 0); PG8_STAGE(PG8_SA(0, 1), a2 + hstep, voffA);
            PG8_WAIT_L(8); PG8_BAR; PG8_WAIT_L(0); PG8_MMA(0, 0, At, B0); PG8_BAR; PG8_SCHED;
            PG8_LDB(B1, 1, 1); PG8_STAGE(PG8_SB(1, 0), b3, voffB);
            PG8_BAR; PG8_WAIT_L(0); PG8_MMA(0, 1, At, B1); PG8_BAR;
            PG8_LDA(At, 1, 1); PG8_STAGE(PG8_SA(1, 0), a3, voffA);
            PG8_BAR; PG8_WAIT_L(0); PG8_MMA(1, 0, At, B0); PG8_BAR; PG8_SCHED;
            PG8_STAGE(PG8_SB(1, 1), b3 + hstep, voffB);
            PG8_WAIT_V(6); PG8_BAR; PG8_MMA(1, 1, At, B1); PG8_BAR;
        }
        PG8_STAMP();
        if constexpr (!Epi::AFTER_DRAIN) { E(acc, cur, wr, wc, fr, fq); S.done(cur); }
        PG8_STAMP();
        if (!has_next) break;
#pragma unroll
        for (int a = 0; a < 2; ++a)
#pragma unroll
            for (int b = 0; b < 2; ++b)
#pragma unroll
                for (int m = 0; m < 4; ++m)
#pragma unroll
                    for (int n = 0; n < 2; ++n) acc[a][b][m][n] = (f32x4){0.f, 0.f, 0.f, 0.f};
        cur = nxt; cA = nA; cB = nB; ++ui;
    }
    PG8_WAIT_V(0);
    if (wr == 0) PG8_BAR;
    PG8_BAR;
    if constexpr (Epi::AFTER_DRAIN) { E.fused(acc, cur, wr, wc, fr, fq, lds, wid, lane); S.done(cur); }
    PG8_STAMP();
    if (STAMP && wid == 0) { stamps[lane] = lane < nts ? (((unsigned long long)(unsigned)ts_hi << 32) | (unsigned)ts_lo) : 0ull;
        if (lane == 62) stamps[62] = rt_entry; if (lane == 63) stamps[63] = (unsigned long long)wall_clock64(); }
#undef PG8_STAMP
#undef PG8_SA
#undef PG8_SB
#undef PG8_STAGE
#undef PG8_LDA
#undef PG8_LDB
#undef PG8_MMA
#undef PG8_WAIT_V
#undef PG8_WAIT_L
#undef PG8_BAR
#undef PG8_SCHED
}
}
#define XB_TMO      128
#define XB_XCNT(j)  (256  + 64 * (j))
#define XB_XSUB(j)  (1280 + 64 * (j))
#define XB_XGEN(j)  (2304 + 64 * (j))
#define XB_TOP      3328
#define XB_TOPGEN   3392
#define XCD_BAR_WORDS 3456
#define XB_SPIN_CAP (1u << 18)
#define XLAS __attribute__((address_space(3)))

__device__ __forceinline__ unsigned xb_ld(unsigned* p)              { return __hip_atomic_load(p, __ATOMIC_RELAXED, __HIP_MEMORY_SCOPE_AGENT); }
__device__ __forceinline__ unsigned xb_add(unsigned* p, unsigned v) { return __hip_atomic_fetch_add(p, v, __ATOMIC_RELAXED, __HIP_MEMORY_SCOPE_AGENT); }
__device__ __forceinline__ unsigned xb_xcc_id() { return (unsigned)__builtin_amdgcn_s_getreg((3 << 11) | 20) & 0xFu; }
#define XB_SPIN(cond, bar) do { unsigned _sp = 0; while (cond) { __builtin_amdgcn_s_sleep(1); \
    if ((++_sp & 255u) == 0u) { if (xb_ld(&(bar)[XB_TMO])) break; if (_sp > XB_SPIN_CAP) { atomicAdd(&(bar)[XB_TMO], 1u); break; } } } } while (0)

struct XcdBarrier {
    unsigned* bar; unsigned x;
    volatile XLAS unsigned* st;
};

__device__ __forceinline__ XcdBarrier xcd_barrier_post(unsigned* bar, volatile XLAS unsigned* st) {
    XcdBarrier b; b.bar = bar; b.x = xb_xcc_id(); b.st = st;
    if (threadIdx.x == 0) (void)xb_add(&bar[XB_XCNT(b.x)], 1u);
    return b;
}
__device__ __forceinline__ void xcd_barrier_complete(unsigned* bar, unsigned x, unsigned& nloc, unsigned& nx) {
    const unsigned G = gridDim.x * gridDim.y * gridDim.z;
    unsigned sum, cnt, mine, sp = 0u;
    for (;;) {
        sum = 0u; cnt = 0u; mine = 0u;
#pragma unroll
        for (unsigned j = 0; j < 16; ++j) { const unsigned c = xb_ld(&bar[XB_XCNT(j)]); sum += c; cnt += (c > 0u) ? 1u : 0u; mine = (j == x) ? c : mine; }
        if (sum == G) break;
        __builtin_amdgcn_s_sleep(1);
        if ((++sp & 255u) == 0u) { if (xb_ld(&bar[XB_TMO])) break; if (sp > XB_SPIN_CAP) { atomicAdd(&bar[XB_TMO], 1u); break; } }
    }
    nloc = mine > 0u ? mine : 1u; nx = cnt > 0u ? cnt : 1u;
}

__device__ __forceinline__ void xcd_barrier(const XcdBarrier& b) {
    asm volatile("s_waitcnt vmcnt(0)" ::: "memory");
    __syncthreads();
    if (threadIdx.x == 0) {
        unsigned* bar = b.bar;
        __builtin_amdgcn_s_waitcnt(0);
        unsigned nloc = b.st[0], nx = b.st[1];
        if (nloc == 0u) { xcd_barrier_complete(bar, b.x, nloc, nx); b.st[0] = nloc; b.st[1] = nx; }
        const unsigned old = xb_add(&bar[XB_XSUB(b.x)], 1u);
        const unsigned gen = old / nloc;
        if (old + 1u == (gen + 1u) * nloc) {
            __builtin_amdgcn_fence(__ATOMIC_RELEASE, "agent");
            asm volatile("s_waitcnt vmcnt(0)" ::: "memory");
            const unsigned og = xb_add(&bar[XB_TOP], 1u);
            const unsigned tg = og / nx;
            if (og + 1u == (tg + 1u) * nx) xb_add(&bar[XB_TOPGEN], 1u);
            else XB_SPIN(xb_ld(&bar[XB_TOPGEN]) == tg, bar);
            __builtin_amdgcn_fence(__ATOMIC_ACQUIRE, "agent");
            xb_add(&bar[XB_XGEN(b.x)], 1u);
            asm volatile("s_waitcnt vmcnt(0)" ::: "memory");
        } else {
            XB_SPIN(xb_ld(&bar[XB_XGEN(b.x)]) == gen, bar);
            __builtin_amdgcn_fence(__ATOMIC_ACQUIRE, "agent");
            asm volatile("s_waitcnt vmcnt(0)" ::: "memory");
        }
    }
    __syncthreads();
}


using pg8::bf16_t; using pg8::f32x4; using pg8::pk2bf; using pg8::bflo; using pg8::bfhi; using pg8::siluf; using pg8::sigmf; using pg8::u32x2;
using pg8::NTOK; using pg8::DM; using pg8::FFH; using pg8::NMOD;
typedef unsigned v4u __attribute__((ext_vector_type(4)));
#define LDS_WAIT() asm volatile("s_waitcnt lgkmcnt(0)" ::: "memory")
constexpr int NCTX = 4096, NWAVES = 8, LDS_BYTES = 139264;
constexpr size_t MiB = 1048576;
constexpr size_t OFF_WCO = 0, OFF_WDNO = 2 * MiB, OFF_WO = 4 * MiB;
constexpr size_t OFF_WGU = 6 * MiB;
constexpr size_t OFF_WD = 17 * MiB;
constexpr size_t OFF_WIN = 23 * MiB;
constexpr size_t OFF_X0 = 42 * MiB;
constexpr size_t OFF_DN = 6 * MiB;
constexpr size_t OFF_X1 = 114 * MiB;
constexpr size_t OFF_PROJ = 138 * MiB;
constexpr size_t OFF_EX = 246 * MiB;
constexpr size_t OFF_MOD = 247 * MiB;
constexpr size_t OFF_BAR = 247 * MiB + 512 * 1024;
constexpr size_t WS_NEED = 248 * MiB;
constexpr size_t BLK = (size_t)NTOK * DM;

struct Params {
    const float *x_prompt, *x_sample, *st_f, *st_b, *c, *c_ctx, *ada_w, *ada_b, *norm_ffn1, *f1g, *f1u, *f1d, *norm_mix, *w_in, *conv_w, *conv_out_w,
        *dn_conv_w, *dn_a_log, *dn_dt_bias, *dn_norm_w, *dn_out_w, *w_o, *norm_ffn2, *f2g, *f2u, *f2d, *norm_f;
    float* out; unsigned char* ws; int rep_prep, rep_gemm, rep_dnpre, rep_scan, rep_thin, rep_sync;
};

__device__ __forceinline__ float wave_sum(float v) {
#pragma unroll
    for (int o = 1; o < 64; o <<= 1) v += __shfl_xor(v, o);
    return v;
}
__device__ __forceinline__ float sum16(float v) {
#pragma unroll
    for (int o = 1; o < 16; o <<= 1) v += __shfl_xor(v, o);
    return v;
}
__device__ __forceinline__ void transpose_item(const float* W, int N, int k0, int n0, bf16_t* WT, int Kd, int dst_row0, float* scr, int lane) {
#pragma unroll 8
    for (int i = 0; i < 32; ++i) { const int kk = 2 * i + (lane >> 5); scr[kk * 33 + (lane & 31)] = W[(size_t)(k0 + kk) * N + n0 + (lane & 31)]; }
    LDS_WAIT();
    const int c = lane & 7;
#pragma unroll
    for (int j = 0; j < 4; ++j) { const int n = (lane >> 3) + 8 * j; const float* s = scr + (8 * c) * 33 + n;
        v4u o; o.x = pk2bf(s[0 * 33], s[1 * 33]); o.y = pk2bf(s[2 * 33], s[3 * 33]); o.z = pk2bf(s[4 * 33], s[5 * 33]); o.w = pk2bf(s[6 * 33], s[7 * 33]);
        *(v4u*)(WT + (size_t)(dst_row0 + n) * Kd + k0 + 8 * c) = o; }
    LDS_WAIT();
}
__device__ __forceinline__ void transpose_matrix(const float* W, int K, int N, bf16_t* WT, int mode, int gw, int ngw, float* scr, int lane) {
    const int nblk = N / 32, nitems = (K / 64) * nblk;
    for (int it = gw; it < nitems; it += ngw) {
        const int kb = it / nblk, nb = it % nblk, n0 = nb * 32;
        const int dr = mode == 0 ? n0 : ((n0 >> 7) * 256 + (n0 & 127) + (mode == 2 ? 128 : 0));
        transpose_item(W, N, kb * 64, n0, WT, K, dr, scr, lane);
    }
}

__device__ __forceinline__ void phase_prep(const Params& p, unsigned char* lds, int wave, int lane) {
    unsigned char* ws = p.ws;
    float* scr = (float*)lds + wave * (64 * 33);
    const int gw = wave * gridDim.x + blockIdx.x, ngw = gridDim.x * NWAVES;
    transpose_matrix(p.w_in, 1024, 9248, (bf16_t*)(ws + OFF_WIN), 0, gw, ngw, scr, lane);
    transpose_matrix(p.f1g, 1024, FFH, (bf16_t*)(ws + OFF_WGU), 1, gw, ngw, scr, lane);
    transpose_matrix(p.f1u, 1024, FFH, (bf16_t*)(ws + OFF_WGU), 2, gw, ngw, scr, lane);
    transpose_matrix(p.f1d, FFH, 1024, (bf16_t*)(ws + OFF_WD), 0, gw, ngw, scr, lane);
    transpose_matrix(p.conv_out_w, 1024, 1024, (bf16_t*)(ws + OFF_WCO), 0, gw, ngw, scr, lane);
    transpose_matrix(p.dn_out_w, 1024, 1024, (bf16_t*)(ws + OFF_WDNO), 0, gw, ngw, scr, lane);
    transpose_matrix(p.w_o, 1024, 1024, (bf16_t*)(ws + OFF_WO), 0, gw, ngw, scr, lane);
    {
        v4u z = {0u, 0u, 0u, 0u}; v4u* zp = (v4u*)((bf16_t*)(ws + OFF_WIN) + (size_t)9248 * 1024);
        const int nz = 224 * 1024 * 2 / 16;
        for (int i = blockIdx.x * 512 + threadIdx.x; i < nz; i += gridDim.x * 512) zp[i] = z;
    }
    __syncthreads();
    float* sc = (float*)lds;
    float* red = (float*)lds + 3072;
    if ((int)blockIdx.x < 144) {
        for (int i = threadIdx.x; i < 3072; i += 512) { const int cc = i >> 10, k = i & 1023; const float v = cc == 0 ? p.c_ctx[k] : p.c[(cc - 1) * 1024 + k]; sc[i] = siluf(v); }
        __syncthreads();
        for (int it = blockIdx.x; it < 144; it += gridDim.x) {
            const int n = it * 64 + lane; float a0 = 0.f, a1 = 0.f, a2 = 0.f;
            const float* wp = p.ada_w + (size_t)(wave * 128) * NMOD + n;
#pragma unroll 8
            for (int k = 0; k < 128; ++k) { const float wv = wp[(size_t)k * NMOD]; const int kk = wave * 128 + k; a0 += sc[kk] * wv; a1 += sc[1024 + kk] * wv; a2 += sc[2048 + kk] * wv; }
            red[(wave * 3 + 0) * 64 + lane] = a0; red[(wave * 3 + 1) * 64 + lane] = a1; red[(wave * 3 + 2) * 64 + lane] = a2;
            __syncthreads();
            if (threadIdx.x < 192) { const int cc = threadIdx.x >> 6, l = threadIdx.x & 63; float s = 0.f;
#pragma unroll
                for (int w = 0; w < 8; ++w) s += red[(w * 3 + cc) * 64 + l];
                ((float*)(ws + OFF_MOD))[cc * NMOD + it * 64 + l] = s + p.ada_b[it * 64 + l]; }
            __syncthreads();
        }
    }
}

template <bool FIRST> __device__ __forceinline__ void phase_norm(const Params& p, const float* X, float* X0, const float* nw, int modi, bf16_t* A, int wave, int lane) {
    const float* mod = (const float*)(p.ws + OFF_MOD);
    const int gw = wave * gridDim.x + blockIdx.x, ngw = gridDim.x * NWAVES;
    for (int row = gw; row < NTOK; row += ngw) {
        const int cond = row < NCTX ? 0 : 1 + ((row - NCTX) >> 10);
        f32x4 v[4];
        if (FIRST) {
            const float* src = row < NCTX ? p.x_prompt + (size_t)row * DM : p.x_sample + (size_t)(row - NCTX) * DM;
#pragma unroll
            for (int j = 0; j < 4; ++j) v[j] = *(const f32x4*)(src + 4 * lane + 256 * j);
            if (row >= NCTX) {
                const int t = (row - NCTX) & 1023; const float r = (float)(t >> 6), cl = (float)(t & 63);
#pragma unroll
                for (int e = 0; e < 4; ++e) { const int i = 4 * lane + e; const float om = 1.0f / powf(10000.0f, (float)i * (1.0f / 256.0f));
                    v[0][e] += sinf(r * om); v[1][e] += cosf(r * om); v[2][e] += sinf(cl * om); v[3][e] += cosf(cl * om); }
            }
#pragma unroll
            for (int j = 0; j < 4; ++j) *(f32x4*)(X0 + (size_t)row * DM + 4 * lane + 256 * j) = v[j];
        } else {
#pragma unroll
            for (int j = 0; j < 4; ++j) v[j] = *(const f32x4*)(X + (size_t)row * DM + 4 * lane + 256 * j);
        }
        float ss = 0.f;
#pragma unroll
        for (int j = 0; j < 4; ++j) ss += v[j][0] * v[j][0] + v[j][1] * v[j][1] + v[j][2] * v[j][2] + v[j][3] * v[j][3];
        const float rstd = rsqrtf(wave_sum(ss) * (1.0f / 1024.0f) + 1e-6f);
        const float* sh = mod + (size_t)cond * NMOD + modi * 1024; const float* scp = sh + 1024;
#pragma unroll
        for (int j = 0; j < 4; ++j) { const int d = 4 * lane + 256 * j; const f32x4 w = *(const f32x4*)(nw + d), s1 = *(const f32x4*)(scp + d), s0 = *(const f32x4*)(sh + d);
            f32x4 y;
#pragma unroll
            for (int e = 0; e < 4; ++e) y[e] = v[j][e] * rstd * w[e] * (1.f + s1[e]) + s0[e];
            u32x2 o; o.x = pk2bf(y[0], y[1]); o.y = pk2bf(y[2], y[3]); *(u32x2*)(A + (size_t)row * DM + d) = o; }
    }
}
__device__ __forceinline__ void phase_final_norm(const Params& p, float* Y, int wave, int lane) {
    const int gw = wave * gridDim.x + blockIdx.x, ngw = gridDim.x * NWAVES;
    for (int row = gw; row < NTOK; row += ngw) {
        f32x4 v[4]; float ss = 0.f;
#pragma unroll
        for (int j = 0; j < 4; ++j) { v[j] = *(const f32x4*)(Y + (size_t)row * DM + 4 * lane + 256 * j); ss += v[j][0] * v[j][0] + v[j][1] * v[j][1] + v[j][2] * v[j][2] + v[j][3] * v[j][3]; }
        const float rstd = rsqrtf(wave_sum(ss) * (1.0f / 1024.0f) + 1e-6f);
#pragma unroll
        for (int j = 0; j < 4; ++j) { const f32x4 w = *(const f32x4*)(p.norm_f + 4 * lane + 256 * j); *(f32x4*)(Y + (size_t)row * DM + 4 * lane + 256 * j) = v[j] * rstd * w; }
    }
}

__device__ __forceinline__ void unpack8(const v4u r, float (&f)[8]) { f[0] = bflo(r.x); f[1] = bfhi(r.x); f[2] = bflo(r.y); f[3] = bfhi(r.y); f[4] = bflo(r.z); f[5] = bfhi(r.z); f[6] = bflo(r.w); f[7] = bfhi(r.w); }
__device__ __forceinline__ void load8f(const float* p, float (&f)[8]) { const f32x4 a = *(const f32x4*)p, b = *(const f32x4*)(p + 4); f[0] = a[0]; f[1] = a[1]; f[2] = a[2]; f[3] = a[3]; f[4] = b[0]; f[5] = b[1]; f[6] = b[2]; f[7] = b[3]; }
__device__ __forceinline__ void phase_qkv_naive(const Params& p, const bf16_t* PROJ, const float* EX, float* QF, float* KF, float* VF, float* BG, bf16_t* YA, int wave, int lane) {
    const int gw = wave * gridDim.x + blockIdx.x, ngw = gridDim.x * NWAVES;
    const v4u zero4 = {0u, 0u, 0u, 0u};
    for (int tok = gw; tok < NTOK; tok += ngw) {
        const int pos = tok < NCTX ? (tok & 255) : ((tok - NCTX) & 63); const int L = tok < NCTX ? 256 : 64;
        const bool hasL = pos != 0, hasR = pos != L - 1;
#pragma unroll 1
        for (int grp = 0; grp < 6; ++grp) {
            const int part = grp >> 1, ch0 = (grp & 1) * 512 + lane * 8;
            const bf16_t* src = PROJ + (size_t)(3 + part) * BLK + (size_t)tok * DM + ch0;
            float c[8], l[8], r[8], w0[8], w1[8], w2[8], y[8];
            unpack8(*(const v4u*)src, c); unpack8(hasL ? *(const v4u*)(src - DM) : zero4, l); unpack8(hasR ? *(const v4u*)(src + DM) : zero4, r);
            const float* cw = p.dn_conv_w + part * 1024 + ch0;
            load8f(cw, w0); load8f(cw + 3072, w1); load8f(cw + 6144, w2);
            float ss = 0.f;
#pragma unroll
            for (int e = 0; e < 8; ++e) { y[e] = siluf(w0[e] * l[e] + w1[e] * c[e] + w2[e] * r[e]); ss += y[e] * y[e]; }
            if (part < 2) { const float sc = rsqrtf(sum16(ss) + 1e-6f) * (part == 0 ? 0.08838834764831845f : 1.0f);
#pragma unroll
                for (int e = 0; e < 8; ++e) y[e] *= sc; }
            float* dst = (part == 0 ? QF : part == 1 ? KF : VF) + (size_t)tok * DM + ch0;
            f32x4 o0 = {y[0], y[1], y[2], y[3]}, o1 = {y[4], y[5], y[6], y[7]};
            *(f32x4*)dst = o0; *(f32x4*)(dst + 4) = o1;
        }
#pragma unroll 1
        for (int grp = 0; grp < 2; ++grp) {
            const int ch0 = grp * 512 + lane * 8; const size_t o = (size_t)tok * DM + ch0;
            float bg[8], cc[8], cl[8], cr[8], xc[8], xl[8], xr[8], w0[8], w1[8], w2[8];
            unpack8(*(const v4u*)(PROJ + o), bg);
            unpack8(*(const v4u*)(PROJ + BLK + o), cc); unpack8(hasL ? *(const v4u*)(PROJ + BLK + o - DM) : zero4, cl); unpack8(hasR ? *(const v4u*)(PROJ + BLK + o + DM) : zero4, cr);
            unpack8(*(const v4u*)(PROJ + 2 * BLK + o), xc); unpack8(hasL ? *(const v4u*)(PROJ + 2 * BLK + o - DM) : zero4, xl); unpack8(hasR ? *(const v4u*)(PROJ + 2 * BLK + o + DM) : zero4, xr);
            load8f(p.conv_w + ch0, w0); load8f(p.conv_w + 1024 + ch0, w1); load8f(p.conv_w + 2048 + ch0, w2);
            float y[8];
#pragma unroll
            for (int e = 0; e < 8; ++e) y[e] = bg[e] * (w0[e] * cl[e] * xl[e] + w1[e] * cc[e] * xc[e] + w2[e] * cr[e] * xr[e]);
            v4u ov; ov.x = pk2bf(y[0], y[1]); ov.y = pk2bf(y[2], y[3]); ov.z = pk2bf(y[4], y[5]); ov.w = pk2bf(y[6], y[7]);
            *(v4u*)(YA + o) = ov;
        }
        if (lane < 16) {
            const float b_raw = EX[(size_t)tok * 32 + lane], a_raw = EX[(size_t)tok * 32 + 16 + lane];
            const float xx = a_raw + p.dn_dt_bias[lane]; const float sp = xx > 20.f ? xx : log1pf(expf(xx));
            BG[(size_t)tok * 32 + lane] = 1.f / (1.f + expf(-b_raw));
            BG[(size_t)tok * 32 + 16 + lane] = -expf(p.dn_a_log[lane]) * sp;
        }
    }
}

__device__ __forceinline__ void dn_naive_item(const Params& p, const float* QF, const float* KF, const float* VF, const float* BG, float* OF, float* OBk, float* lds, int item) {
    const bool lat = item < 32; const int j = lat ? item : item - 32; const int b = j >> 4, h = (j >> 1) & 7, dir = j & 1;
    const int T = lat ? 1024 : 256; const int tok0 = lat ? NCTX + b * 1024 : b * 256;
    const int tid = threadIdx.x, v = tid & 127, kq = tid >> 7;
    float* qs = lds; float* ks = lds + 128; float* vs = lds + 256; float* gb = lds + 384; float* red = lds + 512; float* red2 = lds + 1024;
    float S[32];
    if (lat) { const float* s0 = (dir ? p.st_b : p.st_f) + ((size_t)(b * 8 + h) * 128) * 128;
#pragma unroll
        for (int i = 0; i < 32; ++i) S[i] = s0[(size_t)(kq * 32 + i) * 128 + v]; }
    else {
#pragma unroll
        for (int i = 0; i < 32; ++i) S[i] = 0.f; }
    float* Od = dir ? OBk : OF;
    for (int t = 0; t < T; ++t) {
        const int tok = tok0 + (dir ? T - 1 - t : t);
        __syncthreads();
        if (tid < 128) qs[tid] = QF[(size_t)tok * DM + h * 128 + tid];
        else if (tid < 256) ks[tid - 128] = KF[(size_t)tok * DM + h * 128 + tid - 128];
        else if (tid < 384) vs[tid - 256] = VF[(size_t)tok * DM + h * 128 + tid - 256];
        else if (tid == 384) gb[0] = BG[(size_t)tok * 32 + dir * 8 + h];
        else if (tid == 385) gb[1] = BG[(size_t)tok * 32 + 16 + dir * 8 + h];
        __syncthreads();
        float part = 0.f;
#pragma unroll
        for (int i = 0; i < 32; ++i) part += ks[kq * 32 + i] * S[i];
        red[kq * 128 + v] = part;
        __syncthreads();
        const float kS = red[v] + red[128 + v] + red[256 + v] + red[384 + v];
        const float eg = expf(gb[1]), beta = gb[0];
        const float delta = beta * (vs[v] - eg * kS);
        float op = 0.f;
#pragma unroll
        for (int i = 0; i < 32; ++i) { S[i] = eg * S[i] + ks[kq * 32 + i] * delta; op += qs[kq * 32 + i] * S[i]; }
        red2[kq * 128 + v] = op;
        __syncthreads();
        if (kq == 0) Od[(size_t)tok * DM + h * 128 + v] = red2[v] + red2[128 + v] + red2[256 + v] + red2[384 + v];
    }
    if (!lat) { float* so = p.out + (size_t)NTOK * DM + (size_t)dir * (16 * 8 * 128 * 128) + ((size_t)(b * 8 + h) * 128) * 128;
#pragma unroll
        for (int i = 0; i < 32; ++i) so[(size_t)(kq * 32 + i) * 128 + v] = S[i]; }
}
__device__ __forceinline__ void phase_dn_naive(const Params& p, const float* QF, const float* KF, const float* VF, const float* BG, float* OF, float* OBk, float* lds) {
    const int bx = blockIdx.x;
    if (gridDim.x >= 256) {
        if (bx < 32) dn_naive_item(p, QF, KF, VF, BG, OF, OBk, lds, bx);
        else if (bx < 256) { dn_naive_item(p, QF, KF, VF, BG, OF, OBk, lds, bx); if (bx < 64) dn_naive_item(p, QF, KF, VF, BG, OF, OBk, lds, 224 + bx); }
    } else { for (int it = bx; it < 288; it += gridDim.x) dn_naive_item(p, QF, KF, VF, BG, OF, OBk, lds, it); }
}

typedef short bf16x8 __attribute__((ext_vector_type(8)));
typedef float f32x16 __attribute__((ext_vector_type(16)));
#define MFMA32(a, b, c) __builtin_amdgcn_mfma_f32_32x32x16_bf16((a), (b), (c), 0, 0, 0)
constexpr int DN_ITEM_BYTES = 73728, DN_W = 0, DN_QD = 16384, DN_KD = 32768, DN_A = 49152, DN_U = 57344;
constexpr int LS = 132;
constexpr int L_QF = 0, L_KF = 33792, L_VF = 67584, L_LM = 101376, L_CO = 134144;
__device__ __forceinline__ int crow16(int i, int hh) { return (i & 3) + 8 * (i >> 2) + 4 * hh; }
__device__ __forceinline__ bf16x8 frag_from_f32(const float* p) { const f32x4 a = *(const f32x4*)p, b = *(const f32x4*)(p + 4);
    v4u r; r.x = pk2bf(a[0], a[1]); r.y = pk2bf(a[2], a[3]); r.z = pk2bf(b[0], b[1]); r.w = pk2bf(b[2], b[3]); return __builtin_bit_cast(bf16x8, r); }
template <int S> __device__ __forceinline__ bf16x8 pack_step(const f32x16& x) {
    v4u r; r.x = pk2bf(x[8 * S + 0], x[8 * S + 1]); r.y = pk2bf(x[8 * S + 2], x[8 * S + 3]); r.z = pk2bf(x[8 * S + 4], x[8 * S + 5]); r.w = pk2bf(x[8 * S + 6], x[8 * S + 7]); return __builtin_bit_cast(bf16x8, r); }

__device__ __forceinline__ void dn_pre_item(const Params& p, const bf16_t* PROJ, const float* EX, unsigned char* DN, float* GL, unsigned char* lds, int sc, int h) {
    int tid_l = threadIdx.x; asm volatile("" : "+v"(tid_l));
    const int tid = tid_l, lane = tid & 63, wave = tid >> 6;
    const bool ctx = sc < 64; const int nn = ctx ? (sc & 3) : ((sc - 64) & 15);
    const int tok0 = ctx ? (sc >> 2) * 256 + 64 * nn : NCTX + ((sc - 64) >> 4) * 1024 + 64 * nn;
    float* QFl = (float*)(lds + L_QF); float* KFl = (float*)(lds + L_KF); float* VFl = (float*)(lds + L_VF); float* LM = (float*)(lds + L_LM);
    float* CB = (float*)(lds + L_CO);
    float* CG = CB + 128;
    float* CW = CB + 256;
    float* CE = CB + 384;
    float* CK = CB + 512;
    const v4u zero4 = {0u, 0u, 0u, 0u};
#pragma unroll 1
    for (int jj = 0; jj < 6; ++jj) {
        const int pr = tid + 512 * jj, c = pr / 48, cg = pr % 48, part = cg >> 4, d0 = (cg & 15) * 8;
        const bool hasL = c > 0 || (ctx && nn > 0), hasR = c < 63 || (ctx && nn < 3);
        const bf16_t* src = PROJ + (size_t)(3 + part) * BLK + (size_t)(tok0 + c) * DM + h * 128 + d0;
        float cc[8], l[8], r[8], w0[8], w1[8], w2[8], y[8];
        unpack8(*(const v4u*)src, cc); unpack8(hasL ? *(const v4u*)(src - DM) : zero4, l); unpack8(hasR ? *(const v4u*)(src + DM) : zero4, r);
        const float* cw = p.dn_conv_w + part * 1024 + h * 128 + d0;
        load8f(cw, w0); load8f(cw + 3072, w1); load8f(cw + 6144, w2);
        float ss = 0.f;
#pragma unroll
        for (int e = 0; e < 8; ++e) { y[e] = siluf(w0[e] * l[e] + w1[e] * cc[e] + w2[e] * r[e]); ss += y[e] * y[e]; }
        const float tot = sum16(ss);
        if (part < 2) { const float scl = rsqrtf(tot + 1e-6f) * (part == 0 ? 0.08838834764831845f : 1.0f);
#pragma unroll
            for (int e = 0; e < 8; ++e) y[e] *= scl; }
        float* dst = (part == 0 ? QFl : part == 1 ? KFl : VFl) + c * LS + d0;
        f32x4 o0 = {y[0], y[1], y[2], y[3]}, o1 = {y[4], y[5], y[6], y[7]};
        *(f32x4*)dst = o0; *(f32x4*)(dst + 4) = o1;
    }
    if (wave < 2) {
        const int d = wave, oc = d ? 63 - lane : lane; const size_t tk = (size_t)(tok0 + oc) * 32;
        const float b_raw = EX[tk + d * 8 + h], a_raw = EX[tk + 16 + d * 8 + h];
        const float xx = a_raw + p.dn_dt_bias[d * 8 + h]; const float sp = xx > 20.f ? xx : log1pf(expf(xx));
        const float beta = 1.f / (1.f + expf(-b_raw)); float g = -expf(p.dn_a_log[d * 8 + h]) * sp;
#pragma unroll
        for (int o = 1; o < 64; o <<= 1) { const float t = __shfl_up(g, o); if (lane >= o) g += t; }
        const float glast = __shfl(g, 63); const float eg = expf(g);
        CB[d * 64 + lane] = beta; CG[d * 64 + lane] = g; CW[d * 64 + lane] = beta * eg; CE[d * 64 + lane] = eg; CK[d * 64 + lane] = expf(glast - g);
        if (lane == 0) GL[(sc * 8 + h) * 2 + d] = expf(glast);
    }
    __syncthreads();
    const int dir = wave >> 2;
    unsigned char* item = DN + (size_t)((sc * 8 + h) * 2 + dir) * DN_ITEM_BYTES;
    {
        const int w4 = wave & 3, mt = w4 >> 1, nt = w4 & 1, r = lane & 31, hh = lane >> 5;
        const int ia = 32 * mt + r, ib = 32 * nt + r; const int ca = dir ? 63 - ia : ia, cb = dir ? 63 - ib : ib;
        f32x16 kk, pp;
#pragma unroll
        for (int i = 0; i < 16; ++i) { kk[i] = 0.f; pp[i] = 0.f; }
#pragma unroll
        for (int ks = 0; ks < 8; ++ks) {
            const bf16x8 ka = frag_from_f32(KFl + ca * LS + 16 * ks + 8 * hh), kb = frag_from_f32(KFl + cb * LS + 16 * ks + 8 * hh), qb = frag_from_f32(QFl + cb * LS + 16 * ks + 8 * hh);
            kk = MFMA32(ka, kb, kk); pp = MFMA32(ka, qb, pp);
        }
        const float* gcd = CG + dir * 64; const float* btd = CB + dir * 64;
        const float g_col = gcd[ib];
        f32x16 pv;
#pragma unroll
        for (int i = 0; i < 16; ++i) {
            const int row = 32 * mt + crow16(i, hh); const float g_row = gcd[row];
            LM[dir * 4096 + row * 64 + ib] = (ib < row) ? btd[row] * kk[i] * expf(g_row - g_col) : 0.f;
            pv[i] = (row <= ib) ? pp[i] * expf(g_col - g_row) : 0.f;
        }
        v4u* af = (v4u*)(item + DN_A);
        af[(nt * 4 + mt * 2 + 0) * 64 + lane] = __builtin_bit_cast(v4u, pack_step<0>(pv));
        af[(nt * 4 + mt * 2 + 1) * 64 + lane] = __builtin_bit_cast(v4u, pack_step<1>(pv));
    }
    __syncthreads();
    const int col = tid & 255, cc = col & 127; const bool isw = col >= 128;
    float x[64];
    {
        const float* srcm = isw ? KFl : VFl; const float* coef = (isw ? CW : CB) + dir * 64; const float* Lm = LM + dir * 4096;
#pragma unroll
        for (int c = 0; c < 64; ++c) {
            const int oc = dir ? 63 - c : c;
            float acc = srcm[oc * LS + cc] * coef[c];
#pragma unroll
            for (int s = 0; s < c; ++s) acc -= Lm[c * 64 + s] * x[s];
            x[c] = acc;
        }
        if (!isw) {
            const int jj = cc >> 5, n = cc & 31;
#pragma unroll
            for (int mt = 0; mt < 2; ++mt)
#pragma unroll
                for (int hh = 0; hh < 2; ++hh) {
                    v4u lo, hi;
                    lo.x = pk2bf(x[32 * mt + 4 * hh + 0], x[32 * mt + 4 * hh + 1]); lo.y = pk2bf(x[32 * mt + 4 * hh + 2], x[32 * mt + 4 * hh + 3]);
                    lo.z = pk2bf(x[32 * mt + 4 * hh + 8], x[32 * mt + 4 * hh + 9]); lo.w = pk2bf(x[32 * mt + 4 * hh + 10], x[32 * mt + 4 * hh + 11]);
                    hi.x = pk2bf(x[32 * mt + 4 * hh + 16], x[32 * mt + 4 * hh + 17]); hi.y = pk2bf(x[32 * mt + 4 * hh + 18], x[32 * mt + 4 * hh + 19]);
                    hi.z = pk2bf(x[32 * mt + 4 * hh + 24], x[32 * mt + 4 * hh + 25]); hi.w = pk2bf(x[32 * mt + 4 * hh + 26], x[32 * mt + 4 * hh + 27]);
                    v4u* dst = (v4u*)(item + DN_U + (size_t)(((jj * 2 + mt) * 64 + hh * 32 + n) * 32));
                    dst[0] = lo; dst[1] = hi;
                }
        }
    }
    __syncthreads();
    bf16_t* WL = (bf16_t*)(lds + L_VF);
    if (isw) {
#pragma unroll
        for (int c = 0; c < 64; ++c) WL[(dir * 64 + c) * LS + cc] = (bf16_t)(pk2bf(x[c], 0.f) & 0xffffu);
    }
    __syncthreads();
    {
        const int t = tid & 255; const float* ce = CE + dir * 64; const float* ck = CK + dir * 64;
#pragma unroll 1
        for (int q = 0; q < 4; ++q) {
            const int fl = t + 256 * q, f = fl >> 6, ln = fl & 63, r = ln & 31, hh = ln >> 5;
            {
                const int mt = f >> 3, ks8 = f & 7, cp = 32 * mt + r, oc = dir ? 63 - cp : cp, dkb = 16 * ks8 + 4 * hh;
                const u32x2 lo = *(const u32x2*)(WL + (dir * 64 + cp) * LS + dkb), hi = *(const u32x2*)(WL + (dir * 64 + cp) * LS + dkb + 8);
                v4u wv; wv.x = lo.x; wv.y = lo.y; wv.z = hi.x; wv.w = hi.y;
                ((v4u*)(item + DN_W))[f * 64 + ln] = wv;
                const f32x4 qa = *(const f32x4*)(QFl + oc * LS + dkb), qb = *(const f32x4*)(QFl + oc * LS + dkb + 8); const float e = ce[cp];
                v4u qv; qv.x = pk2bf(qa[0] * e, qa[1] * e); qv.y = pk2bf(qa[2] * e, qa[3] * e); qv.z = pk2bf(qb[0] * e, qb[1] * e); qv.w = pk2bf(qb[2] * e, qb[3] * e);
                ((v4u*)(item + DN_QD))[f * 64 + ln] = qv;
            }
            {
                const int mtK = f >> 2, kst = f & 3, dk = 32 * mtK + r, sb = 16 * kst + 4 * hh;
                float kv[8];
#pragma unroll
                for (int j = 0; j < 8; ++j) { const int sp = sb + (j & 3) + 8 * (j >> 2); const int os = dir ? 63 - sp : sp; kv[j] = KFl[os * LS + dk] * ck[sp]; }
                v4u kq; kq.x = pk2bf(kv[0], kv[1]); kq.y = pk2bf(kv[2], kv[3]); kq.z = pk2bf(kv[4], kv[5]); kq.w = pk2bf(kv[6], kv[7]);
                ((v4u*)(item + DN_KD))[f * 64 + ln] = kq;
            }
        }
    }
    __syncthreads();
}

__device__ __forceinline__ void phase_branch_a(const Params& p, const bf16_t* PROJ, bf16_t* YA, int wave, int lane) {
    const int gw = wave * gridDim.x + blockIdx.x, ngw = gridDim.x * NWAVES;
    const v4u zero4 = {0u, 0u, 0u, 0u};
    for (int tok = gw; tok < NTOK; tok += ngw) {
        const int pos = tok < NCTX ? (tok & 255) : ((tok - NCTX) & 63); const int L = tok < NCTX ? 256 : 64;
        const bool hasL = pos != 0, hasR = pos != L - 1;
#pragma unroll 1
        for (int grp = 0; grp < 2; ++grp) {
            const int ch0 = grp * 512 + lane * 8; const size_t o = (size_t)tok * DM + ch0;
            float bg[8], cc[8], cl[8], cr[8], xc[8], xl[8], xr[8], w0[8], w1[8], w2[8];
            unpack8(*(const v4u*)(PROJ + o), bg);
            unpack8(*(const v4u*)(PROJ + BLK + o), cc); unpack8(hasL ? *(const v4u*)(PROJ + BLK + o - DM) : zero4, cl); unpack8(hasR ? *(const v4u*)(PROJ + BLK + o + DM) : zero4, cr);
            unpack8(*(const v4u*)(PROJ + 2 * BLK + o), xc); unpack8(hasL ? *(const v4u*)(PROJ + 2 * BLK + o - DM) : zero4, xl); unpack8(hasR ? *(const v4u*)(PROJ + 2 * BLK + o + DM) : zero4, xr);
            load8f(p.conv_w + ch0, w0); load8f(p.conv_w + 1024 + ch0, w1); load8f(p.conv_w + 2048 + ch0, w2);
            float y[8];
#pragma unroll
            for (int e = 0; e < 8; ++e) y[e] = bg[e] * (w0[e] * cl[e] * xl[e] + w1[e] * cc[e] * xc[e] + w2[e] * cr[e] * xr[e]);
            v4u ov; ov.x = pk2bf(y[0], y[1]); ov.y = pk2bf(y[2], y[3]); ov.z = pk2bf(y[4], y[5]); ov.w = pk2bf(y[6], y[7]);
            *(v4u*)(YA + o) = ov;
        }
    }
}

__device__ __forceinline__ void dn_scan_item(const Params& p, const unsigned char* DN, const float* GL, float* OF, float* OBk, int it, int lane) {
    const bool lat = it < 128; const int q = lat ? it : it - 128;
    const int jj = q & 3, dir = (q >> 2) & 1, h = (q >> 3) & 7, b = q >> 6;
    const int nch = lat ? 16 : 4, scb = lat ? 64 + 16 * b : 4 * b, tokb = lat ? NCTX + b * 1024 : b * 256;
    const int n = lane & 31, hh = lane >> 5;
    f32x16 S[4];
    if (lat) { const float* s0 = (dir ? p.st_b : p.st_f) + (size_t)(b * 8 + h) * 16384 + 32 * jj + n;
#pragma unroll
        for (int m = 0; m < 4; ++m)
#pragma unroll
            for (int i = 0; i < 16; ++i) S[m][i] = s0[(size_t)(32 * m + crow16(i, hh)) * 128]; }
    else {
#pragma unroll
        for (int m = 0; m < 4; ++m)
#pragma unroll
            for (int i = 0; i < 16; ++i) S[m][i] = 0.f; }
    float* Od = (dir ? OBk : OF) + h * 128 + 32 * jj + n;
#pragma unroll 1
    for (int ci = 0; ci < nch; ++ci) {
        const int no = dir ? nch - 1 - ci : ci; const int id = ((scb + no) * 8 + h) * 2 + dir;
        const unsigned char* item = DN + (size_t)id * DN_ITEM_BYTES;
        const v4u* Wf = (const v4u*)(item + DN_W) + lane; const v4u* Qf = (const v4u*)(item + DN_QD) + lane; const v4u* Kf = (const v4u*)(item + DN_KD) + lane; const v4u* Af = (const v4u*)(item + DN_A) + lane;
        const float gl = GL[id];
        bf16x8 Sb[8];
        Sb[0] = pack_step<0>(S[0]); Sb[1] = pack_step<1>(S[0]); Sb[2] = pack_step<0>(S[1]); Sb[3] = pack_step<1>(S[1]);
        Sb[4] = pack_step<0>(S[2]); Sb[5] = pack_step<1>(S[2]); Sb[6] = pack_step<0>(S[3]); Sb[7] = pack_step<1>(S[3]);
        f32x16 vn[2], o[2];
#pragma unroll
        for (int mt = 0; mt < 2; ++mt) {
            f32x16 ws;
#pragma unroll
            for (int i = 0; i < 16; ++i) { ws[i] = 0.f; o[mt][i] = 0.f; }
#pragma unroll
            for (int ks = 0; ks < 8; ++ks) { ws = MFMA32(__builtin_bit_cast(bf16x8, Wf[(mt * 8 + ks) * 64]), Sb[ks], ws); o[mt] = MFMA32(__builtin_bit_cast(bf16x8, Qf[(mt * 8 + ks) * 64]), Sb[ks], o[mt]); }
            const v4u* up = (const v4u*)(item + DN_U + (size_t)(((jj * 2 + mt) * 64 + lane) * 32));
            const v4u u0 = up[0], u1 = up[1];
            vn[mt][0] = bflo(u0.x) - ws[0]; vn[mt][1] = bfhi(u0.x) - ws[1]; vn[mt][2] = bflo(u0.y) - ws[2]; vn[mt][3] = bfhi(u0.y) - ws[3];
            vn[mt][4] = bflo(u0.z) - ws[4]; vn[mt][5] = bfhi(u0.z) - ws[5]; vn[mt][6] = bflo(u0.w) - ws[6]; vn[mt][7] = bfhi(u0.w) - ws[7];
            vn[mt][8] = bflo(u1.x) - ws[8]; vn[mt][9] = bfhi(u1.x) - ws[9]; vn[mt][10] = bflo(u1.y) - ws[10]; vn[mt][11] = bfhi(u1.y) - ws[11];
            vn[mt][12] = bflo(u1.z) - ws[12]; vn[mt][13] = bfhi(u1.z) - ws[13]; vn[mt][14] = bflo(u1.w) - ws[14]; vn[mt][15] = bfhi(u1.w) - ws[15];
        }
        bf16x8 Vb[4];
        Vb[0] = pack_step<0>(vn[0]); Vb[1] = pack_step<1>(vn[0]); Vb[2] = pack_step<0>(vn[1]); Vb[3] = pack_step<1>(vn[1]);
#pragma unroll
        for (int mt = 0; mt < 2; ++mt)
#pragma unroll
            for (int kst = 0; kst < 4; ++kst) o[mt] = MFMA32(__builtin_bit_cast(bf16x8, Af[(mt * 4 + kst) * 64]), Vb[kst], o[mt]);
#pragma unroll
        for (int m = 0; m < 4; ++m) {
#pragma unroll
            for (int i = 0; i < 16; ++i) S[m][i] *= gl;
#pragma unroll
            for (int kst = 0; kst < 4; ++kst) S[m] = MFMA32(__builtin_bit_cast(bf16x8, Kf[(m * 4 + kst) * 64]), Vb[kst], S[m]);
        }
        const int tok0 = tokb + 64 * no;
#pragma unroll
        for (int mt = 0; mt < 2; ++mt)
#pragma unroll
            for (int i = 0; i < 16; ++i) { const int cp = 32 * mt + crow16(i, hh); const int oc = dir ? 63 - cp : cp; Od[(size_t)(tok0 + oc) * DM] = o[mt][i]; }
    }
    if (!lat) { float* so = p.out + (size_t)NTOK * DM + (size_t)dir * (16 * 8 * 128 * 128) + (size_t)(b * 8 + h) * 16384 + 32 * jj + n;
#pragma unroll
        for (int m = 0; m < 4; ++m)
#pragma unroll
            for (int i = 0; i < 16; ++i) so[(size_t)(32 * m + crow16(i, hh)) * 128] = S[m][i]; }
}

constexpr int SC_BUF = 57344;
__device__ __forceinline__ void dn_scan_group(const Params& p, const unsigned char* DN, const float* GL, float* OF, float* OBk, unsigned char* lds, int grp) {
    int tid_l = threadIdx.x; asm volatile("" : "+v"(tid_l));
    const int tid = tid_l, lane = tid & 63, wave = __builtin_amdgcn_readfirstlane(tid >> 6);
    const bool lat = grp < 32; const int q = lat ? grp : grp - 32;
    const int dir = q & 1, h = (q >> 1) & 7, b = q >> 4;
    const int nch = lat ? 16 : 4, scb = lat ? 64 + 16 * b : 4 * b, tokb = lat ? NCTX + b * 1024 : b * 256;
    if (wave >= 4) {
        const int lt = tid - 256;
        v4u r[14];
        {   const v4u* src = (const v4u*)(DN + (size_t)(((scb + (dir ? nch - 1 : 0)) * 8 + h) * 2 + dir) * DN_ITEM_BYTES) + lt;
#pragma unroll
            for (int k = 0; k < 14; ++k) r[k] = src[256 * k];
            v4u* dst = (v4u*)lds + lt;
#pragma unroll
            for (int k = 0; k < 14; ++k) dst[256 * k] = r[k]; }
        {   const v4u* src = (const v4u*)(DN + (size_t)(((scb + (dir ? nch - 2 : 1)) * 8 + h) * 2 + dir) * DN_ITEM_BYTES) + lt;
#pragma unroll
            for (int k = 0; k < 14; ++k) r[k] = src[256 * k]; }
        __syncthreads();
#pragma unroll 1
        for (int ci = 0; ci < nch; ++ci) {
            if (ci + 1 < nch) { v4u* dst = (v4u*)(lds + ((ci + 1) & 1) * SC_BUF) + lt;
#pragma unroll
                for (int k = 0; k < 14; ++k) dst[256 * k] = r[k]; }
            if (ci + 2 < nch) { const int no = dir ? nch - 3 - ci : ci + 2;
                const v4u* src = (const v4u*)(DN + (size_t)(((scb + no) * 8 + h) * 2 + dir) * DN_ITEM_BYTES) + lt;
#pragma unroll
                for (int k = 0; k < 14; ++k) r[k] = src[256 * k]; }
            __syncthreads();
        }
    } else {
        const int jj = wave, n = lane & 31, hh = lane >> 5;
        f32x16 S[4];
        if (lat) { const float* s0 = (dir ? p.st_b : p.st_f) + (size_t)(b * 8 + h) * 16384 + 32 * jj + n;
#pragma unroll
            for (int m = 0; m < 4; ++m)
#pragma unroll
                for (int i = 0; i < 16; ++i) S[m][i] = s0[(size_t)(32 * m + crow16(i, hh)) * 128]; }
        else {
#pragma unroll
            for (int m = 0; m < 4; ++m)
#pragma unroll
                for (int i = 0; i < 16; ++i) S[m][i] = 0.f; }
        float* Od = (dir ? OBk : OF) + h * 128 + 32 * jj + n;
        v4u un[4]; float gln;
        {   const int id0 = ((scb + (dir ? nch - 1 : 0)) * 8 + h) * 2 + dir; const unsigned char* it0 = DN + (size_t)id0 * DN_ITEM_BYTES + DN_U;
            const v4u* u0 = (const v4u*)(it0 + (size_t)(((jj * 2 + 0) * 64 + lane) * 32)); const v4u* u1 = (const v4u*)(it0 + (size_t)(((jj * 2 + 1) * 64 + lane) * 32));
            un[0] = u0[0]; un[1] = u0[1]; un[2] = u1[0]; un[3] = u1[1]; gln = GL[id0]; }
        __syncthreads();
#pragma unroll 1
        for (int ci = 0; ci < nch; ++ci) {
            const int no = dir ? nch - 1 - ci : ci;
            const float gl = gln;
            const unsigned char* buf = lds + (ci & 1) * SC_BUF;
            const v4u* Wf = (const v4u*)(buf + DN_W) + lane; const v4u* Qf = (const v4u*)(buf + DN_QD) + lane; const v4u* Kf = (const v4u*)(buf + DN_KD) + lane; const v4u* Af = (const v4u*)(buf + DN_A) + lane;
            f32x16 vn[2], o[2];
            {
                bf16x8 Sb[8];
                Sb[0] = pack_step<0>(S[0]); Sb[1] = pack_step<1>(S[0]); Sb[2] = pack_step<0>(S[1]); Sb[3] = pack_step<1>(S[1]);
                Sb[4] = pack_step<0>(S[2]); Sb[5] = pack_step<1>(S[2]); Sb[6] = pack_step<0>(S[3]); Sb[7] = pack_step<1>(S[3]);
#pragma unroll
                for (int mt = 0; mt < 2; ++mt) {
                    f32x16 ws;
#pragma unroll
                    for (int i = 0; i < 16; ++i) { ws[i] = 0.f; o[mt][i] = 0.f; }
#pragma unroll
                    for (int ks = 0; ks < 8; ++ks) { ws = MFMA32(__builtin_bit_cast(bf16x8, Wf[(mt * 8 + ks) * 64]), Sb[ks], ws); o[mt] = MFMA32(__builtin_bit_cast(bf16x8, Qf[(mt * 8 + ks) * 64]), Sb[ks], o[mt]); }
                    const v4u u0 = un[2 * mt], u1 = un[2 * mt + 1];
                    vn[mt][0] = bflo(u0.x) - ws[0]; vn[mt][1] = bfhi(u0.x) - ws[1]; vn[mt][2] = bflo(u0.y) - ws[2]; vn[mt][3] = bfhi(u0.y) - ws[3];
                    vn[mt][4] = bflo(u0.z) - ws[4]; vn[mt][5] = bfhi(u0.z) - ws[5]; vn[mt][6] = bflo(u0.w) - ws[6]; vn[mt][7] = bfhi(u0.w) - ws[7];
                    vn[mt][8] = bflo(u1.x) - ws[8]; vn[mt][9] = bfhi(u1.x) - ws[9]; vn[mt][10] = bflo(u1.y) - ws[10]; vn[mt][11] = bfhi(u1.y) - ws[11];
                    vn[mt][12] = bflo(u1.z) - ws[12]; vn[mt][13] = bfhi(u1.z) - ws[13]; vn[mt][14] = bflo(u1.w) - ws[14]; vn[mt][15] = bfhi(u1.w) - ws[15];
                    __builtin_amdgcn_sched_barrier(0);
                }
            }
            if (ci + 1 < nch) { const int no1 = dir ? nch - 2 - ci : ci + 1; const int id1 = ((scb + no1) * 8 + h) * 2 + dir; const unsigned char* it1 = DN + (size_t)id1 * DN_ITEM_BYTES + DN_U;
                const v4u* u0 = (const v4u*)(it1 + (size_t)(((jj * 2 + 0) * 64 + lane) * 32)); const v4u* u1 = (const v4u*)(it1 + (size_t)(((jj * 2 + 1) * 64 + lane) * 32));
                un[0] = u0[0]; un[1] = u0[1]; un[2] = u1[0]; un[3] = u1[1]; gln = GL[id1]; }
            bf16x8 Vb[4];
            Vb[0] = pack_step<0>(vn[0]); Vb[1] = pack_step<1>(vn[0]); Vb[2] = pack_step<0>(vn[1]); Vb[3] = pack_step<1>(vn[1]);
            __builtin_amdgcn_sched_barrier(0);
#pragma unroll
            for (int mt = 0; mt < 2; ++mt)
#pragma unroll
                for (int kst = 0; kst < 4; ++kst) o[mt] = MFMA32(__builtin_bit_cast(bf16x8, Af[(mt * 4 + kst) * 64]), Vb[kst], o[mt]);
            const int tok0 = tokb + 64 * no;
#pragma unroll
            for (int mt = 0; mt < 2; ++mt)
#pragma unroll
                for (int i = 0; i < 16; ++i) { const int cp = 32 * mt + crow16(i, hh); const int oc = dir ? 63 - cp : cp; Od[(size_t)(tok0 + oc) * DM] = o[mt][i]; }
            __builtin_amdgcn_sched_barrier(0);
#pragma unroll
            for (int m = 0; m < 4; ++m) {
#pragma unroll
                for (int i = 0; i < 16; ++i) S[m][i] *= gl;
#pragma unroll
                for (int kst = 0; kst < 4; ++kst) S[m] = MFMA32(__builtin_bit_cast(bf16x8, Kf[(m * 4 + kst) * 64]), Vb[kst], S[m]);
            }
            __builtin_amdgcn_sched_barrier(0);
            __syncthreads();
        }
        if (!lat) { float* so = p.out + (size_t)NTOK * DM + (size_t)dir * (16 * 8 * 128 * 128) + (size_t)(b * 8 + h) * 16384 + 32 * jj + n;
#pragma unroll
            for (int m = 0; m < 4; ++m)
#pragma unroll
                for (int i = 0; i < 16; ++i) so[(size_t)(32 * m + crow16(i, hh)) * 128] = S[m][i]; }
    }
}
__device__ __forceinline__ void phase_dn_scan(const Params& p, const unsigned char* DN, const float* GL, float* OF, float* OBk, unsigned char* lds) {
    const int bx = blockIdx.x;
    if (gridDim.x >= 256) {
        const int ng = (bx >= 32 && bx < 64) ? 2 : 1;
#pragma unroll 1
        for (int gi = 0; gi < ng; ++gi) dn_scan_group(p, DN, GL, OF, OBk, lds, gi ? 224 + bx : bx);
    } else { for (int g = bx; g < 288; g += gridDim.x) dn_scan_group(p, DN, GL, OF, OBk, lds, g); }
}

__device__ __forceinline__ void phase_ogate(const Params& p, const float* OF, const float* OBk, const bf16_t* Z, bf16_t* OG, int wave, int lane) {
    const int gw = wave * gridDim.x + blockIdx.x, ngw = gridDim.x * NWAVES;
    for (int tok = gw; tok < NTOK; tok += ngw) {
#pragma unroll
        for (int hf = 0; hf < 2; ++hf) {
            const int ch0 = hf * 512 + lane * 8; const size_t o = (size_t)tok * DM + ch0;
            float a[8], b2[8], z[8], nw[8];
            load8f(OF + o, a); load8f(OBk + o, b2); unpack8(*(const v4u*)(Z + o), z); load8f(p.dn_norm_w + (ch0 & 127), nw);
            float ss = 0.f;
#pragma unroll
            for (int e = 0; e < 8; ++e) { a[e] += b2[e]; ss += a[e] * a[e]; }
            const float r = rsqrtf(sum16(ss) * (1.0f / 128.0f) + 1e-6f);
            float y[8];
#pragma unroll
            for (int e = 0; e < 8; ++e) y[e] = a[e] * r * nw[e] * siluf(z[e]);
            v4u ov; ov.x = pk2bf(y[0], y[1]); ov.y = pk2bf(y[2], y[3]); ov.z = pk2bf(y[4], y[5]); ov.w = pk2bf(y[6], y[7]);
            *(v4u*)(OG + o) = ov;
        }
    }
}

template <class Epi> __device__ __forceinline__ void run_gemm(PG8_LAS unsigned char* lds, const bf16_t* A, const bf16_t* Bt, int N, int K, const Epi& E, int nrep) {
    pg8::Gemm g; g.A = A; g.Bt = Bt; g.M = NTOK; g.N = N; g.K = K;
    pg8::StaticOrder S; S.init(NTOK, N, (int)gridDim.x, (int)blockIdx.x);
    pg8::gemm_phase<Epi, pg8::StaticOrder, false>(lds, g, S, E, nullptr);
    __syncthreads();
}

__global__ void __launch_bounds__(512) fwd_megakernel(Params p) {
    extern __shared__ __attribute__((aligned(16))) unsigned char shm[];
    cg::grid_group grid = cg::this_grid();
    PG8_LAS unsigned char* lds3 = (PG8_LAS unsigned char*)shm;
    const int wave = __builtin_amdgcn_readfirstlane(threadIdx.x >> 6), lane = threadIdx.x & 63;
    unsigned char* ws = p.ws;
    volatile XLAS unsigned* xst = (volatile XLAS unsigned*)(lds3 + (LDS_BYTES - 16));
    if (threadIdx.x == 0) { xst[0] = 0u; xst[1] = 0u; }
    __syncthreads();
    XcdBarrier xb = xcd_barrier_post((unsigned*)(ws + OFF_BAR), xst);
    float* X0 = (float*)(ws + OFF_X0); float* X1 = (float*)(ws + OFF_X1); float* MOD = (float*)(ws + OFF_MOD);
    bf16_t* PROJ = (bf16_t*)(ws + OFF_PROJ); float* EX = (float*)(ws + OFF_EX);
    bf16_t* AM = (bf16_t*)p.out;
    bf16_t* HB = (bf16_t*)(ws + OFF_PROJ);
    float* QF = (float*)(ws + OFF_DN); float* KF = QF + BLK; float* VF = KF + BLK; float* BG = VF + BLK;
    float* OF = (float*)(ws + OFF_PROJ); float* OBk = OF + BLK;
    bf16_t* OG = PROJ + 4 * BLK; bf16_t* MRG = PROJ + 5 * BLK; float* GLp = (float*)(ws + OFF_EX + 786432);

#pragma unroll 1
    for (int rep = 0; rep < p.rep_prep; ++rep) { phase_prep(p, shm, wave, lane); __syncthreads(); }
    xcd_barrier(xb);
#pragma unroll 1
    for (int rep = 0; rep < p.rep_thin; ++rep) phase_norm<true>(p, nullptr, X0, p.norm_ffn1, 0, AM, wave, lane);
    xcd_barrier(xb);
    { pg8::EpiSwiglu E; E.H = HB; run_gemm(lds3, AM, (const bf16_t*)(ws + OFF_WGU), 5632, 1024, E, p.rep_gemm); }
    xcd_barrier(xb);
    { pg8::EpiResid E; E.Xin = X0; E.Xout = X1; E.gate = MOD + 2 * 1024; E.scale = 0.5f; run_gemm(lds3, HB, (const bf16_t*)(ws + OFF_WD), 1024, FFH, E, p.rep_gemm); }
    xcd_barrier(xb);
#pragma unroll 1
    for (int rep = 0; rep < p.rep_thin; ++rep) phase_norm<false>(p, X1, nullptr, p.norm_mix, 3, AM, wave, lane);
    xcd_barrier(xb);
    { pg8::EpiProj E; E.P = PROJ; E.EX = EX; run_gemm(lds3, AM, (const bf16_t*)(ws + OFF_WIN), 9472, 1024, E, p.rep_gemm); }
    xcd_barrier(xb);
#pragma unroll 1
    for (int rep = 0; rep < p.rep_dnpre; ++rep) for (int it = blockIdx.x; it < 768; it += gridDim.x) dn_pre_item(p, PROJ, EX, ws + OFF_DN, GLp, shm, it >> 3, it & 7);
#pragma unroll 1
    for (int rep = 0; rep < p.rep_thin; ++rep) phase_branch_a(p, PROJ, AM, wave, lane);
    xcd_barrier(xb);
#pragma unroll 1
    for (int rep = 0; rep < p.rep_scan; ++rep) phase_dn_scan(p, ws + OFF_DN, GLp, OF, OBk, shm);
    xcd_barrier(xb);
#pragma unroll 1
    for (int rep = 0; rep < p.rep_thin; ++rep) phase_ogate(p, OF, OBk, PROJ + 6 * BLK, OG, wave, lane);
    {
        float* scr = (float*)shm + wave * (64 * 33); const int gw = wave * gridDim.x + blockIdx.x, ngw = gridDim.x * NWAVES;
        transpose_matrix(p.f2g, 1024, FFH, (bf16_t*)(ws + OFF_WGU), 1, gw, ngw, scr, lane);
        transpose_matrix(p.f2u, 1024, FFH, (bf16_t*)(ws + OFF_WGU), 2, gw, ngw, scr, lane);
        transpose_matrix(p.f2d, FFH, 1024, (bf16_t*)(ws + OFF_WD), 0, gw, ngw, scr, lane);
        __syncthreads();
    }
    xcd_barrier(xb);
    { pg8::EpiGate<0> E; E.G = PROJ + 7 * BLK; E.T = X0; E.O = nullptr; run_gemm(lds3, AM, (const bf16_t*)(ws + OFF_WCO), 1024, 1024, E, p.rep_gemm); }
    { pg8::EpiGate<1> E; E.G = PROJ + 8 * BLK; E.T = X0; E.O = MRG; run_gemm(lds3, OG, (const bf16_t*)(ws + OFF_WDNO), 1024, 1024, E, p.rep_gemm); }
    xcd_barrier(xb);
    { pg8::EpiResid E; E.Xin = X1; E.Xout = X0; E.gate = MOD + 5 * 1024; E.scale = 1.0f; run_gemm(lds3, MRG, (const bf16_t*)(ws + OFF_WO), 1024, 1024, E, p.rep_gemm); }
    xcd_barrier(xb);
#pragma unroll 1
    for (int rep = 0; rep < p.rep_thin; ++rep) phase_norm<false>(p, X0, nullptr, p.norm_ffn2, 6, AM, wave, lane);
    xcd_barrier(xb);
    { pg8::EpiSwiglu E; E.H = HB; run_gemm(lds3, AM, (const bf16_t*)(ws + OFF_WGU), 5632, 1024, E, p.rep_gemm); }
    xcd_barrier(xb);
    { pg8::EpiResid E; E.Xin = X0; E.Xout = p.out; E.gate = MOD + 8 * 1024; E.scale = 0.5f; run_gemm(lds3, HB, (const bf16_t*)(ws + OFF_WD), 1024, FFH, E, p.rep_gemm); }
    xcd_barrier(xb);
#pragma unroll 1
    for (int rep = 0; rep < p.rep_sync; ++rep) grid.sync();
    phase_final_norm(p, p.out, wave, lane);
}

extern "C" void kernel_launch(void* const* d_in, const int* in_sizes, int n_in, void* d_out, int out_size, void* d_ws, size_t ws_size, hipStream_t stream) {
    static int grid_blocks = 0;
    if (grid_blocks == 0) {
        if (n_in != 27 || ws_size < WS_NEED) { fprintf(stderr, "kernel_launch: unexpected n_in %d / ws %zu\n", n_in, ws_size); grid_blocks = -1; return; }
        int dev = 0, cus = 0, per_cu = 0;
        hipGetDevice(&dev); hipDeviceGetAttribute(&cus, hipDeviceAttributeMultiprocessorCount, dev);
        hipFuncSetAttribute((const void*)fwd_megakernel, hipFuncAttributeMaxDynamicSharedMemorySize, LDS_BYTES);
        hipOccupancyMaxActiveBlocksPerMultiprocessor(&per_cu, (const void*)fwd_megakernel, 512, LDS_BYTES);
        if (per_cu < 1) { fprintf(stderr, "kernel_launch: occupancy query says %d blocks/CU\n", per_cu); per_cu = 1; }
        (void)hipGetLastError();
        grid_blocks = cus;
    }
    if (grid_blocks < 0) return;
    Params p{};
    const float** f = (const float**)&p;
    for (int i = 0; i < 27; ++i) f[i] = (const float*)d_in[i];
    p.out = (float*)d_out; p.ws = (unsigned char*)d_ws; p.rep_prep = REP_PREP; p.rep_gemm = REP_GEMM; p.rep_dnpre = REP_DNPRE; p.rep_scan = REP_SCAN; p.rep_thin = REP_THIN; p.rep_sync = REP_SYNC;
    (void)hipMemsetAsync((unsigned char*)d_ws + OFF_BAR, 0, XCD_BAR_WORDS * sizeof(unsigned), stream);
    void* args[] = {&p};
    hipError_t e = hipLaunchCooperativeKernel((const void*)fwd_megakernel, dim3(grid_blocks), dim3(512), args, LDS_BYTES, stream);
    if (e != hipSuccess) fprintf(stderr, "cooperative launch failed: %s (grid %d)\n", hipGetErrorString(e), grid_blocks);
}
```

```cpp
#include <hip/hip_runtime.h>
#include <hip/hip_cooperative_groups.h>
#include <cstdio>
#include <cstdint>
namespace cg = cooperative_groups;
#define REP_PREP 1
#define REP_GEMM 1
#define REP_DNPRE 1
#define REP_SCAN 1
#define REP_THIN 1
#define REP_SYNC 0
namespace pg8 {
#define PG8_LAS __attribute__((address_space(3)))
typedef unsigned short bf16_t;
typedef short bf16x8 __attribute__((ext_vector_type(8)));
typedef float f32x4 __attribute__((ext_vector_type(4)));
typedef unsigned u32x4 __attribute__((ext_vector_type(4)));
constexpr int BM = 256, BK = 64, HALF = 128, HTB = HALF * BK * 2  , STAGE_BYTES = 8 * HTB, NXCD = 8, WGM = 8;

__host__ __device__ __forceinline__ int lds_byte(int r, int c) { const int st = (r >> 4) * 2 + (c >> 5), rr = r & 15, cc = c & 31, ob = rr * 64 + cc * 2; return st * 1024 + (ob ^ (((ob >> 9) & 1) << 5)); }
__host__ __device__ __forceinline__ void stage_rc(int b, int& R, int& C) { const int st = b / 1024, sb = b % 1024, swz = sb ^ (((sb >> 9) & 1) << 5); R = (st >> 1) * 16 + swz / 64; C = (st & 1) * 32 + (swz % 64) / 2; }
__host__ __device__ __forceinline__ int perm32(int rho) { const int n = rho >> 4, i = rho & 15; return 8 * (i >> 2) + 4 * n + (i & 3); }

struct Unit { int pm, pn; };
struct Gemm { const bf16_t* A; const bf16_t* Bt; int M, N, K; int klen, nsp; };

struct StaticOrder {
    int nM, nN, nwg, G, c;
    __host__ __device__ void init(int M, int N, int G_, int c_) { nM = M / BM; nN = N / BM; nwg = nM * nN; G = G_; c = c_; }
    __host__ __device__ bool next(int i, Unit& u) const {
        const long L = (long)i * G + c; if (L >= nwg) return false;
        int wgid = (int)L; { const int q = nwg / NXCD, r = nwg % NXCD, xcd = wgid % NXCD, off = wgid / NXCD; wgid = (xcd < r ? xcd * (q + 1) : r * (q + 1) + (xcd - r) * q) + off; }
        const int nig = WGM * nN, gid = wgid / nig, fm = gid * WGM, gsz = (nM - fm) < WGM ? (nM - fm) : WGM;
        u.pm = fm + ((wgid % nig) % gsz); u.pn = (wgid % nig) / gsz; return true;
    }
    __device__ __forceinline__ void a_ready(const Unit&) const {}
    __device__ __forceinline__ void done(const Unit&) const {}
};
__device__ __forceinline__ unsigned pk2bf(float a, float b) { typedef float f2v __attribute__((ext_vector_type(2))); typedef __bf16 b2v __attribute__((ext_vector_type(2))); f2v v = {a, b}; b2v r = __builtin_convertvector(v, b2v); return __builtin_bit_cast(unsigned, r); }
__device__ __forceinline__ float bflo(unsigned u) { return __uint_as_float(u << 16); }
__device__ __forceinline__ float bfhi(unsigned u) { return __uint_as_float(u & 0xffff0000u); }
__device__ __forceinline__ float siluf(float x) { return x / (1.f + __expf(-x)); }
__device__ __forceinline__ float sigmf(float x) { return 1.f / (1.f + __expf(-x)); }
__device__ __forceinline__ int cond_of_tile(int pm) { return pm < 16 ? 0 : 1 + ((pm - 16) >> 2); }
constexpr int NTOK = 6144, DM = 1024, FFH = 2816, NMOD = 9216;
typedef unsigned u32x2 __attribute__((ext_vector_type(2)));

struct EpiSwiglu {
    static constexpr bool PERM = false, AFTER_DRAIN = false;
    bf16_t* H;
    __device__ __forceinline__ void operator()(const f32x4 (&acc)[2][2][4][2], const Unit& u, int wr, int wc, int fr, int fq) const {
        const int row0 = u.pm * BM + wr * 64 + fr, col0 = u.pn * 128 + wc * 32 + 4 * fq;
#pragma unroll
        for (int ai = 0; ai < 2; ++ai)
#pragma unroll
            for (int m = 0; m < 4; ++m) { bf16_t* rowp = H + (size_t)(row0 + ai * HALF + m * 16) * FFH + col0;
#pragma unroll
                for (int n = 0; n < 2; ++n) { const f32x4 g = acc[ai][0][m][n], up = acc[ai][1][m][n];
                    u32x2 o; o.x = pk2bf(siluf(g[0]) * up[0], siluf(g[1]) * up[1]); o.y = pk2bf(siluf(g[2]) * up[2], siluf(g[3]) * up[3]);
                    *(u32x2*)(rowp + n * 16) = o; } }
    }
};
struct EpiResid {
    static constexpr bool PERM = false, AFTER_DRAIN = false;
    const float* Xin; float* Xout; const float* gate; float scale;
    __device__ __forceinline__ void operator()(const f32x4 (&acc)[2][2][4][2], const Unit& u, int wr, int wc, int fr, int fq) const {
        const int row0 = u.pm * BM + wr * 64 + fr, col0 = u.pn * BM + wc * 32 + 4 * fq;
        const float* gp = gate + (size_t)cond_of_tile(u.pm) * NMOD + col0;
        f32x4 gv[2][2];
#pragma unroll
        for (int bj = 0; bj < 2; ++bj)
#pragma unroll
            for (int n = 0; n < 2; ++n) gv[bj][n] = *(const f32x4*)(gp + bj * HALF + n * 16) * scale;
#pragma unroll
        for (int ai = 0; ai < 2; ++ai)
#pragma unroll
            for (int m = 0; m < 4; ++m) { const size_t off = (size_t)(row0 + ai * HALF + m * 16) * DM + col0;
#pragma unroll
                for (int bj = 0; bj < 2; ++bj)
#pragma unroll
                    for (int n = 0; n < 2; ++n) { const f32x4 x = *(const f32x4*)(Xin + off + bj * HALF + n * 16);
                        *(f32x4*)(Xout + off + bj * HALF + n * 16) = x + gv[bj][n] * acc[ai][bj][m][n]; } }
    }
};
struct EpiProj {
    static constexpr bool PERM = false, AFTER_DRAIN = false;
    bf16_t* P; float* EX;
    __device__ __forceinline__ void operator()(const f32x4 (&acc)[2][2][4][2], const Unit& u, int wr, int wc, int fr, int fq) const {
        const int row0 = u.pm * BM + wr * 64 + fr;
        if (u.pn < 36) {
            bf16_t* base = P + (size_t)(u.pn >> 2) * NTOK * DM; const int col0 = (u.pn & 3) * 256 + wc * 32 + 4 * fq;
#pragma unroll
            for (int ai = 0; ai < 2; ++ai)
#pragma unroll
                for (int m = 0; m < 4; ++m) { bf16_t* rowp = base + (size_t)(row0 + ai * HALF + m * 16) * DM + col0;
#pragma unroll
                    for (int bj = 0; bj < 2; ++bj)
#pragma unroll
                        for (int n = 0; n < 2; ++n) { const f32x4 v = acc[ai][bj][m][n]; u32x2 o; o.x = pk2bf(v[0], v[1]); o.y = pk2bf(v[2], v[3]); *(u32x2*)(rowp + bj * HALF + n * 16) = o; } }
        } else if (wc == 0) {
#pragma unroll
            for (int ai = 0; ai < 2; ++ai)
#pragma unroll
                for (int m = 0; m < 4; ++m)
#pragma unroll
                    for (int n = 0; n < 2; ++n) *(f32x4*)(EX + (size_t)(row0 + ai * HALF + m * 16) * 32 + n * 16 + 4 * fq) = acc[ai][0][m][n];
        }
    }
};
struct EpiPartial {
    static constexpr bool PERM = false, AFTER_DRAIN = false;
    float* P;
    __device__ __forceinline__ void operator()(const f32x4 (&acc)[2][2][4][2], const Unit& u, int wr, int wc, int fr, int fq) const {
        const int kh = u.pn >> 2, pn = u.pn & 3;
        const int row0 = u.pm * BM + wr * 64 + fr, col0 = pn * BM + wc * 32 + 4 * fq;
        float* base = P + (size_t)kh * NTOK * DM;
#pragma unroll
        for (int ai = 0; ai < 2; ++ai)
#pragma unroll
            for (int m = 0; m < 4; ++m) { float* rowp = base + (size_t)(row0 + ai * HALF + m * 16) * DM + col0;
#pragma unroll
                for (int bj = 0; bj < 2; ++bj)
#pragma unroll
                    for (int n = 0; n < 2; ++n) *(f32x4*)(rowp + bj * HALF + n * 16) = acc[ai][bj][m][n]; }
    }
};
template <int SECOND> struct EpiGate {
    static constexpr bool PERM = false, AFTER_DRAIN = false;
    const bf16_t* G; float* T; bf16_t* O;
    __device__ __forceinline__ void operator()(const f32x4 (&acc)[2][2][4][2], const Unit& u, int wr, int wc, int fr, int fq) const {
        const int row0 = u.pm * BM + wr * 64 + fr, col0 = u.pn * BM + wc * 32 + 4 * fq;
#pragma unroll
        for (int ai = 0; ai < 2; ++ai)
#pragma unroll
            for (int m = 0; m < 4; ++m) { const size_t off = (size_t)(row0 + ai * HALF + m * 16) * DM + col0;
#pragma unroll
                for (int bj = 0; bj < 2; ++bj)
#pragma unroll
                    for (int n = 0; n < 2; ++n) { const size_t o = off + bj * HALF + n * 16; const u32x2 gr = *(const u32x2*)(G + o); const f32x4 a = acc[ai][bj][m][n];
                        f32x4 v; v[0] = sigmf(bflo(gr.x)) * a[0]; v[1] = sigmf(bfhi(gr.x)) * a[1]; v[2] = sigmf(bflo(gr.y)) * a[2]; v[3] = sigmf(bfhi(gr.y)) * a[3];
                        if (SECOND == 0) *(f32x4*)(T + o) = v;
                        else { const f32x4 t = *(const f32x4*)(T + o); v = v + t; u32x2 w; w.x = pk2bf(v[0], v[1]); w.y = pk2bf(v[2], v[3]); *(u32x2*)(O + o) = w; } } }
    }
};

template <class Epi, class Sched, bool STAMP = false>
__device__ __forceinline__ void gemm_phase(PG8_LAS unsigned char* lds, const Gemm g, const Sched& S, const Epi& E, unsigned long long* stamps) {
    int tid_l = threadIdx.x; asm volatile("" : "+v"(tid_l));
    const int tid = tid_l, wid = __builtin_amdgcn_readfirstlane(tid >> 6), lane = tid & 63, wr = wid >> 2, wc = wid & 3, fr = lane & 15, fq = lane >> 4;
    const int K = g.K, nt = g.klen / BK;
    int ts_lo = 0, ts_hi = 0, nts = 0; const unsigned long long rt_entry = STAMP ? (unsigned long long)wall_clock64() : 0ull;
#define PG8_STAMP() do { if (STAMP && wid == 0 && nts < 64) { const unsigned long long _c = (unsigned long long)clock64(); \
        ts_lo = (lane == nts) ? (int)(unsigned)_c : ts_lo; ts_hi = (lane == nts) ? (int)(unsigned)(_c >> 32) : ts_hi; ++nts; } } while (0)
    PG8_STAMP();
    unsigned voffA[2], voffB[2];
#pragma unroll
    for (int i = 0; i < 2; ++i) { int R, C; stage_rc(tid * 16 + i * 8192, R, C); const int Rb = Epi::PERM ? ((R & ~31) + perm32(R & 31)) : R;
        voffA[i] = (unsigned)(R * K + C) * 2u; voffB[i] = (unsigned)(Rb * K + C) * 2u; }
    const size_t kstep = (size_t)(BK * 2);
    const size_t hstep = (size_t)HALF * K * 2;
    const size_t tstep = 2 * hstep;
    const unsigned ldsw = (unsigned)wid * 1024u;
    const int aoff = lds_byte(wr * 64 + fr, fq * 8), boff = lds_byte(wc * 32 + fr, fq * 8);
#define PG8_SA(b, h) (((b) * 2 + (h)) * HTB)
#define PG8_SB(b, h) ((4 + (b) * 2 + (h)) * HTB)
#define PG8_STAGE(bufoff, gbase, voff) do { _Pragma("unroll") for (int _i = 0; _i < 2; ++_i) \
        __builtin_amdgcn_global_load_lds((const unsigned*)((const char*)(gbase) + (voff)[_i]), (PG8_LAS unsigned*)(lds + (bufoff) + ldsw + _i * 8192), 16, 0, 0); } while (0)
#define PG8_LDA(dst, b, h) do { _Pragma("unroll") for (int m = 0; m < 4; ++m) _Pragma("unroll") for (int k = 0; k < 2; ++k) dst[m][k] = *(const PG8_LAS bf16x8*)(lds + PG8_SA(b, h) + aoff + m * 2048 + k * 1024); } while (0)
#define PG8_LDB(dst, b, h) do { _Pragma("unroll") for (int n = 0; n < 2; ++n) _Pragma("unroll") for (int k = 0; k < 2; ++k) dst[n][k] = *(const PG8_LAS bf16x8*)(lds + PG8_SB(b, h) + boff + n * 2048 + k * 1024); } while (0)
#define PG8_MMA(ai, bj, At, Bt) do { __builtin_amdgcn_s_setprio(1); _Pragma("unroll") for (int m = 0; m < 4; ++m) _Pragma("unroll") for (int n = 0; n < 2; ++n) _Pragma("unroll") for (int k = 0; k < 2; ++k) \
        acc[ai][bj][m][n] = __builtin_amdgcn_mfma_f32_16x16x32_bf16(Bt[n][k], At[m][k], acc[ai][bj][m][n], 0, 0, 0); __builtin_amdgcn_s_setprio(0); } while (0)
#define PG8_WAIT_V(n) asm volatile("s_waitcnt vmcnt(" #n ")" ::: "memory")
#define PG8_WAIT_L(n) asm volatile("s_waitcnt lgkmcnt(" #n ")" ::: "memory")
#define PG8_BAR __builtin_amdgcn_s_barrier()
#define PG8_SCHED __builtin_amdgcn_sched_barrier(0)
    Unit cur, nxt; int ui = 0;
    if (!S.next(0, cur)) return;
    f32x4 acc[2][2][4][2];
#pragma unroll
    for (int a = 0; a < 2; ++a)
#pragma unroll
        for (int b = 0; b < 2; ++b)
#pragma unroll
            for (int m = 0; m < 4; ++m)
#pragma unroll
                for (int n = 0; n < 2; ++n) acc[a][b][m][n] = (f32x4){0.f, 0.f, 0.f, 0.f};
    bf16x8 At[4][2], B0[2][2], B1[2][2];
    const size_t khb = (size_t)g.klen * 2;
    const char* cA = (const char*)g.A + (size_t)cur.pm * tstep + (cur.pn >= g.nsp ? khb : 0); const char* cB = (const char*)g.Bt + (size_t)(cur.pn >= g.nsp ? cur.pn - g.nsp : cur.pn) * tstep + (cur.pn >= g.nsp ? khb : 0);
    S.a_ready(cur);
    PG8_STAGE(PG8_SB(0, 0), cB, voffB); PG8_STAGE(PG8_SA(0, 0), cA, voffA); PG8_STAGE(PG8_SB(0, 1), cB + hstep, voffB); PG8_STAGE(PG8_SA(0, 1), cA + hstep, voffA);
    if (wr == 1) PG8_BAR;
    PG8_WAIT_V(4); PG8_BAR;
    PG8_STAGE(PG8_SB(1, 0), cB + kstep, voffB); PG8_STAGE(PG8_SA(1, 0), cA + kstep, voffA); PG8_STAGE(PG8_SB(1, 1), cB + hstep + kstep, voffB);
    PG8_WAIT_V(6); PG8_BAR;
    PG8_STAMP();
    for (;;) {
        const bool has_next = S.next(ui + 1, nxt);
        const char* nA = has_next ? (const char*)g.A + (size_t)nxt.pm * tstep + (nxt.pn >= g.nsp ? khb : 0) : cA; const char* nB = has_next ? (const char*)g.Bt + (size_t)(nxt.pn >= g.nsp ? nxt.pn - g.nsp : nxt.pn) * tstep + (nxt.pn >= g.nsp ? khb : 0) : cB;
        for (int t = 0; t < nt; t += 2) {
            const bool last = (t == nt - 2);
            const char* a1 = cA + (size_t)(t + 1) * kstep;
            const char* a2 = last ? nA : cA + (size_t)(t + 2) * kstep; const char* b2 = last ? nB : cB + (size_t)(t + 2) * kstep;
            const char* a3 = a2 + kstep; const char* b3 = b2 + kstep;
            if (last && has_next) S.a_ready(nxt);
            PG8_LDB(B0, 0, 0); PG8_SCHED; PG8_LDA(At, 0, 0); PG8_STAGE(PG8_SA(1, 1), a1 + hstep, voffA);
            PG8_WAIT_L(8); PG8_BAR; PG8_WAIT_L(0); PG8_MMA(0, 0, At, B0); PG8_BAR; PG8_SCHED;
            PG8_LDB(B1, 0, 1); PG8_STAGE(PG8_SB(0, 0), b2, voffB);
            PG8_BAR; PG8_WAIT_L(0); PG8_MMA(0, 1, At, B1); PG8_BAR;
            PG8_LDA(At, 0, 1); PG8_STAGE(PG8_SA(0, 0), a2, voffA);
            PG8_BAR; PG8_WAIT_L(0); PG8_MMA(1, 0, At, B0); PG8_BAR; PG8_SCHED;
            PG8_STAGE(PG8_SB(0, 1), b2 + hstep, voffB);
            PG8_WAIT_V(6); PG8_BAR; PG8_MMA(1, 1, At, B1); PG8_BAR;
            PG8_LDB(B0, 1, 0); PG8_SCHED; PG8_LDA(At, 1, 0); PG8_STAGE(PG8_SA(0, 1), a2 + hstep, voffA);
            PG8_WAIT_L(8); PG8_BAR; PG8_WAIT_L(0); PG8_MMA(0, 0, At, B0); PG8_BAR; PG8_SCHED;
            PG8_LDB(B1, 1, 1); PG8_STAGE(PG8_SB(1, 0), b3, voffB);
            PG8_BAR; PG8_WAIT_L(0); PG8_MMA(0, 1, At, B1); PG8_BAR;
            PG8_LDA(At, 1, 1); PG8_STAGE(PG8_SA(1, 0), a3, voffA);
            PG8_BAR; PG8_WAIT_L(0); PG8_MMA(1, 0, At, B0); PG8_BAR; PG8_SCHED;
            PG8_STAGE(PG8_SB(1, 1), b3 + hstep, voffB);
            PG8_WAIT_V(6); PG8_BAR; PG8_MMA(1, 1, At, B1); PG8_BAR;
        }
        PG8_STAMP();
        if constexpr (!Epi::AFTER_DRAIN) { E(acc, cur, wr, wc, fr, fq); S.done(cur); }
        PG8_STAMP();
        if (!has_next) break;
#pragma unroll
        for (int a = 0; a < 2; ++a)
#pragma unroll
            for (int b = 0; b < 2; ++b)
#pragma unroll
                for (int m = 0; m < 4; ++m)
#pragma unroll
                    for (int n = 0; n < 2; ++n) acc[a][b][m][n] = (f32x4){0.f, 0.f, 0.f, 0.f};
        cur = nxt; cA = nA; cB = nB; ++ui;
    }
    PG8_WAIT_V(0);
    if (wr == 0) PG8_BAR;
    PG8_BAR;
    if constexpr (Epi::AFTER_DRAIN) { E.fused(acc, cur, wr, wc, fr, fq, lds, wid, lane); S.done(cur); }
    PG8_STAMP();
    if (STAMP && wid == 0) { stamps[lane] = lane < nts ? (((unsigned long long)(unsigned)ts_hi << 32) | (unsigned)ts_lo) : 0ull;
        if (lane == 62) stamps[62] = rt_entry; if (lane == 63) stamps[63] = (unsigned long long)wall_clock64(); }
#undef PG8_STAMP
#undef PG8_SA
#undef PG8_SB
#undef PG8_STAGE
#undef PG8_LDA
#undef PG8_LDB
#undef PG8_MMA
#undef PG8_WAIT_V
#undef PG8_WAIT_L
#undef PG8_BAR
#undef PG8_SCHED
}
}
#define XB_TMO      128
#define XB_XCNT(j)  (256  + 64 * (j))
#define XB_XSUB(j)  (1280 + 64 * (j))
#define XB_XGEN(j)  (2304 + 64 * (j))
#define XB_TOP      3328
#define XB_TOPGEN   3392
#define XCD_BAR_WORDS 3456
#define XB_SPIN_CAP (1u << 18)
#define XLAS __attribute__((address_space(3)))

__device__ __forceinline__ unsigned xb_ld(unsigned* p)              { return __hip_atomic_load(p, __ATOMIC_RELAXED, __HIP_MEMORY_SCOPE_AGENT); }
__device__ __forceinline__ unsigned xb_add(unsigned* p, unsigned v) { return __hip_atomic_fetch_add(p, v, __ATOMIC_RELAXED, __HIP_MEMORY_SCOPE_AGENT); }
__device__ __forceinline__ unsigned xb_xcc_id() { return (unsigned)__builtin_amdgcn_s_getreg((3 << 11) | 20) & 0xFu; }
#define XB_SPIN(cond, bar) do { unsigned _sp = 0; while (cond) { __builtin_amdgcn_s_sleep(1); \
    if ((++_sp & 255u) == 0u) { if (xb_ld(&(bar)[XB_TMO])) break; if (_sp > XB_SPIN_CAP) { atomicAdd(&(bar)[XB_TMO], 1u); break; } } } } while (0)

struct XcdBarrier {
    unsigned* bar; unsigned x;
    volatile XLAS unsigned* st;
};

__device__ __forceinline__ XcdBarrier xcd_barrier_post(unsigned* bar, volatile XLAS unsigned* st) {
    XcdBarrier b; b.bar = bar; b.x = xb_xcc_id(); b.st = st;
    if (threadIdx.x == 0) (void)xb_add(&bar[XB_XCNT(b.x)], 1u);
    return b;
}
__device__ __forceinline__ void xcd_barrier_complete(unsigned* bar, unsigned x, unsigned& nloc, unsigned& nx) {
    const unsigned G = gridDim.x * gridDim.y * gridDim.z;
    unsigned sum, cnt, mine, sp = 0u;
    for (;;) {
        sum = 0u; cnt = 0u; mine = 0u;
#pragma unroll
        for (unsigned j = 0; j < 16; ++j) { const unsigned c = xb_ld(&bar[XB_XCNT(j)]); sum += c; cnt += (c > 0u) ? 1u : 0u; mine = (j == x) ? c : mine; }
        if (sum == G) break;
        __builtin_amdgcn_s_sleep(1);
        if ((++sp & 255u) == 0u) { if (xb_ld(&bar[XB_TMO])) break; if (sp > XB_SPIN_CAP) { atomicAdd(&bar[XB_TMO], 1u); break; } }
    }
    nloc = mine > 0u ? mine : 1u; nx = cnt > 0u ? cnt : 1u;
}

__device__ __forceinline__ void xcd_barrier(const XcdBarrier& b) {
    asm volatile("s_waitcnt vmcnt(0)" ::: "memory");
    __syncthreads();
    if (threadIdx.x == 0) {
        unsigned* bar = b.bar;
        __builtin_amdgcn_s_waitcnt(0);
        unsigned nloc = b.st[0], nx = b.st[1];
        if (nloc == 0u) { xcd_barrier_complete(bar, b.x, nloc, nx); b.st[0] = nloc; b.st[1] = nx; }
        const unsigned old = xb_add(&bar[XB_XSUB(b.x)], 1u);
        const unsigned gen = old / nloc;
        if (old + 1u == (gen + 1u) * nloc) {
            __builtin_amdgcn_fence(__ATOMIC_RELEASE, "agent");
            asm volatile("s_waitcnt vmcnt(0)" ::: "memory");
            const unsigned og = xb_add(&bar[XB_TOP], 1u);
            const unsigned tg = og / nx;
            if (og + 1u == (tg + 1u) * nx) xb_add(&bar[XB_TOPGEN], 1u);
            else XB_SPIN(xb_ld(&bar[XB_TOPGEN]) == tg, bar);
            __builtin_amdgcn_fence(__ATOMIC_ACQUIRE, "agent");
            xb_add(&bar[XB_XGEN(b.x)], 1u);
            asm volatile("s_waitcnt vmcnt(0)" ::: "memory");
        } else {
            XB_SPIN(xb_ld(&bar[XB_XGEN(b.x)]) == gen, bar);
            __builtin_amdgcn_fence(__ATOMIC_ACQUIRE, "agent");
            asm volatile("s_waitcnt vmcnt(0)" ::: "memory");
        }
    }
    __syncthreads();
}


using pg8::bf16_t; using pg8::f32x4; using pg8::pk2bf; using pg8::bflo; using pg8::bfhi; using pg8::siluf; using pg8::sigmf; using pg8::u32x2;
using pg8::NTOK; using pg8::DM; using pg8::FFH; using pg8::NMOD;
typedef unsigned v4u __attribute__((ext_vector_type(4)));
#define LDS_WAIT() asm volatile("s_waitcnt lgkmcnt(0)" ::: "memory")
constexpr int NCTX = 4096, NWAVES = 8, LDS_BYTES = 139264;
constexpr size_t MiB = 1048576;
constexpr size_t OFF_WCO = 0, OFF_WDNO = 2 * MiB, OFF_WO = 4 * MiB;
constexpr size_t OFF_WGU = 6 * MiB;
constexpr size_t OFF_WD = 17 * MiB;
constexpr size_t OFF_WIN = 23 * MiB;
constexpr size_t OFF_X0 = 42 * MiB;
constexpr size_t OFF_DN = 6 * MiB;
constexpr size_t OFF_X1 = 114 * MiB;
constexpr size_t OFF_PROJ = 138 * MiB;
constexpr size_t OFF_EX = 246 * MiB;
constexpr size_t OFF_MOD = 247 * MiB;
constexpr size_t OFF_BAR = 247 * MiB + 512 * 1024;
constexpr size_t WS_NEED = 248 * MiB;
constexpr size_t BLK = (size_t)NTOK * DM;

struct Params {
    const float *x_prompt, *x_sample, *st_f, *st_b, *c, *c_ctx, *ada_w, *ada_b, *norm_ffn1, *f1g, *f1u, *f1d, *norm_mix, *w_in, *conv_w, *conv_out_w,
        *dn_conv_w, *dn_a_log, *dn_dt_bias, *dn_norm_w, *dn_out_w, *w_o, *norm_ffn2, *f2g, *f2u, *f2d, *norm_f;
    float* out; unsigned char* ws; int rep_prep, rep_gemm, rep_dnpre, rep_scan, rep_thin, rep_sync;
};

__device__ __forceinline__ float wave_sum(float v) {
#pragma unroll
    for (int o = 1; o < 64; o <<= 1) v += __shfl_xor(v, o);
    return v;
}
__device__ __forceinline__ float sum16(float v) {
#pragma unroll
    for (int o = 1; o < 16; o <<= 1) v += __shfl_xor(v, o);
    return v;
}
__device__ __forceinline__ void transpose_item(const float* W, int N, int k0, int n0, bf16_t* WT, int Kd, int dst_row0, float* scr, int lane) {
#pragma unroll 8
    for (int i = 0; i < 32; ++i) { const int kk = 2 * i + (lane >> 5); scr[kk * 33 + (lane & 31)] = W[(size_t)(k0 + kk) * N + n0 + (lane & 31)]; }
    LDS_WAIT();
    const int c = lane & 7;
#pragma unroll
    for (int j = 0; j < 4; ++j) { const int n = (lane >> 3) + 8 * j; const float* s = scr + (8 * c) * 33 + n;
        v4u o; o.x = pk2bf(s[0 * 33], s[1 * 33]); o.y = pk2bf(s[2 * 33], s[3 * 33]); o.z = pk2bf(s[4 * 33], s[5 * 33]); o.w = pk2bf(s[6 * 33], s[7 * 33]);
        *(v4u*)(WT + (size_t)(dst_row0 + n) * Kd + k0 + 8 * c) = o; }
    LDS_WAIT();
}
__device__ __forceinline__ void transpose_matrix(const float* W, int K, int N, bf16_t* WT, int mode, int gw, int ngw, float* scr, int lane) {
    const int nblk = N / 32, nitems = (K / 64) * nblk;
    for (int it = gw; it < nitems; it += ngw) {
        const int kb = it / nblk, nb = it % nblk, n0 = nb * 32;
        const int dr = mode == 0 ? n0 : ((n0 >> 7) * 256 + (n0 & 127) + (mode == 2 ? 128 : 0));
        transpose_item(W, N, kb * 64, n0, WT, K, dr, scr, lane);
    }
}

__device__ __forceinline__ void phase_prep(const Params& p, unsigned char* lds, int wave, int lane) {
    unsigned char* ws = p.ws;
    float* scr = (float*)lds + wave * (64 * 33);
    const int gw = wave * gridDim.x + blockIdx.x, ngw = gridDim.x * NWAVES;
    transpose_matrix(p.w_in, 1024, 9248, (bf16_t*)(ws + OFF_WIN), 0, gw, ngw, scr, lane);
    transpose_matrix(p.f1g, 1024, FFH, (bf16_t*)(ws + OFF_WGU), 1, gw, ngw, scr, lane);
    transpose_matrix(p.f1u, 1024, FFH, (bf16_t*)(ws + OFF_WGU), 2, gw, ngw, scr, lane);
    transpose_matrix(p.f1d, FFH, 1024, (bf16_t*)(ws + OFF_WD), 0, gw, ngw, scr, lane);
    transpose_matrix(p.conv_out_w, 1024, 1024, (bf16_t*)(ws + OFF_WCO), 0, gw, ngw, scr, lane);
    transpose_matrix(p.dn_out_w, 1024, 1024, (bf16_t*)(ws + OFF_WDNO), 0, gw, ngw, scr, lane);
    transpose_matrix(p.w_o, 1024, 1024, (bf16_t*)(ws + OFF_WO), 0, gw, ngw, scr, lane);
    {
        v4u z = {0u, 0u, 0u, 0u}; v4u* zp = (v4u*)((bf16_t*)(ws + OFF_WIN) + (size_t)9248 * 1024);
        const int nz = 224 * 1024 * 2 / 16;
        for (int i = blockIdx.x * 512 + threadIdx.x; i < nz; i += gridDim.x * 512) zp[i] = z;
    }
    __syncthreads();
    float* sc = (float*)lds;
    float* red = (float*)lds + 3072;
    if ((int)blockIdx.x < 144) {
        for (int i = threadIdx.x; i < 3072; i += 512) { const int cc = i >> 10, k = i & 1023; const float v = cc == 0 ? p.c_ctx[k] : p.c[(cc - 1) * 1024 + k]; sc[i] = siluf(v); }
        __syncthreads();
        for (int it = blockIdx.x; it < 144; it += gridDim.x) {
            const int n = it * 64 + lane; float a0 = 0.f, a1 = 0.f, a2 = 0.f;
            const float* wp = p.ada_w + (size_t)(wave * 128) * NMOD + n;
#pragma unroll 8
            for (int k = 0; k < 128; ++k) { const float wv = wp[(size_t)k * NMOD]; const int kk = wave * 128 + k; a0 += sc[kk] * wv; a1 += sc[1024 + kk] * wv; a2 += sc[2048 + kk] * wv; }
            red[(wave * 3 + 0) * 64 + lane] = a0; red[(wave * 3 + 1) * 64 + lane] = a1; red[(wave * 3 + 2) * 64 + lane] = a2;
            __syncthreads();
            if (threadIdx.x < 192) { const int cc = threadIdx.x >> 6, l = threadIdx.x & 63; float s = 0.f;
#pragma unroll
                for (int w = 0; w < 8; ++w) s += red[(w * 3 + cc) * 64 + l];
                ((float*)(ws + OFF_MOD))[cc * NMOD + it * 64 + l] = s + p.ada_b[it * 64 + l]; }
            __syncthreads();
        }
    }
}

template <int FIRST> __device__ __forceinline__ void phase_norm(const Params& p, const float* X, float* X0, const float* nw, int modi, bf16_t* A, int wave, int lane, const float* PART = nullptr, int gatei = 0, float gscale = 0.f) {
    const float* mod = (const float*)(p.ws + OFF_MOD);
    const int gw = wave * gridDim.x + blockIdx.x, ngw = gridDim.x * NWAVES;
    for (int row = gw; row < NTOK; row += ngw) {
        const int cond = row < NCTX ? 0 : 1 + ((row - NCTX) >> 10);
        f32x4 v[4];
        if (FIRST == 1) {
            const float* src = row < NCTX ? p.x_prompt + (size_t)row * DM : p.x_sample + (size_t)(row - NCTX) * DM;
#pragma unroll
            for (int j = 0; j < 4; ++j) v[j] = *(const f32x4*)(src + 4 * lane + 256 * j);
            if (row >= NCTX) {
                const int t = (row - NCTX) & 1023; const float r = (float)(t >> 6), cl = (float)(t & 63);
#pragma unroll
                for (int e = 0; e < 4; ++e) { const int i = 4 * lane + e; const float om = 1.0f / powf(10000.0f, (float)i * (1.0f / 256.0f));
                    v[0][e] += sinf(r * om); v[1][e] += cosf(r * om); v[2][e] += sinf(cl * om); v[3][e] += cosf(cl * om); }
            }
#pragma unroll
            for (int j = 0; j < 4; ++j) *(f32x4*)(X0 + (size_t)row * DM + 4 * lane + 256 * j) = v[j];
        } else if (FIRST == 2) {
            const float* gp = mod + (size_t)cond * NMOD + gatei * 1024;
#pragma unroll
            for (int j = 0; j < 4; ++j) { const size_t o = (size_t)row * DM + 4 * lane + 256 * j;
                const f32x4 x = *(const f32x4*)(X + o), p0 = *(const f32x4*)(PART + o), p1 = *(const f32x4*)(PART + BLK + o), gg = *(const f32x4*)(gp + 4 * lane + 256 * j);
                v[j] = x + (gg * gscale) * (p0 + p1); *(f32x4*)(X0 + o) = v[j]; }
        } else {
#pragma unroll
            for (int j = 0; j < 4; ++j) v[j] = *(const f32x4*)(X + (size_t)row * DM + 4 * lane + 256 * j);
        }
        float ss = 0.f;
#pragma unroll
        for (int j = 0; j < 4; ++j) ss += v[j][0] * v[j][0] + v[j][1] * v[j][1] + v[j][2] * v[j][2] + v[j][3] * v[j][3];
        const float rstd = rsqrtf(wave_sum(ss) * (1.0f / 1024.0f) + 1e-6f);
        const float* sh = mod + (size_t)cond * NMOD + modi * 1024; const float* scp = sh + 1024;
#pragma unroll
        for (int j = 0; j < 4; ++j) { const int d = 4 * lane + 256 * j; const f32x4 w = *(const f32x4*)(nw + d), s1 = *(const f32x4*)(scp + d), s0 = *(const f32x4*)(sh + d);
            f32x4 y;
#pragma unroll
            for (int e = 0; e < 4; ++e) y[e] = v[j][e] * rstd * w[e] * (1.f + s1[e]) + s0[e];
            u32x2 o; o.x = pk2bf(y[0], y[1]); o.y = pk2bf(y[2], y[3]); *(u32x2*)(A + (size_t)row * DM + d) = o; }
    }
}
__device__ __forceinline__ void phase_final_norm(const Params& p, const float* X, const float* PART, float* Y, int wave, int lane) {
    const float* mod = (const float*)(p.ws + OFF_MOD);
    const int gw = wave * gridDim.x + blockIdx.x, ngw = gridDim.x * NWAVES;
    for (int row = gw; row < NTOK; row += ngw) {
        f32x4 v[4]; float ss = 0.f;
#pragma unroll
        for (int j = 0; j < 4; ++j) { const size_t o = (size_t)row * DM + 4 * lane + 256 * j; const int cond = row < NCTX ? 0 : 1 + ((row - NCTX) >> 10);
            const f32x4 x = *(const f32x4*)(X + o), p0 = *(const f32x4*)(PART + o), p1 = *(const f32x4*)(PART + BLK + o), gg = *(const f32x4*)(mod + (size_t)cond * NMOD + 8 * 1024 + 4 * lane + 256 * j);
            v[j] = x + (gg * 0.5f) * (p0 + p1); ss += v[j][0] * v[j][0] + v[j][1] * v[j][1] + v[j][2] * v[j][2] + v[j][3] * v[j][3]; }
        const float rstd = rsqrtf(wave_sum(ss) * (1.0f / 1024.0f) + 1e-6f);
#pragma unroll
        for (int j = 0; j < 4; ++j) { const f32x4 w = *(const f32x4*)(p.norm_f + 4 * lane + 256 * j); *(f32x4*)(Y + (size_t)row * DM + 4 * lane + 256 * j) = v[j] * rstd * w; }
    }
}

__device__ __forceinline__ void unpack8(const v4u r, float (&f)[8]) { f[0] = bflo(r.x); f[1] = bfhi(r.x); f[2] = bflo(r.y); f[3] = bfhi(r.y); f[4] = bflo(r.z); f[5] = bfhi(r.z); f[6] = bflo(r.w); f[7] = bfhi(r.w); }
__device__ __forceinline__ void load8f(const float* p, float (&f)[8]) { const f32x4 a = *(const f32x4*)p, b = *(const f32x4*)(p + 4); f[0] = a[0]; f[1] = a[1]; f[2] = a[2]; f[3] = a[3]; f[4] = b[0]; f[5] = b[1]; f[6] = b[2]; f[7] = b[3]; }
__device__ __forceinline__ void phase_qkv_naive(const Params& p, const bf16_t* PROJ, const float* EX, float* QF, float* KF, float* VF, float* BG, bf16_t* YA, int wave, int lane) {
    const int gw = wave * gridDim.x + blockIdx.x, ngw = gridDim.x * NWAVES;
    const v4u zero4 = {0u, 0u, 0u, 0u};
    for (int tok = gw; tok < NTOK; tok += ngw) {
        const int pos = tok < NCTX ? (tok & 255) : ((tok - NCTX) & 63); const int L = tok < NCTX ? 256 : 64;
        const bool hasL = pos != 0, hasR = pos != L - 1;
#pragma unroll 1
        for (int grp = 0; grp < 6; ++grp) {
            const int part = grp >> 1, ch0 = (grp & 1) * 512 + lane * 8;
            const bf16_t* src = PROJ + (size_t)(3 + part) * BLK + (size_t)tok * DM + ch0;
            float c[8], l[8], r[8], w0[8], w1[8], w2[8], y[8];
            unpack8(*(const v4u*)src, c); unpack8(hasL ? *(const v4u*)(src - DM) : zero4, l); unpack8(hasR ? *(const v4u*)(src + DM) : zero4, r);
            const float* cw = p.dn_conv_w + part * 1024 + ch0;
            load8f(cw, w0); load8f(cw + 3072, w1); load8f(cw + 6144, w2);
            float ss = 0.f;
#pragma unroll
            for (int e = 0; e < 8; ++e) { y[e] = siluf(w0[e] * l[e] + w1[e] * c[e] + w2[e] * r[e]); ss += y[e] * y[e]; }
            if (part < 2) { const float sc = rsqrtf(sum16(ss) + 1e-6f) * (part == 0 ? 0.08838834764831845f : 1.0f);
#pragma unroll
                for (int e = 0; e < 8; ++e) y[e] *= sc; }
            float* dst = (part == 0 ? QF : part == 1 ? KF : VF) + (size_t)tok * DM + ch0;
            f32x4 o0 = {y[0], y[1], y[2], y[3]}, o1 = {y[4], y[5], y[6], y[7]};
            *(f32x4*)dst = o0; *(f32x4*)(dst + 4) = o1;
        }
#pragma unroll 1
        for (int grp = 0; grp < 2; ++grp) {
            const int ch0 = grp * 512 + lane * 8; const size_t o = (size_t)tok * DM + ch0;
            float bg[8], cc[8], cl[8], cr[8], xc[8], xl[8], xr[8], w0[8], w1[8], w2[8];
            unpack8(*(const v4u*)(PROJ + o), bg);
            unpack8(*(const v4u*)(PROJ + BLK + o), cc); unpack8(hasL ? *(const v4u*)(PROJ + BLK + o - DM) : zero4, cl); unpack8(hasR ? *(const v4u*)(PROJ + BLK + o + DM) : zero4, cr);
            unpack8(*(const v4u*)(PROJ + 2 * BLK + o), xc); unpack8(hasL ? *(const v4u*)(PROJ + 2 * BLK + o - DM) : zero4, xl); unpack8(hasR ? *(const v4u*)(PROJ + 2 * BLK + o + DM) : zero4, xr);
            load8f(p.conv_w + ch0, w0); load8f(p.conv_w + 1024 + ch0, w1); load8f(p.conv_w + 2048 + ch0, w2);
            float y[8];
#pragma unroll
            for (int e = 0; e < 8; ++e) y[e] = bg[e] * (w0[e] * cl[e] * xl[e] + w1[e] * cc[e] * xc[e] + w2[e] * cr[e] * xr[e]);
            v4u ov; ov.x = pk2bf(y[0], y[1]); ov.y = pk2bf(y[2], y[3]); ov.z = pk2bf(y[4], y[5]); ov.w = pk2bf(y[6], y[7]);
            *(v4u*)(YA + o) = ov;
        }
        if (lane < 16) {
            const float b_raw = EX[(size_t)tok * 32 + lane], a_raw = EX[(size_t)tok * 32 + 16 + lane];
            const float xx = a_raw + p.dn_dt_bias[lane]; const float sp = xx > 20.f ? xx : log1pf(expf(xx));
            BG[(size_t)tok * 32 + lane] = 1.f / (1.f + expf(-b_raw));
            BG[(size_t)tok * 32 + 16 + lane] = -expf(p.dn_a_log[lane]) * sp;
        }
    }
}

__device__ __forceinline__ void dn_naive_item(const Params& p, const float* QF, const float* KF, const float* VF, const float* BG, float* OF, float* OBk, float* lds, int item) {
    const bool lat = item < 32; const int j = lat ? item : item - 32; const int b = j >> 4, h = (j >> 1) & 7, dir = j & 1;
    const int T = lat ? 1024 : 256; const int tok0 = lat ? NCTX + b * 1024 : b * 256;
    const int tid = threadIdx.x, v = tid & 127, kq = tid >> 7;
    float* qs = lds; float* ks = lds + 128; float* vs = lds + 256; float* gb = lds + 384; float* red = lds + 512; float* red2 = lds + 1024;
    float S[32];
    if (lat) { const float* s0 = (dir ? p.st_b : p.st_f) + ((size_t)(b * 8 + h) * 128) * 128;
#pragma unroll
        for (int i = 0; i < 32; ++i) S[i] = s0[(size_t)(kq * 32 + i) * 128 + v]; }
    else {
#pragma unroll
        for (int i = 0; i < 32; ++i) S[i] = 0.f; }
    float* Od = dir ? OBk : OF;
    for (int t = 0; t < T; ++t) {
        const int tok = tok0 + (dir ? T - 1 - t : t);
        __syncthreads();
        if (tid < 128) qs[tid] = QF[(size_t)tok * DM + h * 128 + tid];
        else if (tid < 256) ks[tid - 128] = KF[(size_t)tok * DM + h * 128 + tid - 128];
        else if (tid < 384) vs[tid - 256] = VF[(size_t)tok * DM + h * 128 + tid - 256];
        else if (tid == 384) gb[0] = BG[(size_t)tok * 32 + dir * 8 + h];
        else if (tid == 385) gb[1] = BG[(size_t)tok * 32 + 16 + dir * 8 + h];
        __syncthreads();
        float part = 0.f;
#pragma unroll
        for (int i = 0; i < 32; ++i) part += ks[kq * 32 + i] * S[i];
        red[kq * 128 + v] = part;
        __syncthreads();
        const float kS = red[v] + red[128 + v] + red[256 + v] + red[384 + v];
        const float eg = expf(gb[1]), beta = gb[0];
        const float delta = beta * (vs[v] - eg * kS);
        float op = 0.f;
#pragma unroll
        for (int i = 0; i < 32; ++i) { S[i] = eg * S[i] + ks[kq * 32 + i] * delta; op += qs[kq * 32 + i] * S[i]; }
        red2[kq * 128 + v] = op;
        __syncthreads();
        if (kq == 0) Od[(size_t)tok * DM + h * 128 + v] = red2[v] + red2[128 + v] + red2[256 + v] + red2[384 + v];
    }
    if (!lat) { float* so = p.out + (size_t)NTOK * DM + (size_t)dir * (16 * 8 * 128 * 128) + ((size_t)(b * 8 + h) * 128) * 128;
#pragma unroll
        for (int i = 0; i < 32; ++i) so[(size_t)(kq * 32 + i) * 128 + v] = S[i]; }
}
__device__ __forceinline__ void phase_dn_naive(const Params& p, const float* QF, const float* KF, const float* VF, const float* BG, float* OF, float* OBk, float* lds) {
    const int bx = blockIdx.x;
    if (gridDim.x >= 256) {
        if (bx < 32) dn_naive_item(p, QF, KF, VF, BG, OF, OBk, lds, bx);
        else if (bx < 256) { dn_naive_item(p, QF, KF, VF, BG, OF, OBk, lds, bx); if (bx < 64) dn_naive_item(p, QF, KF, VF, BG, OF, OBk, lds, 224 + bx); }
    } else { for (int it = bx; it < 288; it += gridDim.x) dn_naive_item(p, QF, KF, VF, BG, OF, OBk, lds, it); }
}

typedef short bf16x8 __attribute__((ext_vector_type(8)));
typedef float f32x16 __attribute__((ext_vector_type(16)));
#define MFMA32(a, b, c) __builtin_amdgcn_mfma_f32_32x32x16_bf16((a), (b), (c), 0, 0, 0)
constexpr int DN_ITEM_BYTES = 73728, DN_W = 0, DN_QD = 16384, DN_KD = 32768, DN_A = 49152, DN_U = 57344;
constexpr int LS = 132;
constexpr int L_QF = 0, L_KF = 33792, L_VF = 67584, L_LM = 101376, L_CO = 134144;
__device__ __forceinline__ int crow16(int i, int hh) { return (i & 3) + 8 * (i >> 2) + 4 * hh; }
__device__ __forceinline__ bf16x8 frag_from_f32(const float* p) { const f32x4 a = *(const f32x4*)p, b = *(const f32x4*)(p + 4);
    v4u r; r.x = pk2bf(a[0], a[1]); r.y = pk2bf(a[2], a[3]); r.z = pk2bf(b[0], b[1]); r.w = pk2bf(b[2], b[3]); return __builtin_bit_cast(bf16x8, r); }
template <int S> __device__ __forceinline__ bf16x8 pack_step(const f32x16& x) {
    v4u r; r.x = pk2bf(x[8 * S + 0], x[8 * S + 1]); r.y = pk2bf(x[8 * S + 2], x[8 * S + 3]); r.z = pk2bf(x[8 * S + 4], x[8 * S + 5]); r.w = pk2bf(x[8 * S + 6], x[8 * S + 7]); return __builtin_bit_cast(bf16x8, r); }

__device__ __forceinline__ void dn_pre_item(const Params& p, const bf16_t* PROJ, const float* EX, unsigned char* DN, float* GL, unsigned char* lds, int sc, int h) {
    int tid_l = threadIdx.x; asm volatile("" : "+v"(tid_l));
    const int tid = tid_l, lane = tid & 63, wave = tid >> 6;
    const bool ctx = sc < 64; const int nn = ctx ? (sc & 3) : ((sc - 64) & 15);
    const int tok0 = ctx ? (sc >> 2) * 256 + 64 * nn : NCTX + ((sc - 64) >> 4) * 1024 + 64 * nn;
    float* QFl = (float*)(lds + L_QF); float* KFl = (float*)(lds + L_KF); float* VFl = (float*)(lds + L_VF); float* LM = (float*)(lds + L_LM);
    float* CB = (float*)(lds + L_CO);
    float* CG = CB + 128;
    float* CW = CB + 256;
    float* CE = CB + 384;
    float* CK = CB + 512;
    const v4u zero4 = {0u, 0u, 0u, 0u};
#pragma unroll 2
    for (int jj = 0; jj < 6; ++jj) {
        const int pr = tid + 512 * jj, c = pr / 48, cg = pr % 48, part = cg >> 4, d0 = (cg & 15) * 8;
        const bool hasL = c > 0 || (ctx && nn > 0), hasR = c < 63 || (ctx && nn < 3);
        const bf16_t* src = PROJ + (size_t)(3 + part) * BLK + (size_t)(tok0 + c) * DM + h * 128 + d0;
        float cc[8], l[8], r[8], w0[8], w1[8], w2[8], y[8];
        unpack8(*(const v4u*)src, cc); unpack8(hasL ? *(const v4u*)(src - DM) : zero4, l); unpack8(hasR ? *(const v4u*)(src + DM) : zero4, r);
        const float* cw = p.dn_conv_w + part * 1024 + h * 128 + d0;
        load8f(cw, w0); load8f(cw + 3072, w1); load8f(cw + 6144, w2);
        float ss = 0.f;
#pragma unroll
        for (int e = 0; e < 8; ++e) { y[e] = siluf(w0[e] * l[e] + w1[e] * cc[e] + w2[e] * r[e]); ss += y[e] * y[e]; }
        const float tot = sum16(ss);
        if (part < 2) { const float scl = rsqrtf(tot + 1e-6f) * (part == 0 ? 0.08838834764831845f : 1.0f);
#pragma unroll
            for (int e = 0; e < 8; ++e) y[e] *= scl; }
        float* dst = (part == 0 ? QFl : part == 1 ? KFl : VFl) + c * LS + d0;
        f32x4 o0 = {y[0], y[1], y[2], y[3]}, o1 = {y[4], y[5], y[6], y[7]};
        *(f32x4*)dst = o0; *(f32x4*)(dst + 4) = o1;
    }
    if (wave < 2) {
        const int d = wave, oc = d ? 63 - lane : lane; const size_t tk = (size_t)(tok0 + oc) * 32;
        const float b_raw = EX[tk + d * 8 + h], a_raw = EX[tk + 16 + d * 8 + h];
        const float xx = a_raw + p.dn_dt_bias[d * 8 + h]; const float sp = xx > 20.f ? xx : log1pf(expf(xx));
        const float beta = 1.f / (1.f + expf(-b_raw)); float g = -expf(p.dn_a_log[d * 8 + h]) * sp;
#pragma unroll
        for (int o = 1; o < 64; o <<= 1) { const float t = __shfl_up(g, o); if (lane >= o) g += t; }
        const float glast = __shfl(g, 63); const float eg = expf(g);
        CB[d * 64 + lane] = beta; CG[d * 64 + lane] = g; CW[d * 64 + lane] = beta * eg; CE[d * 64 + lane] = eg; CK[d * 64 + lane] = expf(glast - g);
        if (lane == 0) GL[(sc * 8 + h) * 2 + d] = expf(glast);
    }
    __syncthreads();
    const int dir = wave >> 2;
    unsigned char* item = DN + (size_t)((sc * 8 + h) * 2 + dir) * DN_ITEM_BYTES;
    {
        const int w4 = wave & 3, mt = w4 >> 1, nt = w4 & 1, r = lane & 31, hh = lane >> 5;
        const int ia = 32 * mt + r, ib = 32 * nt + r; const int ca = dir ? 63 - ia : ia, cb = dir ? 63 - ib : ib;
        f32x16 kk, pp;
#pragma unroll
        for (int i = 0; i < 16; ++i) { kk[i] = 0.f; pp[i] = 0.f; }
#pragma unroll
        for (int ks = 0; ks < 8; ++ks) {
            const bf16x8 ka = frag_from_f32(KFl + ca * LS + 16 * ks + 8 * hh), kb = frag_from_f32(KFl + cb * LS + 16 * ks + 8 * hh), qb = frag_from_f32(QFl + cb * LS + 16 * ks + 8 * hh);
            kk = MFMA32(ka, kb, kk); pp = MFMA32(ka, qb, pp);
        }
        const float* gcd = CG + dir * 64; const float* btd = CB + dir * 64;
        const float g_col = gcd[ib];
        f32x16 pv;
#pragma unroll
        for (int i = 0; i < 16; ++i) {
            const int row = 32 * mt + crow16(i, hh); const float g_row = gcd[row];
            LM[dir * 4096 + row * 64 + ib] = (ib < row) ? btd[row] * kk[i] * expf(g_row - g_col) : 0.f;
            pv[i] = (row <= ib) ? pp[i] * expf(g_col - g_row) : 0.f;
        }
        v4u* af = (v4u*)(item + DN_A);
        af[(nt * 4 + mt * 2 + 0) * 64 + lane] = __builtin_bit_cast(v4u, pack_step<0>(pv));
        af[(nt * 4 + mt * 2 + 1) * 64 + lane] = __builtin_bit_cast(v4u, pack_step<1>(pv));
    }
    __syncthreads();
    const int col = tid & 255, cc = col & 127; const bool isw = col >= 128;
    float x[64];
    {
        const float* srcm = isw ? KFl : VFl; const float* coef = (isw ? CW : CB) + dir * 64; const float* Lm = LM + dir * 4096;
#pragma unroll
        for (int c = 0; c < 64; ++c) {
            const int oc = dir ? 63 - c : c;
            float acc = srcm[oc * LS + cc] * coef[c];
#pragma unroll
            for (int s = 0; s < c; ++s) acc -= Lm[c * 64 + s] * x[s];
            x[c] = acc;
        }
        if (!isw) {
            const int jj = cc >> 5, n = cc & 31;
#pragma unroll
            for (int mt = 0; mt < 2; ++mt)
#pragma unroll
                for (int hh = 0; hh < 2; ++hh) {
                    v4u lo, hi;
                    lo.x = pk2bf(x[32 * mt + 4 * hh + 0], x[32 * mt + 4 * hh + 1]); lo.y = pk2bf(x[32 * mt + 4 * hh + 2], x[32 * mt + 4 * hh + 3]);
                    lo.z = pk2bf(x[32 * mt + 4 * hh + 8], x[32 * mt + 4 * hh + 9]); lo.w = pk2bf(x[32 * mt + 4 * hh + 10], x[32 * mt + 4 * hh + 11]);
                    hi.x = pk2bf(x[32 * mt + 4 * hh + 16], x[32 * mt + 4 * hh + 17]); hi.y = pk2bf(x[32 * mt + 4 * hh + 18], x[32 * mt + 4 * hh + 19]);
                    hi.z = pk2bf(x[32 * mt + 4 * hh + 24], x[32 * mt + 4 * hh + 25]); hi.w = pk2bf(x[32 * mt + 4 * hh + 26], x[32 * mt + 4 * hh + 27]);
                    v4u* dst = (v4u*)(item + DN_U + (size_t)(((jj * 2 + mt) * 64 + hh * 32 + n) * 32));
                    dst[0] = lo; dst[1] = hi;
                }
        }
    }
    __syncthreads();
    bf16_t* WL = (bf16_t*)(lds + L_VF);
    if (isw) {
#pragma unroll
        for (int c = 0; c < 64; ++c) WL[(dir * 64 + c) * LS + cc] = (bf16_t)(pk2bf(x[c], 0.f) & 0xffffu);
    }
    __syncthreads();
    {
        const int t = tid & 255; const float* ce = CE + dir * 64; const float* ck = CK + dir * 64;
#pragma unroll 1
        for (int q = 0; q < 4; ++q) {
            const int fl = t + 256 * q, f = fl >> 6, ln = fl & 63, r = ln & 31, hh = ln >> 5;
            {
                const int mt = f >> 3, ks8 = f & 7, cp = 32 * mt + r, oc = dir ? 63 - cp : cp, dkb = 16 * ks8 + 4 * hh;
                const u32x2 lo = *(const u32x2*)(WL + (dir * 64 + cp) * LS + dkb), hi = *(const u32x2*)(WL + (dir * 64 + cp) * LS + dkb + 8);
                v4u wv; wv.x = lo.x; wv.y = lo.y; wv.z = hi.x; wv.w = hi.y;
                ((v4u*)(item + DN_W))[f * 64 + ln] = wv;
                const f32x4 qa = *(const f32x4*)(QFl + oc * LS + dkb), qb = *(const f32x4*)(QFl + oc * LS + dkb + 8); const float e = ce[cp];
                v4u qv; qv.x = pk2bf(qa[0] * e, qa[1] * e); qv.y = pk2bf(qa[2] * e, qa[3] * e); qv.z = pk2bf(qb[0] * e, qb[1] * e); qv.w = pk2bf(qb[2] * e, qb[3] * e);
                ((v4u*)(item + DN_QD))[f * 64 + ln] = qv;
            }
            {
                const int mtK = f >> 2, kst = f & 3, dk = 32 * mtK + r, sb = 16 * kst + 4 * hh;
                float kv[8];
#pragma unroll
                for (int j = 0; j < 8; ++j) { const int sp = sb + (j & 3) + 8 * (j >> 2); const int os = dir ? 63 - sp : sp; kv[j] = KFl[os * LS + dk] * ck[sp]; }
                v4u kq; kq.x = pk2bf(kv[0], kv[1]); kq.y = pk2bf(kv[2], kv[3]); kq.z = pk2bf(kv[4], kv[5]); kq.w = pk2bf(kv[6], kv[7]);
                ((v4u*)(item + DN_KD))[f * 64 + ln] = kq;
            }
        }
    }
    __syncthreads();
}

__device__ __forceinline__ void phase_branch_a(const Params& p, const bf16_t* PROJ, bf16_t* YA, int wave, int lane) {
    const int gw = wave * gridDim.x + blockIdx.x, ngw = gridDim.x * NWAVES;
    const v4u zero4 = {0u, 0u, 0u, 0u};
    for (int tok = gw; tok < NTOK; tok += ngw) {
        const int pos = tok < NCTX ? (tok & 255) : ((tok - NCTX) & 63); const int L = tok < NCTX ? 256 : 64;
        const bool hasL = pos != 0, hasR = pos != L - 1;
#pragma unroll 1
        for (int grp = 0; grp < 2; ++grp) {
            const int ch0 = grp * 512 + lane * 8; const size_t o = (size_t)tok * DM + ch0;
            float bg[8], cc[8], cl[8], cr[8], xc[8], xl[8], xr[8], w0[8], w1[8], w2[8];
            unpack8(*(const v4u*)(PROJ + o), bg);
            unpack8(*(const v4u*)(PROJ + BLK + o), cc); unpack8(hasL ? *(const v4u*)(PROJ + BLK + o - DM) : zero4, cl); unpack8(hasR ? *(const v4u*)(PROJ + BLK + o + DM) : zero4, cr);
            unpack8(*(const v4u*)(PROJ + 2 * BLK + o), xc); unpack8(hasL ? *(const v4u*)(PROJ + 2 * BLK + o - DM) : zero4, xl); unpack8(hasR ? *(const v4u*)(PROJ + 2 * BLK + o + DM) : zero4, xr);
            load8f(p.conv_w + ch0, w0); load8f(p.conv_w + 1024 + ch0, w1); load8f(p.conv_w + 2048 + ch0, w2);
            float y[8];
#pragma unroll
            for (int e = 0; e < 8; ++e) y[e] = bg[e] * (w0[e] * cl[e] * xl[e] + w1[e] * cc[e] * xc[e] + w2[e] * cr[e] * xr[e]);
            v4u ov; ov.x = pk2bf(y[0], y[1]); ov.y = pk2bf(y[2], y[3]); ov.z = pk2bf(y[4], y[5]); ov.w = pk2bf(y[6], y[7]);
            *(v4u*)(YA + o) = ov;
        }
    }
}

__device__ __forceinline__ void dn_scan_item(const Params& p, const unsigned char* DN, const float* GL, float* OF, float* OBk, int it, int lane) {
    const bool lat = it < 128; const int q = lat ? it : it - 128;
    const int jj = q & 3, dir = (q >> 2) & 1, h = (q >> 3) & 7, b = q >> 6;
    const int nch = lat ? 16 : 4, scb = lat ? 64 + 16 * b : 4 * b, tokb = lat ? NCTX + b * 1024 : b * 256;
    const int n = lane & 31, hh = lane >> 5;
    f32x16 S[4];
    if (lat) { const float* s0 = (dir ? p.st_b : p.st_f) + (size_t)(b * 8 + h) * 16384 + 32 * jj + n;
#pragma unroll
        for (int m = 0; m < 4; ++m)
#pragma unroll
            for (int i = 0; i < 16; ++i) S[m][i] = s0[(size_t)(32 * m + crow16(i, hh)) * 128]; }
    else {
#pragma unroll
        for (int m = 0; m < 4; ++m)
#pragma unroll
            for (int i = 0; i < 16; ++i) S[m][i] = 0.f; }
    float* Od = (dir ? OBk : OF) + h * 128 + 32 * jj + n;
#pragma unroll 1
    for (int ci = 0; ci < nch; ++ci) {
        const int no = dir ? nch - 1 - ci : ci; const int id = ((scb + no) * 8 + h) * 2 + dir;
        const unsigned char* item = DN + (size_t)id * DN_ITEM_BYTES;
        const v4u* Wf = (const v4u*)(item + DN_W) + lane; const v4u* Qf = (const v4u*)(item + DN_QD) + lane; const v4u* Kf = (const v4u*)(item + DN_KD) + lane; const v4u* Af = (const v4u*)(item + DN_A) + lane;
        const float gl = GL[id];
        bf16x8 Sb[8];
        Sb[0] = pack_step<0>(S[0]); Sb[1] = pack_step<1>(S[0]); Sb[2] = pack_step<0>(S[1]); Sb[3] = pack_step<1>(S[1]);
        Sb[4] = pack_step<0>(S[2]); Sb[5] = pack_step<1>(S[2]); Sb[6] = pack_step<0>(S[3]); Sb[7] = pack_step<1>(S[3]);
        f32x16 vn[2], o[2];
#pragma unroll
        for (int mt = 0; mt < 2; ++mt) {
            f32x16 ws;
#pragma unroll
            for (int i = 0; i < 16; ++i) { ws[i] = 0.f; o[mt][i] = 0.f; }
#pragma unroll
            for (int ks = 0; ks < 8; ++ks) { ws = MFMA32(__builtin_bit_cast(bf16x8, Wf[(mt * 8 + ks) * 64]), Sb[ks], ws); o[mt] = MFMA32(__builtin_bit_cast(bf16x8, Qf[(mt * 8 + ks) * 64]), Sb[ks], o[mt]); }
            const v4u* up = (const v4u*)(item + DN_U + (size_t)(((jj * 2 + mt) * 64 + lane) * 32));
            const v4u u0 = up[0], u1 = up[1];
            vn[mt][0] = bflo(u0.x) - ws[0]; vn[mt][1] = bfhi(u0.x) - ws[1]; vn[mt][2] = bflo(u0.y) - ws[2]; vn[mt][3] = bfhi(u0.y) - ws[3];
            vn[mt][4] = bflo(u0.z) - ws[4]; vn[mt][5] = bfhi(u0.z) - ws[5]; vn[mt][6] = bflo(u0.w) - ws[6]; vn[mt][7] = bfhi(u0.w) - ws[7];
            vn[mt][8] = bflo(u1.x) - ws[8]; vn[mt][9] = bfhi(u1.x) - ws[9]; vn[mt][10] = bflo(u1.y) - ws[10]; vn[mt][11] = bfhi(u1.y) - ws[11];
            vn[mt][12] = bflo(u1.z) - ws[12]; vn[mt][13] = bfhi(u1.z) - ws[13]; vn[mt][14] = bflo(u1.w) - ws[14]; vn[mt][15] = bfhi(u1.w) - ws[15];
        }
        bf16x8 Vb[4];
        Vb[0] = pack_step<0>(vn[0]); Vb[1] = pack_step<1>(vn[0]); Vb[2] = pack_step<0>(vn[1]); Vb[3] = pack_step<1>(vn[1]);
#pragma unroll
        for (int mt = 0; mt < 2; ++mt)
#pragma unroll
            for (int kst = 0; kst < 4; ++kst) o[mt] = MFMA32(__builtin_bit_cast(bf16x8, Af[(mt * 4 + kst) * 64]), Vb[kst], o[mt]);
#pragma unroll
        for (int m = 0; m < 4; ++m) {
#pragma unroll
            for (int i = 0; i < 16; ++i) S[m][i] *= gl;
#pragma unroll
            for (int kst = 0; kst < 4; ++kst) S[m] = MFMA32(__builtin_bit_cast(bf16x8, Kf[(m * 4 + kst) * 64]), Vb[kst], S[m]);
        }
        const int tok0 = tokb + 64 * no;
#pragma unroll
        for (int mt = 0; mt < 2; ++mt)
#pragma unroll
            for (int i = 0; i < 16; ++i) { const int cp = 32 * mt + crow16(i, hh); const int oc = dir ? 63 - cp : cp; Od[(size_t)(tok0 + oc) * DM] = o[mt][i]; }
    }
    if (!lat) { float* so = p.out + (size_t)NTOK * DM + (size_t)dir * (16 * 8 * 128 * 128) + (size_t)(b * 8 + h) * 16384 + 32 * jj + n;
#pragma unroll
        for (int m = 0; m < 4; ++m)
#pragma unroll
            for (int i = 0; i < 16; ++i) so[(size_t)(32 * m + crow16(i, hh)) * 128] = S[m][i]; }
}

constexpr int SC_BUF = 57344;
__device__ __forceinline__ void dn_scan_group(const Params& p, const unsigned char* DN, const float* GL, float* OF, float* OBk, unsigned char* lds, int grp) {
    int tid_l = threadIdx.x; asm volatile("" : "+v"(tid_l));
    const int tid = tid_l, lane = tid & 63, wave = __builtin_amdgcn_readfirstlane(tid >> 6);
    const bool lat = grp < 32; const int q = lat ? grp : grp - 32;
    const int dir = q & 1, h = (q >> 1) & 7, b = q >> 4;
    const int nch = lat ? 16 : 4, scb = lat ? 64 + 16 * b : 4 * b, tokb = lat ? NCTX + b * 1024 : b * 256;
    if (wave >= 4) {
        const int lt = tid - 256;
        v4u r[14];
        {   const v4u* src = (const v4u*)(DN + (size_t)(((scb + (dir ? nch - 1 : 0)) * 8 + h) * 2 + dir) * DN_ITEM_BYTES) + lt;
#pragma unroll
            for (int k = 0; k < 14; ++k) r[k] = src[256 * k];
            v4u* dst = (v4u*)lds + lt;
#pragma unroll
            for (int k = 0; k < 14; ++k) dst[256 * k] = r[k]; }
        {   const v4u* src = (const v4u*)(DN + (size_t)(((scb + (dir ? nch - 2 : 1)) * 8 + h) * 2 + dir) * DN_ITEM_BYTES) + lt;
#pragma unroll
            for (int k = 0; k < 14; ++k) r[k] = src[256 * k]; }
        __syncthreads();
#pragma unroll 1
        for (int ci = 0; ci < nch; ++ci) {
            if (ci + 1 < nch) { v4u* dst = (v4u*)(lds + ((ci + 1) & 1) * SC_BUF) + lt;
#pragma unroll
                for (int k = 0; k < 14; ++k) dst[256 * k] = r[k]; }
            if (ci + 2 < nch) { const int no = dir ? nch - 3 - ci : ci + 2;
                const v4u* src = (const v4u*)(DN + (size_t)(((scb + no) * 8 + h) * 2 + dir) * DN_ITEM_BYTES) + lt;
#pragma unroll
                for (int k = 0; k < 14; ++k) r[k] = src[256 * k]; }
            __syncthreads();
        }
    } else {
        const int jj = wave, n = lane & 31, hh = lane >> 5;
        f32x16 S[4];
        if (lat) { const float* s0 = (dir ? p.st_b : p.st_f) + (size_t)(b * 8 + h) * 16384 + 32 * jj + n;
#pragma unroll
            for (int m = 0; m < 4; ++m)
#pragma unroll
                for (int i = 0; i < 16; ++i) S[m][i] = s0[(size_t)(32 * m + crow16(i, hh)) * 128]; }
        else {
#pragma unroll
            for (int m = 0; m < 4; ++m)
#pragma unroll
                for (int i = 0; i < 16; ++i) S[m][i] = 0.f; }
        float* Od = (dir ? OBk : OF) + h * 128 + 32 * jj + n;
        v4u un[4]; float gln;
        {   const int id0 = ((scb + (dir ? nch - 1 : 0)) * 8 + h) * 2 + dir; const unsigned char* it0 = DN + (size_t)id0 * DN_ITEM_BYTES + DN_U;
            const v4u* u0 = (const v4u*)(it0 + (size_t)(((jj * 2 + 0) * 64 + lane) * 32)); const v4u* u1 = (const v4u*)(it0 + (size_t)(((jj * 2 + 1) * 64 + lane) * 32));
            un[0] = u0[0]; un[1] = u0[1]; un[2] = u1[0]; un[3] = u1[1]; gln = GL[id0]; }
        __syncthreads();
#pragma unroll 1
        for (int ci = 0; ci < nch; ++ci) {
            const int no = dir ? nch - 1 - ci : ci;
            const float gl = gln;
            const unsigned char* buf = lds + (ci & 1) * SC_BUF;
            const v4u* Wf = (const v4u*)(buf + DN_W) + lane; const v4u* Qf = (const v4u*)(buf + DN_QD) + lane; const v4u* Kf = (const v4u*)(buf + DN_KD) + lane; const v4u* Af = (const v4u*)(buf + DN_A) + lane;
            f32x16 vn[2], o[2];
            {
                bf16x8 Sb[8];
                Sb[0] = pack_step<0>(S[0]); Sb[1] = pack_step<1>(S[0]); Sb[2] = pack_step<0>(S[1]); Sb[3] = pack_step<1>(S[1]);
                Sb[4] = pack_step<0>(S[2]); Sb[5] = pack_step<1>(S[2]); Sb[6] = pack_step<0>(S[3]); Sb[7] = pack_step<1>(S[3]);
#pragma unroll
                for (int mt = 0; mt < 2; ++mt) {
                    f32x16 ws;
#pragma unroll
                    for (int i = 0; i < 16; ++i) { ws[i] = 0.f; o[mt][i] = 0.f; }
#pragma unroll
                    for (int ks = 0; ks < 8; ++ks) { ws = MFMA32(__builtin_bit_cast(bf16x8, Wf[(mt * 8 + ks) * 64]), Sb[ks], ws); o[mt] = MFMA32(__builtin_bit_cast(bf16x8, Qf[(mt * 8 + ks) * 64]), Sb[ks], o[mt]); }
                    const v4u u0 = un[2 * mt], u1 = un[2 * mt + 1];
                    vn[mt][0] = bflo(u0.x) - ws[0]; vn[mt][1] = bfhi(u0.x) - ws[1]; vn[mt][2] = bflo(u0.y) - ws[2]; vn[mt][3] = bfhi(u0.y) - ws[3];
                    vn[mt][4] = bflo(u0.z) - ws[4]; vn[mt][5] = bfhi(u0.z) - ws[5]; vn[mt][6] = bflo(u0.w) - ws[6]; vn[mt][7] = bfhi(u0.w) - ws[7];
                    vn[mt][8] = bflo(u1.x) - ws[8]; vn[mt][9] = bfhi(u1.x) - ws[9]; vn[mt][10] = bflo(u1.y) - ws[10]; vn[mt][11] = bfhi(u1.y) - ws[11];
                    vn[mt][12] = bflo(u1.z) - ws[12]; vn[mt][13] = bfhi(u1.z) - ws[13]; vn[mt][14] = bflo(u1.w) - ws[14]; vn[mt][15] = bfhi(u1.w) - ws[15];
                    __builtin_amdgcn_sched_barrier(0);
                }
            }
            if (ci + 1 < nch) { const int no1 = dir ? nch - 2 - ci : ci + 1; const int id1 = ((scb + no1) * 8 + h) * 2 + dir; const unsigned char* it1 = DN + (size_t)id1 * DN_ITEM_BYTES + DN_U;
                const v4u* u0 = (const v4u*)(it1 + (size_t)(((jj * 2 + 0) * 64 + lane) * 32)); const v4u* u1 = (const v4u*)(it1 + (size_t)(((jj * 2 + 1) * 64 + lane) * 32));
                un[0] = u0[0]; un[1] = u0[1]; un[2] = u1[0]; un[3] = u1[1]; gln = GL[id1]; }
            bf16x8 Vb[4];
            Vb[0] = pack_step<0>(vn[0]); Vb[1] = pack_step<1>(vn[0]); Vb[2] = pack_step<0>(vn[1]); Vb[3] = pack_step<1>(vn[1]);
            __builtin_amdgcn_sched_barrier(0);
#pragma unroll
            for (int mt = 0; mt < 2; ++mt)
#pragma unroll
                for (int kst = 0; kst < 4; ++kst) o[mt] = MFMA32(__builtin_bit_cast(bf16x8, Af[(mt * 4 + kst) * 64]), Vb[kst], o[mt]);
            const int tok0 = tokb + 64 * no;
#pragma unroll
            for (int mt = 0; mt < 2; ++mt)
#pragma unroll
                for (int i = 0; i < 16; ++i) { const int cp = 32 * mt + crow16(i, hh); const int oc = dir ? 63 - cp : cp; Od[(size_t)(tok0 + oc) * DM] = o[mt][i]; }
            __builtin_amdgcn_sched_barrier(0);
#pragma unroll
            for (int m = 0; m < 4; ++m) {
#pragma unroll
                for (int i = 0; i < 16; ++i) S[m][i] *= gl;
#pragma unroll
                for (int kst = 0; kst < 4; ++kst) S[m] = MFMA32(__builtin_bit_cast(bf16x8, Kf[(m * 4 + kst) * 64]), Vb[kst], S[m]);
            }
            __builtin_amdgcn_sched_barrier(0);
            __syncthreads();
        }
        if (!lat) { float* so = p.out + (size_t)NTOK * DM + (size_t)dir * (16 * 8 * 128 * 128) + (size_t)(b * 8 + h) * 16384 + 32 * jj + n;
#pragma unroll
            for (int m = 0; m < 4; ++m)
#pragma unroll
                for (int i = 0; i < 16; ++i) so[(size_t)(32 * m + crow16(i, hh)) * 128] = S[m][i]; }
    }
}
__device__ __forceinline__ void phase_dn_scan(const Params& p, const unsigned char* DN, const float* GL, float* OF, float* OBk, unsigned char* lds) {
    const int bx = blockIdx.x;
    if (gridDim.x >= 256) {
        const int ng = (bx >= 32 && bx < 64) ? 2 : 1;
#pragma unroll 1
        for (int gi = 0; gi < ng; ++gi) dn_scan_group(p, DN, GL, OF, OBk, lds, gi ? 224 + bx : bx);
    } else { for (int g = bx; g < 288; g += gridDim.x) dn_scan_group(p, DN, GL, OF, OBk, lds, g); }
}

__device__ __forceinline__ void phase_ogate(const Params& p, const float* OF, const float* OBk, const bf16_t* Z, bf16_t* OG, int wave, int lane) {
    const int gw = wave * gridDim.x + blockIdx.x, ngw = gridDim.x * NWAVES;
    for (int tok = gw; tok < NTOK; tok += ngw) {
#pragma unroll
        for (int hf = 0; hf < 2; ++hf) {
            const int ch0 = hf * 512 + lane * 8; const size_t o = (size_t)tok * DM + ch0;
            float a[8], b2[8], z[8], nw[8];
            load8f(OF + o, a); load8f(OBk + o, b2); unpack8(*(const v4u*)(Z + o), z); load8f(p.dn_norm_w + (ch0 & 127), nw);
            float ss = 0.f;
#pragma unroll
            for (int e = 0; e < 8; ++e) { a[e] += b2[e]; ss += a[e] * a[e]; }
            const float r = rsqrtf(sum16(ss) * (1.0f / 128.0f) + 1e-6f);
            float y[8];
#pragma unroll
            for (int e = 0; e < 8; ++e) y[e] = a[e] * r * nw[e] * siluf(z[e]);
            v4u ov; ov.x = pk2bf(y[0], y[1]); ov.y = pk2bf(y[2], y[3]); ov.z = pk2bf(y[4], y[5]); ov.w = pk2bf(y[6], y[7]);
            *(v4u*)(OG + o) = ov;
        }
    }
}

template <class Epi> __device__ __forceinline__ void run_gemm(PG8_LAS unsigned char* lds, const bf16_t* A, const bf16_t* Bt, int N, int K, const Epi& E, int nrep, int split = 1) {
    pg8::Gemm g; g.A = A; g.Bt = Bt; g.M = NTOK; g.N = N; g.K = K; g.klen = K / split; g.nsp = N / 256;
    pg8::StaticOrder S; S.init(NTOK, N * split, (int)gridDim.x, (int)blockIdx.x);
    pg8::gemm_phase<Epi, pg8::StaticOrder, false>(lds, g, S, E, nullptr);
    __syncthreads();
}

__global__ void __launch_bounds__(512) fwd_megakernel(Params p) {
    extern __shared__ __attribute__((aligned(16))) unsigned char shm[];
    cg::grid_group grid = cg::this_grid();
    PG8_LAS unsigned char* lds3 = (PG8_LAS unsigned char*)shm;
    const int wave = __builtin_amdgcn_readfirstlane(threadIdx.x >> 6), lane = threadIdx.x & 63;
    unsigned char* ws = p.ws;
    volatile XLAS unsigned* xst = (volatile XLAS unsigned*)(lds3 + (LDS_BYTES - 16));
    if (threadIdx.x == 0) { xst[0] = 0u; xst[1] = 0u; }
    __syncthreads();
    XcdBarrier xb = xcd_barrier_post((unsigned*)(ws + OFF_BAR), xst);
    float* X0 = (float*)(ws + OFF_X0); float* X1 = (float*)(ws + OFF_X1); float* MOD = (float*)(ws + OFF_MOD);
    bf16_t* PROJ = (bf16_t*)(ws + OFF_PROJ); float* EX = (float*)(ws + OFF_EX);
    bf16_t* AM = (bf16_t*)p.out;
    bf16_t* HB = (bf16_t*)(ws + OFF_PROJ);
    float* QF = (float*)(ws + OFF_DN); float* KF = QF + BLK; float* VF = KF + BLK; float* BG = VF + BLK;
    float* OF = (float*)(ws + OFF_PROJ); float* OBk = OF + BLK;
    float* PART = (float*)(ws + 66 * MiB);
    bf16_t* OG = PROJ + 4 * BLK; bf16_t* MRG = PROJ + 5 * BLK; float* GLp = (float*)(ws + OFF_EX + 786432);

#pragma unroll 1
    for (int rep = 0; rep < p.rep_prep; ++rep) { phase_prep(p, shm, wave, lane); __syncthreads(); }
    xcd_barrier(xb);
#pragma unroll 1
    for (int rep = 0; rep < p.rep_thin; ++rep) phase_norm<1>(p, nullptr, X0, p.norm_ffn1, 0, AM, wave, lane);
    xcd_barrier(xb);
    { pg8::EpiSwiglu E; E.H = HB; run_gemm(lds3, AM, (const bf16_t*)(ws + OFF_WGU), 5632, 1024, E, p.rep_gemm); }
    xcd_barrier(xb);
    { pg8::EpiPartial E; E.P = PART; run_gemm(lds3, HB, (const bf16_t*)(ws + OFF_WD), 1024, FFH, E, p.rep_gemm, 2); }
    xcd_barrier(xb);
#pragma unroll 1
    for (int rep = 0; rep < p.rep_thin; ++rep) phase_norm<2>(p, X0, X1, p.norm_mix, 3, AM, wave, lane, PART, 2, 0.5f);
    xcd_barrier(xb);
    { pg8::EpiProj E; E.P = PROJ; E.EX = EX; run_gemm(lds3, AM, (const bf16_t*)(ws + OFF_WIN), 9472, 1024, E, p.rep_gemm); }
    xcd_barrier(xb);
#pragma unroll 1
    for (int rep = 0; rep < p.rep_dnpre; ++rep) for (int it = blockIdx.x; it < 768; it += gridDim.x) dn_pre_item(p, PROJ, EX, ws + OFF_DN, GLp, shm, it >> 3, it & 7);
#pragma unroll 1
    for (int rep = 0; rep < p.rep_thin; ++rep) phase_branch_a(p, PROJ, AM, wave, lane);
    xcd_barrier(xb);
#pragma unroll 1
    for (int rep = 0; rep < p.rep_scan; ++rep) phase_dn_scan(p, ws + OFF_DN, GLp, OF, OBk, shm);
    xcd_barrier(xb);
#pragma unroll 1
    for (int rep = 0; rep < p.rep_thin; ++rep) phase_ogate(p, OF, OBk, PROJ + 6 * BLK, OG, wave, lane);
    {
        float* scr = (float*)shm + wave * (64 * 33); const int gw = wave * gridDim.x + blockIdx.x, ngw = gridDim.x * NWAVES;
        transpose_matrix(p.f2g, 1024, FFH, (bf16_t*)(ws + OFF_WGU), 1, gw, ngw, scr, lane);
        transpose_matrix(p.f2u, 1024, FFH, (bf16_t*)(ws + OFF_WGU), 2, gw, ngw, scr, lane);
        transpose_matrix(p.f2d, FFH, 1024, (bf16_t*)(ws + OFF_WD), 0, gw, ngw, scr, lane);
        __syncthreads();
    }
    xcd_barrier(xb);
    { pg8::EpiGate<0> E; E.G = PROJ + 7 * BLK; E.T = X0; E.O = nullptr; run_gemm(lds3, AM, (const bf16_t*)(ws + OFF_WCO), 1024, 1024, E, p.rep_gemm); }
    { pg8::EpiGate<1> E; E.G = PROJ + 8 * BLK; E.T = X0; E.O = MRG; run_gemm(lds3, OG, (const bf16_t*)(ws + OFF_WDNO), 1024, 1024, E, p.rep_gemm); }
    xcd_barrier(xb);
    { pg8::EpiPartial E; E.P = PART; run_gemm(lds3, MRG, (const bf16_t*)(ws + OFF_WO), 1024, 1024, E, p.rep_gemm, 2); }
    xcd_barrier(xb);
#pragma unroll 1
    for (int rep = 0; rep < p.rep_thin; ++rep) phase_norm<2>(p, X1, X0, p.norm_ffn2, 6, AM, wave, lane, PART, 5, 1.0f);
    xcd_barrier(xb);
    { pg8::EpiSwiglu E; E.H = HB; run_gemm(lds3, AM, (const bf16_t*)(ws + OFF_WGU), 5632, 1024, E, p.rep_gemm); }
    xcd_barrier(xb);
    { pg8::EpiPartial E; E.P = PART; run_gemm(lds3, HB, (const bf16_t*)(ws + OFF_WD), 1024, FFH, E, p.rep_gemm, 2); }
    xcd_barrier(xb);
#pragma unroll 1
    for (int rep = 0; rep < p.rep_sync; ++rep) grid.sync();
    phase_final_norm(p, X0, PART, p.out, wave, lane);
}

extern "C" void kernel_launch(void* const* d_in, const int* in_sizes, int n_in, void* d_out, int out_size, void* d_ws, size_t ws_size, hipStream_t stream) {
    static int grid_blocks = 0;
    if (grid_blocks == 0) {
        if (n_in != 27 || ws_size < WS_NEED) { fprintf(stderr, "kernel_launch: unexpected n_in %d / ws %zu\n", n_in, ws_size); grid_blocks = -1; return; }
        int dev = 0, cus = 0, per_cu = 0;
        hipGetDevice(&dev); hipDeviceGetAttribute(&cus, hipDeviceAttributeMultiprocessorCount, dev);
        hipFuncSetAttribute((const void*)fwd_megakernel, hipFuncAttributeMaxDynamicSharedMemorySize, LDS_BYTES);
        hipOccupancyMaxActiveBlocksPerMultiprocessor(&per_cu, (const void*)fwd_megakernel, 512, LDS_BYTES);
        if (per_cu < 1) { fprintf(stderr, "kernel_launch: occupancy query says %d blocks/CU\n", per_cu); per_cu = 1; }
        (void)hipGetLastError();
        grid_blocks = cus;
    }
    if (grid_blocks < 0) return;
    Params p{};
    const float** f = (const float**)&p;
    for (int i = 0; i < 27; ++i) f[i] = (const float*)d_in[i];
    p.out = (float*)d_out; p.ws = (unsigned char*)d_ws; p.rep_prep = REP_PREP; p.rep_gemm = REP_GEMM; p.rep_dnpre = REP_DNPRE; p.rep_scan = REP_SCAN; p.rep_thin = REP_THIN; p.rep_sync = REP_SYNC;
    (void)hipMemsetAsync((unsigned char*)d_ws + OFF_BAR, 0, XCD_BAR_WORDS * sizeof(unsigned), stream);
    void* args[] = {&p};
    hipError_t e = hipLaunchCooperativeKernel((const void*)fwd_megakernel, dim3(grid_blocks), dim3(512), args, LDS_BYTES, stream);
    if (e != hipSuccess) fprintf(stderr, "cooperative launch failed: %s (grid %d)\n", hipGetErrorString(e), grid_blocks);
}
```

```cpp
#include <hip/hip_runtime.h>
#include <hip/hip_cooperative_groups.h>
#include <cstdio>
#include <cstdint>
namespace cg = cooperative_groups;
#define REP_PREP 1
#define REP_GEMM 1
#define REP_DNPRE 1
#define REP_SCAN 1
#define REP_THIN 1
#define REP_SYNC 0
namespace pg8 {
#define PG8_LAS __attribute__((address_space(3)))
typedef unsigned short bf16_t;
typedef short bf16x8 __attribute__((ext_vector_type(8)));
typedef float f32x4 __attribute__((ext_vector_type(4)));
typedef unsigned u32x4 __attribute__((ext_vector_type(4)));
constexpr int BM = 256, BK = 64, HALF = 128, HTB = HALF * BK * 2  , STAGE_BYTES = 8 * HTB, NXCD = 8, WGM = 8;

__host__ __device__ __forceinline__ int lds_byte(int r, int c) { const int st = (r >> 4) * 2 + (c >> 5), rr = r & 15, cc = c & 31, ob = rr * 64 + cc * 2; return st * 1024 + (ob ^ (((ob >> 9) & 1) << 5)); }
__host__ __device__ __forceinline__ void stage_rc(int b, int& R, int& C) { const int st = b / 1024, sb = b % 1024, swz = sb ^ (((sb >> 9) & 1) << 5); R = (st >> 1) * 16 + swz / 64; C = (st & 1) * 32 + (swz % 64) / 2; }
__host__ __device__ __forceinline__ int perm32(int rho) { const int n = rho >> 4, i = rho & 15; return 8 * (i >> 2) + 4 * n + (i & 3); }

struct Unit { int pm, pn; };
struct Gemm { const bf16_t* A; const bf16_t* Bt; int M, N, K; int klen, nsp; };

struct StaticOrder {
    int nM, nN, nwg, G, c;
    __host__ __device__ void init(int M, int N, int G_, int c_) { nM = M / BM; nN = N / BM; nwg = nM * nN; G = G_; c = c_; }
    __host__ __device__ bool next(int i, Unit& u) const {
        const long L = (long)i * G + c; if (L >= nwg) return false;
        int wgid = (int)L; { const int q = nwg / NXCD, r = nwg % NXCD, xcd = wgid % NXCD, off = wgid / NXCD; wgid = (xcd < r ? xcd * (q + 1) : r * (q + 1) + (xcd - r) * q) + off; }
        const int nig = WGM * nN, gid = wgid / nig, fm = gid * WGM, gsz = (nM - fm) < WGM ? (nM - fm) : WGM;
        u.pm = fm + ((wgid % nig) % gsz); u.pn = (wgid % nig) / gsz; return true;
    }
    __device__ __forceinline__ void a_ready(const Unit&) const {}
    __device__ __forceinline__ void done(const Unit&) const {}
};
__device__ __forceinline__ unsigned pk2bf(float a, float b) { typedef float f2v __attribute__((ext_vector_type(2))); typedef __bf16 b2v __attribute__((ext_vector_type(2))); f2v v = {a, b}; b2v r = __builtin_convertvector(v, b2v); return __builtin_bit_cast(unsigned, r); }
__device__ __forceinline__ float bflo(unsigned u) { return __uint_as_float(u << 16); }
__device__ __forceinline__ float bfhi(unsigned u) { return __uint_as_float(u & 0xffff0000u); }
__device__ __forceinline__ float siluf(float x) { return x / (1.f + __expf(-x)); }
__device__ __forceinline__ float sigmf(float x) { return 1.f / (1.f + __expf(-x)); }
__device__ __forceinline__ int cond_of_tile(int pm) { return pm < 16 ? 0 : 1 + ((pm - 16) >> 2); }
constexpr int NTOK = 6144, DM = 1024, FFH = 2816, NMOD = 9216;
typedef unsigned u32x2 __attribute__((ext_vector_type(2)));

struct EpiSwiglu {
    static constexpr bool PERM = true, AFTER_DRAIN = false;
    bf16_t* H;
    __device__ __forceinline__ void operator()(const f32x4 (&acc)[2][2][4][2], const Unit& u, int wr, int wc, int fr, int fq) const {
        const int row0 = u.pm * BM + wr * 64 + fr, col0 = u.pn * 128 + wc * 32 + 8 * fq;
#pragma unroll
        for (int ai = 0; ai < 2; ++ai)
#pragma unroll
            for (int m = 0; m < 4; ++m) { bf16_t* rowp = H + (size_t)(row0 + ai * HALF + m * 16) * FFH + col0;
                const f32x4 g0 = acc[ai][0][m][0], u0 = acc[ai][1][m][0], g1 = acc[ai][0][m][1], u1 = acc[ai][1][m][1];
                u32x4 o; o.x = pk2bf(siluf(g0[0]) * u0[0], siluf(g0[1]) * u0[1]); o.y = pk2bf(siluf(g0[2]) * u0[2], siluf(g0[3]) * u0[3]);
                o.z = pk2bf(siluf(g1[0]) * u1[0], siluf(g1[1]) * u1[1]); o.w = pk2bf(siluf(g1[2]) * u1[2], siluf(g1[3]) * u1[3]);
                *(u32x4*)rowp = o; }
    }
};
struct EpiResid {
    static constexpr bool PERM = false, AFTER_DRAIN = false;
    const float* Xin; float* Xout; const float* gate; float scale;
    __device__ __forceinline__ void operator()(const f32x4 (&acc)[2][2][4][2], const Unit& u, int wr, int wc, int fr, int fq) const {
        const int row0 = u.pm * BM + wr * 64 + fr, col0 = u.pn * BM + wc * 32 + 4 * fq;
        const float* gp = gate + (size_t)cond_of_tile(u.pm) * NMOD + col0;
        f32x4 gv[2][2];
#pragma unroll
        for (int bj = 0; bj < 2; ++bj)
#pragma unroll
            for (int n = 0; n < 2; ++n) gv[bj][n] = *(const f32x4*)(gp + bj * HALF + n * 16) * scale;
#pragma unroll
        for (int ai = 0; ai < 2; ++ai)
#pragma unroll
            for (int m = 0; m < 4; ++m) { const size_t off = (size_t)(row0 + ai * HALF + m * 16) * DM + col0;
#pragma unroll
                for (int bj = 0; bj < 2; ++bj)
#pragma unroll
                    for (int n = 0; n < 2; ++n) { const f32x4 x = *(const f32x4*)(Xin + off + bj * HALF + n * 16);
                        *(f32x4*)(Xout + off + bj * HALF + n * 16) = x + gv[bj][n] * acc[ai][bj][m][n]; } }
    }
};
struct EpiProj {
    static constexpr bool PERM = true, AFTER_DRAIN = false;
    bf16_t* P; float* EX;
    __device__ __forceinline__ void operator()(const f32x4 (&acc)[2][2][4][2], const Unit& u, int wr, int wc, int fr, int fq) const {
        const int row0 = u.pm * BM + wr * 64 + fr;
        if (u.pn < 36) {
            bf16_t* base = P + (size_t)(u.pn >> 2) * NTOK * DM; const int col0 = (u.pn & 3) * 256 + wc * 32 + 8 * fq;
#pragma unroll
            for (int ai = 0; ai < 2; ++ai)
#pragma unroll
                for (int m = 0; m < 4; ++m) { bf16_t* rowp = base + (size_t)(row0 + ai * HALF + m * 16) * DM + col0;
#pragma unroll
                    for (int bj = 0; bj < 2; ++bj) { const f32x4 v0 = acc[ai][bj][m][0], v1 = acc[ai][bj][m][1];
                        u32x4 o; o.x = pk2bf(v0[0], v0[1]); o.y = pk2bf(v0[2], v0[3]); o.z = pk2bf(v1[0], v1[1]); o.w = pk2bf(v1[2], v1[3]); *(u32x4*)(rowp + bj * HALF) = o; } }
        } else if (wc == 0) {
#pragma unroll
            for (int ai = 0; ai < 2; ++ai)
#pragma unroll
                for (int m = 0; m < 4; ++m)
#pragma unroll
                    for (int n = 0; n < 2; ++n) *(f32x4*)(EX + (size_t)(row0 + ai * HALF + m * 16) * 32 + 8 * fq + 4 * n) = acc[ai][0][m][n];
        }
    }
};
struct EpiPartial {
    static constexpr bool PERM = false, AFTER_DRAIN = false;
    float* P;
    __device__ __forceinline__ void operator()(const f32x4 (&acc)[2][2][4][2], const Unit& u, int wr, int wc, int fr, int fq) const {
        const int kh = u.pn >> 2, pn = u.pn & 3;
        const int row0 = u.pm * BM + wr * 64 + fr, col0 = pn * BM + wc * 32 + 4 * fq;
        float* base = P + (size_t)kh * NTOK * DM;
#pragma unroll
        for (int ai = 0; ai < 2; ++ai)
#pragma unroll
            for (int m = 0; m < 4; ++m) { float* rowp = base + (size_t)(row0 + ai * HALF + m * 16) * DM + col0;
#pragma unroll
                for (int bj = 0; bj < 2; ++bj)
#pragma unroll
                    for (int n = 0; n < 2; ++n) *(f32x4*)(rowp + bj * HALF + n * 16) = acc[ai][bj][m][n]; }
    }
};
template <int SECOND> struct EpiGate {
    static constexpr bool PERM = false, AFTER_DRAIN = false;
    const bf16_t* G; float* T; bf16_t* O;
    __device__ __forceinline__ void operator()(const f32x4 (&acc)[2][2][4][2], const Unit& u, int wr, int wc, int fr, int fq) const {
        const int row0 = u.pm * BM + wr * 64 + fr, col0 = u.pn * BM + wc * 32 + 4 * fq;
#pragma unroll
        for (int ai = 0; ai < 2; ++ai)
#pragma unroll
            for (int m = 0; m < 4; ++m) { const size_t off = (size_t)(row0 + ai * HALF + m * 16) * DM + col0;
#pragma unroll
                for (int bj = 0; bj < 2; ++bj)
#pragma unroll
                    for (int n = 0; n < 2; ++n) { const size_t o = off + bj * HALF + n * 16; const u32x2 gr = *(const u32x2*)(G + o); const f32x4 a = acc[ai][bj][m][n];
                        f32x4 v; v[0] = sigmf(bflo(gr.x)) * a[0]; v[1] = sigmf(bfhi(gr.x)) * a[1]; v[2] = sigmf(bflo(gr.y)) * a[2]; v[3] = sigmf(bfhi(gr.y)) * a[3];
                        if (SECOND == 0) *(f32x4*)(T + o) = v;
                        else { const f32x4 t = *(const f32x4*)(T + o); v = v + t; u32x2 w; w.x = pk2bf(v[0], v[1]); w.y = pk2bf(v[2], v[3]); *(u32x2*)(O + o) = w; } } }
    }
};

template <class Epi, class Sched, bool STAMP = false>
__device__ __forceinline__ void gemm_phase(PG8_LAS unsigned char* lds, const Gemm g, const Sched& S, const Epi& E, unsigned long long* stamps) {
    int tid_l = threadIdx.x; asm volatile("" : "+v"(tid_l));
    const int tid = tid_l, wid = __builtin_amdgcn_readfirstlane(tid >> 6), lane = tid & 63, wr = wid >> 2, wc = wid & 3, fr = lane & 15, fq = lane >> 4;
    const int K = g.K, nt = g.klen / BK;
    int ts_lo = 0, ts_hi = 0, nts = 0; const unsigned long long rt_entry = STAMP ? (unsigned long long)wall_clock64() : 0ull;
#define PG8_STAMP() do { if (STAMP && wid == 0 && nts < 64) { const unsigned long long _c = (unsigned long long)clock64(); \
        ts_lo = (lane == nts) ? (int)(unsigned)_c : ts_lo; ts_hi = (lane == nts) ? (int)(unsigned)(_c >> 32) : ts_hi; ++nts; } } while (0)
    PG8_STAMP();
    unsigned voffA[2], voffB[2];
#pragma unroll
    for (int i = 0; i < 2; ++i) { int R, C; stage_rc(tid * 16 + i * 8192, R, C); const int Rb = Epi::PERM ? ((R & ~31) + perm32(R & 31)) : R;
        voffA[i] = (unsigned)(R * K + C) * 2u; voffB[i] = (unsigned)(Rb * K + C) * 2u; }
    const size_t kstep = (size_t)(BK * 2);
    const size_t hstep = (size_t)HALF * K * 2;
    const size_t tstep = 2 * hstep;
    const unsigned ldsw = (unsigned)wid * 1024u;
    const int aoff = lds_byte(wr * 64 + fr, fq * 8), boff = lds_byte(wc * 32 + fr, fq * 8);
#define PG8_SA(b, h) (((b) * 2 + (h)) * HTB)
#define PG8_SB(b, h) ((4 + (b) * 2 + (h)) * HTB)
#define PG8_STAGE(bufoff, gbase, voff) do { _Pragma("unroll") for (int _i = 0; _i < 2; ++_i) \
        __builtin_amdgcn_global_load_lds((const unsigned*)((const char*)(gbase) + (voff)[_i]), (PG8_LAS unsigned*)(lds + (bufoff) + ldsw + _i * 8192), 16, 0, 0); } while (0)
#define PG8_LDA(dst, b, h) do { _Pragma("unroll") for (int m = 0; m < 4; ++m) _Pragma("unroll") for (int k = 0; k < 2; ++k) dst[m][k] = *(const PG8_LAS bf16x8*)(lds + PG8_SA(b, h) + aoff + m * 2048 + k * 1024); } while (0)
#define PG8_LDB(dst, b, h) do { _Pragma("unroll") for (int n = 0; n < 2; ++n) _Pragma("unroll") for (int k = 0; k < 2; ++k) dst[n][k] = *(const PG8_LAS bf16x8*)(lds + PG8_SB(b, h) + boff + n * 2048 + k * 1024); } while (0)
#define PG8_MMA(ai, bj, At, Bt) do { __builtin_amdgcn_s_setprio(1); _Pragma("unroll") for (int m = 0; m < 4; ++m) _Pragma("unroll") for (int n = 0; n < 2; ++n) _Pragma("unroll") for (int k = 0; k < 2; ++k) \
        acc[ai][bj][m][n] = __builtin_amdgcn_mfma_f32_16x16x32_bf16(Bt[n][k], At[m][k], acc[ai][bj][m][n], 0, 0, 0); __builtin_amdgcn_s_setprio(0); } while (0)
#define PG8_WAIT_V(n) asm volatile("s_waitcnt vmcnt(" #n ")" ::: "memory")
#define PG8_WAIT_L(n) asm volatile("s_waitcnt lgkmcnt(" #n ")" ::: "memory")
#define PG8_BAR __builtin_amdgcn_s_barrier()
#define PG8_SCHED __builtin_amdgcn_sched_barrier(0)
    Unit cur, nxt; int ui = 0;
    if (!S.next(0, cur)) return;
    f32x4 acc[2][2][4][2];
#pragma unroll
    for (int a = 0; a < 2; ++a)
#pragma unroll
        for (int b = 0; b < 2; ++b)
#pragma unroll
            for (int m = 0; m < 4; ++m)
#pragma unroll
                for (int n = 0; n < 2; ++n) acc[a][b][m][n] = (f32x4){0.f, 0.f, 0.f, 0.f};
    bf16x8 At[4][2], B0[2][2], B1[2][2];
    const size_t khb = (size_t)g.klen * 2;
    const char* cA = (const char*)g.A + (size_t)cur.pm * tstep + (cur.pn >= g.nsp ? khb : 0); const char* cB = (const char*)g.Bt + (size_t)(cur.pn >= g.nsp ? cur.pn - g.nsp : cur.pn) * tstep + (cur.pn >= g.nsp ? khb : 0);
    S.a_ready(cur);
    PG8_STAGE(PG8_SB(0, 0), cB, voffB); PG8_STAGE(PG8_SA(0, 0), cA, voffA); PG8_STAGE(PG8_SB(0, 1), cB + hstep, voffB); PG8_STAGE(PG8_SA(0, 1), cA + hstep, voffA);
    if (wr == 1) PG8_BAR;
    PG8_WAIT_V(4); PG8_BAR;
    PG8_STAGE(PG8_SB(1, 0), cB + kstep, voffB); PG8_STAGE(PG8_SA(1, 0), cA + kstep, voffA); PG8_STAGE(PG8_SB(1, 1), cB + hstep + kstep, voffB);
    PG8_WAIT_V(6); PG8_BAR;
    PG8_STAMP();
    for (;;) {
        const bool has_next = S.next(ui + 1, nxt);
        const char* nA = has_next ? (const char*)g.A + (size_t)nxt.pm * tstep + (nxt.pn >= g.nsp ? khb : 0) : cA; const char* nB = has_next ? (const char*)g.Bt + (size_t)(nxt.pn >= g.nsp ? nxt.pn - g.nsp : nxt.pn) * tstep + (nxt.pn >= g.nsp ? khb : 0) : cB;
        for (int t = 0; t < nt; t += 2) {
            const bool last = (t == nt - 2);
            const char* a1 = cA + (size_t)(t + 1) * kstep;
            const char* a2 = last ? nA : cA + (size_t)(t + 2) * kstep; const char* b2 = last ? nB : cB + (size_t)(t + 2) * kstep;
            const char* a3 = a2 + kstep; const char* b3 = b2 + kstep;
            if (last && has_next) S.a_ready(nxt);
            PG8_LDB(B0, 0, 0); PG8_SCHED; PG8_LDA(At, 0, 0); PG8_STAGE(PG8_SA(1, 1), a1 + hstep, voffA);
            PG8_WAIT_L(8); PG8_BAR; PG8_WAIT_L(0); PG8_MMA(0, 0, At, B0); PG8_BAR; PG8_SCHED;
            PG8_LDB(B1, 0, 1); PG8_STAGE(PG8_SB(0, 0), b2, voffB);
            PG8_BAR; PG8_WAIT_L(0); PG8_MMA(0, 1, At, B1); PG8_BAR;
            PG8_LDA(At, 0, 1); PG8_STAGE(PG8_SA(0, 0), a2, voffA);
            PG8_BAR; PG8_WAIT_L(0); PG8_MMA(1, 0, At, B0); PG8_BAR; PG8_SCHED;
            PG8_STAGE(PG8_SB(0, 1), b2 + hstep, voffB);
            PG8_WAIT_V(6); PG8_BAR; PG8_MMA(1, 1, At, B1); PG8_BAR;
            PG8_LDB(B0, 1, 0); PG8_SCHED; PG8_LDA(At, 1, 0); PG8_STAGE(PG8_SA(0, 1), a2 + hstep, voffA);
            PG8_WAIT_L(8); PG8_BAR; PG8_WAIT_L(0); PG8_MMA(0, 0, At, B0); PG8_BAR; PG8_SCHED;
            PG8_LDB(B1, 1, 1); PG8_STAGE(PG8_SB(1, 0), b3, voffB);
            PG8_BAR; PG8_WAIT_L(0); PG8_MMA(0, 1, At, B1); PG8_BAR;
            PG8_LDA(At, 1, 1); PG8_STAGE(PG8_SA(1, 0), a3, voffA);
            PG8_BAR; PG8_WAIT_L(0); PG8_MMA(1, 0, At, B0); PG8_BAR; PG8_SCHED;
            PG8_STAGE(PG8_SB(1, 1), b3 + hstep, voffB);
            PG8_WAIT_V(6); PG8_BAR; PG8_MMA(1, 1, At, B1); PG8_BAR;
        }
        PG8_STAMP();
        if constexpr (!Epi::AFTER_DRAIN) { E(acc, cur, wr, wc, fr, fq); S.done(cur); }
        PG8_STAMP();
        if (!has_next) break;
#pragma unroll
        for (int a = 0; a < 2; ++a)
#pragma unroll
            for (int b = 0; b < 2; ++b)
#pragma unroll
                for (int m = 0; m < 4; ++m)
#pragma unroll
                    for (int n = 0; n < 2; ++n) acc[a][b][m][n] = (f32x4){0.f, 0.f, 0.f, 0.f};
        cur = nxt; cA = nA; cB = nB; ++ui;
    }
    PG8_WAIT_V(0);
    if (wr == 0) PG8_BAR;
    PG8_BAR;
    if constexpr (Epi::AFTER_DRAIN) { E.fused(acc, cur, wr, wc, fr, fq, lds, wid, lane); S.done(cur); }
    PG8_STAMP();
    if (STAMP && wid == 0) { stamps[lane] = lane < nts ? (((unsigned long long)(unsigned)ts_hi << 32) | (unsigned)ts_lo) : 0ull;
        if (lane == 62) stamps[62] = rt_entry; if (lane == 63) stamps[63] = (unsigned long long)wall_clock64(); }
#undef PG8_STAMP
#undef PG8_SA
#undef PG8_SB
#undef PG8_STAGE
#undef PG8_LDA
#undef PG8_LDB
#undef PG8_MMA
#undef PG8_WAIT_V
#undef PG8_WAIT_L
#undef PG8_BAR
#undef PG8_SCHED
}
}
#define XB_TMO      128
#define XB_XCNT(j)  (256  + 64 * (j))
#define XB_XSUB(j)  (1280 + 64 * (j))
#define XB_XGEN(j)  (2304 + 64 * (j))
#define XB_TOP      3328
#define XB_TOPGEN   3392
#define XCD_BAR_WORDS 3456
#define XB_SPIN_CAP (1u << 18)
#define XLAS __attribute__((address_space(3)))

__device__ __forceinline__ unsigned xb_ld(unsigned* p)              { return __hip_atomic_load(p, __ATOMIC_RELAXED, __HIP_MEMORY_SCOPE_AGENT); }
__device__ __forceinline__ unsigned xb_add(unsigned* p, unsigned v) { return __hip_atomic_fetch_add(p, v, __ATOMIC_RELAXED, __HIP_MEMORY_SCOPE_AGENT); }
__device__ __forceinline__ unsigned xb_xcc_id() { return (unsigned)__builtin_amdgcn_s_getreg((3 << 11) | 20) & 0xFu; }
#define XB_SPIN(cond, bar) do { unsigned _sp = 0; while (cond) { __builtin_amdgcn_s_sleep(1); \
    if ((++_sp & 255u) == 0u) { if (xb_ld(&(bar)[XB_TMO])) break; if (_sp > XB_SPIN_CAP) { atomicAdd(&(bar)[XB_TMO], 1u); break; } } } } while (0)

struct XcdBarrier {
    unsigned* bar; unsigned x;
    volatile XLAS unsigned* st;
};

__device__ __forceinline__ XcdBarrier xcd_barrier_post(unsigned* bar, volatile XLAS unsigned* st) {
    XcdBarrier b; b.bar = bar; b.x = xb_xcc_id(); b.st = st;
    if (threadIdx.x == 0) (void)xb_add(&bar[XB_XCNT(b.x)], 1u);
    return b;
}
__device__ __forceinline__ void xcd_barrier_complete(unsigned* bar, unsigned x, unsigned& nloc, unsigned& nx) {
    const unsigned G = gridDim.x * gridDim.y * gridDim.z;
    unsigned sum, cnt, mine, sp = 0u;
    for (;;) {
        sum = 0u; cnt = 0u; mine = 0u;
#pragma unroll
        for (unsigned j = 0; j < 16; ++j) { const unsigned c = xb_ld(&bar[XB_XCNT(j)]); sum += c; cnt += (c > 0u) ? 1u : 0u; mine = (j == x) ? c : mine; }
        if (sum == G) break;
        __builtin_amdgcn_s_sleep(1);
        if ((++sp & 255u) == 0u) { if (xb_ld(&bar[XB_TMO])) break; if (sp > XB_SPIN_CAP) { atomicAdd(&bar[XB_TMO], 1u); break; } }
    }
    nloc = mine > 0u ? mine : 1u; nx = cnt > 0u ? cnt : 1u;
}

__device__ __forceinline__ void xcd_barrier(const XcdBarrier& b) {
    asm volatile("s_waitcnt vmcnt(0)" ::: "memory");
    __syncthreads();
    if (threadIdx.x == 0) {
        unsigned* bar = b.bar;
        __builtin_amdgcn_s_waitcnt(0);
        unsigned nloc = b.st[0], nx = b.st[1];
        if (nloc == 0u) { xcd_barrier_complete(bar, b.x, nloc, nx); b.st[0] = nloc; b.st[1] = nx; }
        const unsigned old = xb_add(&bar[XB_XSUB(b.x)], 1u);
        const unsigned gen = old / nloc;
        if (old + 1u == (gen + 1u) * nloc) {
            __builtin_amdgcn_fence(__ATOMIC_RELEASE, "agent");
            asm volatile("s_waitcnt vmcnt(0)" ::: "memory");
            const unsigned og = xb_add(&bar[XB_TOP], 1u);
            const unsigned tg = og / nx;
            if (og + 1u == (tg + 1u) * nx) xb_add(&bar[XB_TOPGEN], 1u);
            else XB_SPIN(xb_ld(&bar[XB_TOPGEN]) == tg, bar);
            __builtin_amdgcn_fence(__ATOMIC_ACQUIRE, "agent");
            xb_add(&bar[XB_XGEN(b.x)], 1u);
            asm volatile("s_waitcnt vmcnt(0)" ::: "memory");
        } else {
            XB_SPIN(xb_ld(&bar[XB_XGEN(b.x)]) == gen, bar);
            __builtin_amdgcn_fence(__ATOMIC_ACQUIRE, "agent");
            asm volatile("s_waitcnt vmcnt(0)" ::: "memory");
        }
    }
    __syncthreads();
}


using pg8::bf16_t; using pg8::f32x4; using pg8::pk2bf; using pg8::bflo; using pg8::bfhi; using pg8::siluf; using pg8::sigmf; using pg8::u32x2;
using pg8::NTOK; using pg8::DM; using pg8::FFH; using pg8::NMOD;
typedef unsigned v4u __attribute__((ext_vector_type(4)));
#define LDS_WAIT() asm volatile("s_waitcnt lgkmcnt(0)" ::: "memory")
constexpr int NCTX = 4096, NWAVES = 8, LDS_BYTES = 139264;
constexpr size_t MiB = 1048576;
constexpr size_t OFF_WCO = 0, OFF_WDNO = 2 * MiB, OFF_WO = 4 * MiB;
constexpr size_t OFF_WGU = 6 * MiB;
constexpr size_t OFF_WD = 17 * MiB;
constexpr size_t OFF_WIN = 23 * MiB;
constexpr size_t OFF_X0 = 42 * MiB;
constexpr size_t OFF_DN = 6 * MiB;
constexpr size_t OFF_X1 = 114 * MiB;
constexpr size_t OFF_PROJ = 138 * MiB;
constexpr size_t OFF_EX = 246 * MiB;
constexpr size_t OFF_MOD = 247 * MiB;
constexpr size_t OFF_BAR = 247 * MiB + 512 * 1024;
constexpr size_t WS_NEED = 248 * MiB;
constexpr size_t BLK = (size_t)NTOK * DM;

struct Params {
    const float *x_prompt, *x_sample, *st_f, *st_b, *c, *c_ctx, *ada_w, *ada_b, *norm_ffn1, *f1g, *f1u, *f1d, *norm_mix, *w_in, *conv_w, *conv_out_w,
        *dn_conv_w, *dn_a_log, *dn_dt_bias, *dn_norm_w, *dn_out_w, *w_o, *norm_ffn2, *f2g, *f2u, *f2d, *norm_f;
    float* out; unsigned char* ws; int rep_prep, rep_gemm, rep_dnpre, rep_scan, rep_thin, rep_sync;
};

__device__ __forceinline__ float wave_sum(float v) {
#pragma unroll
    for (int o = 1; o < 64; o <<= 1) v += __shfl_xor(v, o);
    return v;
}
__device__ __forceinline__ float sum16(float v) {
#pragma unroll
    for (int o = 1; o < 16; o <<= 1) v += __shfl_xor(v, o);
    return v;
}
__device__ __forceinline__ void transpose_item(const float* W, int N, int k0, int n0, bf16_t* WT, int Kd, int dst_row0, float* scr, int lane) {
#pragma unroll 8
    for (int i = 0; i < 32; ++i) { const int kk = 2 * i + (lane >> 5); scr[kk * 33 + (lane & 31)] = W[(size_t)(k0 + kk) * N + n0 + (lane & 31)]; }
    LDS_WAIT();
    const int c = lane & 7;
#pragma unroll
    for (int j = 0; j < 4; ++j) { const int n = (lane >> 3) + 8 * j; const float* s = scr + (8 * c) * 33 + n;
        v4u o; o.x = pk2bf(s[0 * 33], s[1 * 33]); o.y = pk2bf(s[2 * 33], s[3 * 33]); o.z = pk2bf(s[4 * 33], s[5 * 33]); o.w = pk2bf(s[6 * 33], s[7 * 33]);
        *(v4u*)(WT + (size_t)(dst_row0 + n) * Kd + k0 + 8 * c) = o; }
    LDS_WAIT();
}
__device__ __forceinline__ void transpose_matrix(const float* W, int K, int N, bf16_t* WT, int mode, int gw, int ngw, float* scr, int lane) {
    const int nblk = N / 32, nitems = (K / 64) * nblk;
    for (int it = gw; it < nitems; it += ngw) {
        const int kb = it / nblk, nb = it % nblk, n0 = nb * 32;
        const int dr = mode == 0 ? n0 : ((n0 >> 7) * 256 + (n0 & 127) + (mode == 2 ? 128 : 0));
        transpose_item(W, N, kb * 64, n0, WT, K, dr, scr, lane);
    }
}

__device__ __forceinline__ void phase_prep(const Params& p, unsigned char* lds, int wave, int lane) {
    unsigned char* ws = p.ws;
    float* scr = (float*)lds + wave * (64 * 33);
    const int gw = wave * gridDim.x + blockIdx.x, ngw = gridDim.x * NWAVES;
    transpose_matrix(p.f1g, 1024, FFH, (bf16_t*)(ws + OFF_WGU), 1, gw, ngw, scr, lane);
    transpose_matrix(p.f1u, 1024, FFH, (bf16_t*)(ws + OFF_WGU), 2, gw, ngw, scr, lane);
    __syncthreads();
    float* sc = (float*)lds;
    float* red = (float*)lds + 3072;
    if ((int)blockIdx.x < 144) {
        for (int i = threadIdx.x; i < 3072; i += 512) { const int cc = i >> 10, k = i & 1023; const float v = cc == 0 ? p.c_ctx[k] : p.c[(cc - 1) * 1024 + k]; sc[i] = siluf(v); }
        __syncthreads();
        for (int it = blockIdx.x; it < 144; it += gridDim.x) {
            const int n = it * 64 + lane; float a0 = 0.f, a1 = 0.f, a2 = 0.f;
            const float* wp = p.ada_w + (size_t)(wave * 128) * NMOD + n;
#pragma unroll 8
            for (int k = 0; k < 128; ++k) { const float wv = wp[(size_t)k * NMOD]; const int kk = wave * 128 + k; a0 += sc[kk] * wv; a1 += sc[1024 + kk] * wv; a2 += sc[2048 + kk] * wv; }
            red[(wave * 3 + 0) * 64 + lane] = a0; red[(wave * 3 + 1) * 64 + lane] = a1; red[(wave * 3 + 2) * 64 + lane] = a2;
            __syncthreads();
            if (threadIdx.x < 192) { const int cc = threadIdx.x >> 6, l = threadIdx.x & 63; float s = 0.f;
#pragma unroll
                for (int w = 0; w < 8; ++w) s += red[(w * 3 + cc) * 64 + l];
                ((float*)(ws + OFF_MOD))[cc * NMOD + it * 64 + l] = s + p.ada_b[it * 64 + l]; }
            __syncthreads();
        }
    }
}


__device__ __forceinline__ void side_transposes(const Params& p, unsigned char* lds, int wave, int lane, int which, int b0) {
    if (gridDim.x < 256) b0 = 0;
    const int nb = (int)gridDim.x - b0, bi = (int)blockIdx.x - b0;
    if (bi < 0) return;
    unsigned char* ws = p.ws;
    float* scr = (float*)lds + wave * (64 * 33);
    const int gw = wave * nb + bi, ngw = nb * NWAVES;
    if (which == 0) {
        transpose_matrix(p.f1d, FFH, 1024, (bf16_t*)(ws + OFF_WD), 0, gw, ngw, scr, lane);
    } else if (which == 1) {
        transpose_matrix(p.w_in, 1024, 9248, (bf16_t*)(ws + OFF_WIN), 0, gw, ngw, scr, lane);
        transpose_matrix(p.conv_out_w, 1024, 1024, (bf16_t*)(ws + OFF_WCO), 0, gw, ngw, scr, lane);
        transpose_matrix(p.dn_out_w, 1024, 1024, (bf16_t*)(ws + OFF_WDNO), 0, gw, ngw, scr, lane);
        transpose_matrix(p.w_o, 1024, 1024, (bf16_t*)(ws + OFF_WO), 0, gw, ngw, scr, lane);
        v4u z = {0u, 0u, 0u, 0u}; v4u* zp = (v4u*)((bf16_t*)(ws + OFF_WIN) + (size_t)9248 * 1024);
        const int nz = 224 * 1024 * 2 / 16;
        for (int i = bi * 512 + (int)threadIdx.x; i < nz; i += nb * 512) zp[i] = z;
    } else {
        transpose_matrix(p.f2g, 1024, FFH, (bf16_t*)(ws + OFF_WGU), 1, gw, ngw, scr, lane);
        transpose_matrix(p.f2u, 1024, FFH, (bf16_t*)(ws + OFF_WGU), 2, gw, ngw, scr, lane);
        transpose_matrix(p.f2d, FFH, 1024, (bf16_t*)(ws + OFF_WD), 0, gw, ngw, scr, lane);
    }
    __syncthreads();
}

template <int FIRST> __device__ __forceinline__ void phase_norm(const Params& p, const float* X, float* X0, const float* nw, int modi, bf16_t* A, int wave, int lane, const float* PART = nullptr, int gatei = 0, float gscale = 0.f) {
    const float* mod = (const float*)(p.ws + OFF_MOD);
    const int gw = wave * gridDim.x + blockIdx.x, ngw = gridDim.x * NWAVES;
    for (int row = gw; row < NTOK; row += ngw) {
        const int cond = row < NCTX ? 0 : 1 + ((row - NCTX) >> 10);
        f32x4 v[4];
        if (FIRST == 1) {
            const float* src = row < NCTX ? p.x_prompt + (size_t)row * DM : p.x_sample + (size_t)(row - NCTX) * DM;
#pragma unroll
            for (int j = 0; j < 4; ++j) v[j] = *(const f32x4*)(src + 4 * lane + 256 * j);
            if (row >= NCTX) {
                const int t = (row - NCTX) & 1023; const float r = (float)(t >> 6), cl = (float)(t & 63);
#pragma unroll
                for (int e = 0; e < 4; ++e) { const int i = 4 * lane + e; const float om = 1.0f / powf(10000.0f, (float)i * (1.0f / 256.0f));
                    v[0][e] += sinf(r * om); v[1][e] += cosf(r * om); v[2][e] += sinf(cl * om); v[3][e] += cosf(cl * om); }
            }
#pragma unroll
            for (int j = 0; j < 4; ++j) *(f32x4*)(X0 + (size_t)row * DM + 4 * lane + 256 * j) = v[j];
        } else if (FIRST == 2) {
            const float* gp = mod + (size_t)cond * NMOD + gatei * 1024;
#pragma unroll
            for (int j = 0; j < 4; ++j) { const size_t o = (size_t)row * DM + 4 * lane + 256 * j;
                const f32x4 x = *(const f32x4*)(X + o), p0 = *(const f32x4*)(PART + o), p1 = *(const f32x4*)(PART + BLK + o), gg = *(const f32x4*)(gp + 4 * lane + 256 * j);
                v[j] = x + (gg * gscale) * (p0 + p1); *(f32x4*)(X0 + o) = v[j]; }
        } else {
#pragma unroll
            for (int j = 0; j < 4; ++j) v[j] = *(const f32x4*)(X + (size_t)row * DM + 4 * lane + 256 * j);
        }
        float ss = 0.f;
#pragma unroll
        for (int j = 0; j < 4; ++j) ss += v[j][0] * v[j][0] + v[j][1] * v[j][1] + v[j][2] * v[j][2] + v[j][3] * v[j][3];
        const float rstd = rsqrtf(wave_sum(ss) * (1.0f / 1024.0f) + 1e-6f);
        const float* sh = mod + (size_t)cond * NMOD + modi * 1024; const float* scp = sh + 1024;
#pragma unroll
        for (int j = 0; j < 4; ++j) { const int d = 4 * lane + 256 * j; const f32x4 w = *(const f32x4*)(nw + d), s1 = *(const f32x4*)(scp + d), s0 = *(const f32x4*)(sh + d);
            f32x4 y;
#pragma unroll
            for (int e = 0; e < 4; ++e) y[e] = v[j][e] * rstd * w[e] * (1.f + s1[e]) + s0[e];
            u32x2 o; o.x = pk2bf(y[0], y[1]); o.y = pk2bf(y[2], y[3]); *(u32x2*)(A + (size_t)row * DM + d) = o; }
    }
}
__device__ __forceinline__ void phase_final_norm(const Params& p, const float* X, const float* PART, float* Y, int wave, int lane) {
    const float* mod = (const float*)(p.ws + OFF_MOD);
    const int gw = wave * gridDim.x + blockIdx.x, ngw = gridDim.x * NWAVES;
    for (int row = gw; row < NTOK; row += ngw) {
        f32x4 v[4]; float ss = 0.f;
#pragma unroll
        for (int j = 0; j < 4; ++j) { const size_t o = (size_t)row * DM + 4 * lane + 256 * j; const int cond = row < NCTX ? 0 : 1 + ((row - NCTX) >> 10);
            const f32x4 x = *(const f32x4*)(X + o), p0 = *(const f32x4*)(PART + o), p1 = *(const f32x4*)(PART + BLK + o), gg = *(const f32x4*)(mod + (size_t)cond * NMOD + 8 * 1024 + 4 * lane + 256 * j);
            v[j] = x + (gg * 0.5f) * (p0 + p1); ss += v[j][0] * v[j][0] + v[j][1] * v[j][1] + v[j][2] * v[j][2] + v[j][3] * v[j][3]; }
        const float rstd = rsqrtf(wave_sum(ss) * (1.0f / 1024.0f) + 1e-6f);
#pragma unroll
        for (int j = 0; j < 4; ++j) { const f32x4 w = *(const f32x4*)(p.norm_f + 4 * lane + 256 * j); *(f32x4*)(Y + (size_t)row * DM + 4 * lane + 256 * j) = v[j] * rstd * w; }
    }
}

__device__ __forceinline__ void unpack8(const v4u r, float (&f)[8]) { f[0] = bflo(r.x); f[1] = bfhi(r.x); f[2] = bflo(r.y); f[3] = bfhi(r.y); f[4] = bflo(r.z); f[5] = bfhi(r.z); f[6] = bflo(r.w); f[7] = bfhi(r.w); }
__device__ __forceinline__ void load8f(const float* p, float (&f)[8]) { const f32x4 a = *(const f32x4*)p, b = *(const f32x4*)(p + 4); f[0] = a[0]; f[1] = a[1]; f[2] = a[2]; f[3] = a[3]; f[4] = b[0]; f[5] = b[1]; f[6] = b[2]; f[7] = b[3]; }
__device__ __forceinline__ void phase_qkv_naive(const Params& p, const bf16_t* PROJ, const float* EX, float* QF, float* KF, float* VF, float* BG, bf16_t* YA, int wave, int lane) {
    const int gw = wave * gridDim.x + blockIdx.x, ngw = gridDim.x * NWAVES;
    const v4u zero4 = {0u, 0u, 0u, 0u};
    for (int tok = gw; tok < NTOK; tok += ngw) {
        const int pos = tok < NCTX ? (tok & 255) : ((tok - NCTX) & 63); const int L = tok < NCTX ? 256 : 64;
        const bool hasL = pos != 0, hasR = pos != L - 1;
#pragma unroll 1
        for (int grp = 0; grp < 6; ++grp) {
            const int part = grp >> 1, ch0 = (grp & 1) * 512 + lane * 8;
            const bf16_t* src = PROJ + (size_t)(3 + part) * BLK + (size_t)tok * DM + ch0;
            float c[8], l[8], r[8], w0[8], w1[8], w2[8], y[8];
            unpack8(*(const v4u*)src, c); unpack8(hasL ? *(const v4u*)(src - DM) : zero4, l); unpack8(hasR ? *(const v4u*)(src + DM) : zero4, r);
            const float* cw = p.dn_conv_w + part * 1024 + ch0;
            load8f(cw, w0); load8f(cw + 3072, w1); load8f(cw + 6144, w2);
            float ss = 0.f;
#pragma unroll
            for (int e = 0; e < 8; ++e) { y[e] = siluf(w0[e] * l[e] + w1[e] * c[e] + w2[e] * r[e]); ss += y[e] * y[e]; }
            if (part < 2) { const float sc = rsqrtf(sum16(ss) + 1e-6f) * (part == 0 ? 0.08838834764831845f : 1.0f);
#pragma unroll
                for (int e = 0; e < 8; ++e) y[e] *= sc; }
            float* dst = (part == 0 ? QF : part == 1 ? KF : VF) + (size_t)tok * DM + ch0;
            f32x4 o0 = {y[0], y[1], y[2], y[3]}, o1 = {y[4], y[5], y[6], y[7]};
            *(f32x4*)dst = o0; *(f32x4*)(dst + 4) = o1;
        }
#pragma unroll 1
        for (int grp = 0; grp < 2; ++grp) {
            const int ch0 = grp * 512 + lane * 8; const size_t o = (size_t)tok * DM + ch0;
            float bg[8], cc[8], cl[8], cr[8], xc[8], xl[8], xr[8], w0[8], w1[8], w2[8];
            unpack8(*(const v4u*)(PROJ + o), bg);
            unpack8(*(const v4u*)(PROJ + BLK + o), cc); unpack8(hasL ? *(const v4u*)(PROJ + BLK + o - DM) : zero4, cl); unpack8(hasR ? *(const v4u*)(PROJ + BLK + o + DM) : zero4, cr);
            unpack8(*(const v4u*)(PROJ + 2 * BLK + o), xc); unpack8(hasL ? *(const v4u*)(PROJ + 2 * BLK + o - DM) : zero4, xl); unpack8(hasR ? *(const v4u*)(PROJ + 2 * BLK + o + DM) : zero4, xr);
            load8f(p.conv_w + ch0, w0); load8f(p.conv_w + 1024 + ch0, w1); load8f(p.conv_w + 2048 + ch0, w2);
            float y[8];
#pragma unroll
            for (int e = 0; e < 8; ++e) y[e] = bg[e] * (w0[e] * cl[e] * xl[e] + w1[e] * cc[e] * xc[e] + w2[e] * cr[e] * xr[e]);
            v4u ov; ov.x = pk2bf(y[0], y[1]); ov.y = pk2bf(y[2], y[3]); ov.z = pk2bf(y[4], y[5]); ov.w = pk2bf(y[6], y[7]);
            *(v4u*)(YA + o) = ov;
        }
        if (lane < 16) {
            const float b_raw = EX[(size_t)tok * 32 + lane], a_raw = EX[(size_t)tok * 32 + 16 + lane];
            const float xx = a_raw + p.dn_dt_bias[lane]; const float sp = xx > 20.f ? xx : log1pf(expf(xx));
            BG[(size_t)tok * 32 + lane] = 1.f / (1.f + expf(-b_raw));
            BG[(size_t)tok * 32 + 16 + lane] = -expf(p.dn_a_log[lane]) * sp;
        }
    }
}

__device__ __forceinline__ void dn_naive_item(const Params& p, const float* QF, const float* KF, const float* VF, const float* BG, float* OF, float* OBk, float* lds, int item) {
    const bool lat = item < 32; const int j = lat ? item : item - 32; const int b = j >> 4, h = (j >> 1) & 7, dir = j & 1;
    const int T = lat ? 1024 : 256; const int tok0 = lat ? NCTX + b * 1024 : b * 256;
    const int tid = threadIdx.x, v = tid & 127, kq = tid >> 7;
    float* qs = lds; float* ks = lds + 128; float* vs = lds + 256; float* gb = lds + 384; float* red = lds + 512; float* red2 = lds + 1024;
    float S[32];
    if (lat) { const float* s0 = (dir ? p.st_b : p.st_f) + ((size_t)(b * 8 + h) * 128) * 128;
#pragma unroll
        for (int i = 0; i < 32; ++i) S[i] = s0[(size_t)(kq * 32 + i) * 128 + v]; }
    else {
#pragma unroll
        for (int i = 0; i < 32; ++i) S[i] = 0.f; }
    float* Od = dir ? OBk : OF;
    for (int t = 0; t < T; ++t) {
        const int tok = tok0 + (dir ? T - 1 - t : t);
        __syncthreads();
        if (tid < 128) qs[tid] = QF[(size_t)tok * DM + h * 128 + tid];
        else if (tid < 256) ks[tid - 128] = KF[(size_t)tok * DM + h * 128 + tid - 128];
        else if (tid < 384) vs[tid - 256] = VF[(size_t)tok * DM + h * 128 + tid - 256];
        else if (tid == 384) gb[0] = BG[(size_t)tok * 32 + dir * 8 + h];
        else if (tid == 385) gb[1] = BG[(size_t)tok * 32 + 16 + dir * 8 + h];
        __syncthreads();
        float part = 0.f;
#pragma unroll
        for (int i = 0; i < 32; ++i) part += ks[kq * 32 + i] * S[i];
        red[kq * 128 + v] = part;
        __syncthreads();
        const float kS = red[v] + red[128 + v] + red[256 + v] + red[384 + v];
        const float eg = expf(gb[1]), beta = gb[0];
        const float delta = beta * (vs[v] - eg * kS);
        float op = 0.f;
#pragma unroll
        for (int i = 0; i < 32; ++i) { S[i] = eg * S[i] + ks[kq * 32 + i] * delta; op += qs[kq * 32 + i] * S[i]; }
        red2[kq * 128 + v] = op;
        __syncthreads();
        if (kq == 0) Od[(size_t)tok * DM + h * 128 + v] = red2[v] + red2[128 + v] + red2[256 + v] + red2[384 + v];
    }
    if (!lat) { float* so = p.out + (size_t)NTOK * DM + (size_t)dir * (16 * 8 * 128 * 128) + ((size_t)(b * 8 + h) * 128) * 128;
#pragma unroll
        for (int i = 0; i < 32; ++i) so[(size_t)(kq * 32 + i) * 128 + v] = S[i]; }
}
__device__ __forceinline__ void phase_dn_naive(const Params& p, const float* QF, const float* KF, const float* VF, const float* BG, float* OF, float* OBk, float* lds) {
    const int bx = blockIdx.x;
    if (gridDim.x >= 256) {
        if (bx < 32) dn_naive_item(p, QF, KF, VF, BG, OF, OBk, lds, bx);
        else if (bx < 256) { dn_naive_item(p, QF, KF, VF, BG, OF, OBk, lds, bx); if (bx < 64) dn_naive_item(p, QF, KF, VF, BG, OF, OBk, lds, 224 + bx); }
    } else { for (int it = bx; it < 288; it += gridDim.x) dn_naive_item(p, QF, KF, VF, BG, OF, OBk, lds, it); }
}

typedef short bf16x8 __attribute__((ext_vector_type(8)));
typedef float f32x16 __attribute__((ext_vector_type(16)));
#define MFMA32(a, b, c) __builtin_amdgcn_mfma_f32_32x32x16_bf16((a), (b), (c), 0, 0, 0)
constexpr int DN_ITEM_BYTES = 73728, DN_W = 0, DN_QD = 16384, DN_KD = 32768, DN_A = 49152, DN_U = 57344;
constexpr int LS = 132;
constexpr int L_QF = 0, L_KF = 33792, L_VF = 67584, L_LM = 101376, L_CO = 134144;
__device__ __forceinline__ int crow16(int i, int hh) { return (i & 3) + 8 * (i >> 2) + 4 * hh; }
__device__ __forceinline__ bf16x8 frag_from_f32(const float* p) { const f32x4 a = *(const f32x4*)p, b = *(const f32x4*)(p + 4);
    v4u r; r.x = pk2bf(a[0], a[1]); r.y = pk2bf(a[2], a[3]); r.z = pk2bf(b[0], b[1]); r.w = pk2bf(b[2], b[3]); return __builtin_bit_cast(bf16x8, r); }
template <int S> __device__ __forceinline__ bf16x8 pack_step(const f32x16& x) {
    v4u r; r.x = pk2bf(x[8 * S + 0], x[8 * S + 1]); r.y = pk2bf(x[8 * S + 2], x[8 * S + 3]); r.z = pk2bf(x[8 * S + 4], x[8 * S + 5]); r.w = pk2bf(x[8 * S + 6], x[8 * S + 7]); return __builtin_bit_cast(bf16x8, r); }

__device__ __forceinline__ void dn_pre_item(const Params& p, const bf16_t* PROJ, const float* EX, unsigned char* DN, float* GL, unsigned char* lds, int sc, int h) {
    int tid_l = threadIdx.x; asm volatile("" : "+v"(tid_l));
    const int tid = tid_l, lane = tid & 63, wave = tid >> 6;
    const bool ctx = sc < 64; const int nn = ctx ? (sc & 3) : ((sc - 64) & 15);
    const int tok0 = ctx ? (sc >> 2) * 256 + 64 * nn : NCTX + ((sc - 64) >> 4) * 1024 + 64 * nn;
    float* QFl = (float*)(lds + L_QF); float* KFl = (float*)(lds + L_KF); float* VFl = (float*)(lds + L_VF); float* LM = (float*)(lds + L_LM);
    float* CB = (float*)(lds + L_CO);
    float* CG = CB + 128;
    float* CW = CB + 256;
    float* CE = CB + 384;
    float* CK = CB + 512;
    const v4u zero4 = {0u, 0u, 0u, 0u};
#pragma unroll 2
    for (int jj = 0; jj < 6; ++jj) {
        const int pr = tid + 512 * jj, c = pr / 48, cg = pr % 48, part = cg >> 4, d0 = (cg & 15) * 8;
        const bool hasL = c > 0 || (ctx && nn > 0), hasR = c < 63 || (ctx && nn < 3);
        const bf16_t* src = PROJ + (size_t)(3 + part) * BLK + (size_t)(tok0 + c) * DM + h * 128 + d0;
        float cc[8], l[8], r[8], w0[8], w1[8], w2[8], y[8];
        unpack8(*(const v4u*)src, cc); unpack8(hasL ? *(const v4u*)(src - DM) : zero4, l); unpack8(hasR ? *(const v4u*)(src + DM) : zero4, r);
        const float* cw = p.dn_conv_w + part * 1024 + h * 128 + d0;
        load8f(cw, w0); load8f(cw + 3072, w1); load8f(cw + 6144, w2);
        float ss = 0.f;
#pragma unroll
        for (int e = 0; e < 8; ++e) { y[e] = siluf(w0[e] * l[e] + w1[e] * cc[e] + w2[e] * r[e]); ss += y[e] * y[e]; }
        const float tot = sum16(ss);
        if (part < 2) { const float scl = rsqrtf(tot + 1e-6f) * (part == 0 ? 0.08838834764831845f : 1.0f);
#pragma unroll
            for (int e = 0; e < 8; ++e) y[e] *= scl; }
        float* dst = (part == 0 ? QFl : part == 1 ? KFl : VFl) + c * LS + d0;
        f32x4 o0 = {y[0], y[1], y[2], y[3]}, o1 = {y[4], y[5], y[6], y[7]};
        *(f32x4*)dst = o0; *(f32x4*)(dst + 4) = o1;
    }
    if (wave < 2) {
        const int d = wave, oc = d ? 63 - lane : lane; const size_t tk = (size_t)(tok0 + oc) * 32;
        const float b_raw = EX[tk + d * 8 + h], a_raw = EX[tk + 16 + d * 8 + h];
        const float xx = a_raw + p.dn_dt_bias[d * 8 + h]; const float sp = xx > 20.f ? xx : log1pf(expf(xx));
        const float beta = 1.f / (1.f + expf(-b_raw)); float g = -expf(p.dn_a_log[d * 8 + h]) * sp;
#pragma unroll
        for (int o = 1; o < 64; o <<= 1) { const float t = __shfl_up(g, o); if (lane >= o) g += t; }
        const float glast = __shfl(g, 63); const float eg = expf(g);
        CB[d * 64 + lane] = beta; CG[d * 64 + lane] = g; CW[d * 64 + lane] = beta * eg; CE[d * 64 + lane] = eg; CK[d * 64 + lane] = expf(glast - g);
        if (lane == 0) GL[(sc * 8 + h) * 2 + d] = expf(glast);
    }
    __syncthreads();
    const int dir = wave >> 2;
    unsigned char* item = DN + (size_t)((sc * 8 + h) * 2 + dir) * DN_ITEM_BYTES;
    {
        const int w4 = wave & 3, mt = w4 >> 1, nt = w4 & 1, r = lane & 31, hh = lane >> 5;
        const int ia = 32 * mt + r, ib = 32 * nt + r; const int ca = dir ? 63 - ia : ia, cb = dir ? 63 - ib : ib;
        f32x16 kk, pp;
#pragma unroll
        for (int i = 0; i < 16; ++i) { kk[i] = 0.f; pp[i] = 0.f; }
#pragma unroll
        for (int ks = 0; ks < 8; ++ks) {
            const bf16x8 ka = frag_from_f32(KFl + ca * LS + 16 * ks + 8 * hh), kb = frag_from_f32(KFl + cb * LS + 16 * ks + 8 * hh), qb = frag_from_f32(QFl + cb * LS + 16 * ks + 8 * hh);
            kk = MFMA32(ka, kb, kk); pp = MFMA32(ka, qb, pp);
        }
        const float* gcd = CG + dir * 64; const float* btd = CB + dir * 64;
        const float g_col = gcd[ib];
        f32x16 pv;
#pragma unroll
        for (int i = 0; i < 16; ++i) {
            const int row = 32 * mt + crow16(i, hh); const float g_row = gcd[row];
            LM[dir * 4096 + row * 64 + ib] = (ib < row) ? btd[row] * kk[i] * expf(g_row - g_col) : 0.f;
            pv[i] = (row <= ib) ? pp[i] * expf(g_col - g_row) : 0.f;
        }
        v4u* af = (v4u*)(item + DN_A);
        af[(nt * 4 + mt * 2 + 0) * 64 + lane] = __builtin_bit_cast(v4u, pack_step<0>(pv));
        af[(nt * 4 + mt * 2 + 1) * 64 + lane] = __builtin_bit_cast(v4u, pack_step<1>(pv));
    }
    __syncthreads();
    const int col = tid & 255, cc = col & 127; const bool isw = col >= 128;
    float x[64];
    {
        const float* srcm = isw ? KFl : VFl; const float* coef = (isw ? CW : CB) + dir * 64; const float* Lm = LM + dir * 4096;
#pragma unroll
        for (int c = 0; c < 64; ++c) {
            const int oc = dir ? 63 - c : c;
            float acc = srcm[oc * LS + cc] * coef[c];
#pragma unroll
            for (int s = 0; s < c; ++s) acc -= Lm[c * 64 + s] * x[s];
            x[c] = acc;
        }
        if (!isw) {
            const int jj = cc >> 5, n = cc & 31;
#pragma unroll
            for (int mt = 0; mt < 2; ++mt)
#pragma unroll
                for (int hh = 0; hh < 2; ++hh) {
                    v4u lo, hi;
                    lo.x = pk2bf(x[32 * mt + 4 * hh + 0], x[32 * mt + 4 * hh + 1]); lo.y = pk2bf(x[32 * mt + 4 * hh + 2], x[32 * mt + 4 * hh + 3]);
                    lo.z = pk2bf(x[32 * mt + 4 * hh + 8], x[32 * mt + 4 * hh + 9]); lo.w = pk2bf(x[32 * mt + 4 * hh + 10], x[32 * mt + 4 * hh + 11]);
                    hi.x = pk2bf(x[32 * mt + 4 * hh + 16], x[32 * mt + 4 * hh + 17]); hi.y = pk2bf(x[32 * mt + 4 * hh + 18], x[32 * mt + 4 * hh + 19]);
                    hi.z = pk2bf(x[32 * mt + 4 * hh + 24], x[32 * mt + 4 * hh + 25]); hi.w = pk2bf(x[32 * mt + 4 * hh + 26], x[32 * mt + 4 * hh + 27]);
                    v4u* dst = (v4u*)(item + DN_U + (size_t)(((jj * 2 + mt) * 64 + hh * 32 + n) * 32));
                    dst[0] = lo; dst[1] = hi;
                }
        }
    }
    __syncthreads();
    bf16_t* WL = (bf16_t*)(lds + L_VF);
    if (isw) {
#pragma unroll
        for (int c = 0; c < 64; ++c) WL[(dir * 64 + c) * LS + cc] = (bf16_t)(pk2bf(x[c], 0.f) & 0xffffu);
    }
    __syncthreads();
    {
        const int t = tid & 255; const float* ce = CE + dir * 64; const float* ck = CK + dir * 64;
#pragma unroll 1
        for (int q = 0; q < 4; ++q) {
            const int fl = t + 256 * q, f = fl >> 6, ln = fl & 63, r = ln & 31, hh = ln >> 5;
            {
                const int mt = f >> 3, ks8 = f & 7, cp = 32 * mt + r, oc = dir ? 63 - cp : cp, dkb = 16 * ks8 + 4 * hh;
                const u32x2 lo = *(const u32x2*)(WL + (dir * 64 + cp) * LS + dkb), hi = *(const u32x2*)(WL + (dir * 64 + cp) * LS + dkb + 8);
                v4u wv; wv.x = lo.x; wv.y = lo.y; wv.z = hi.x; wv.w = hi.y;
                ((v4u*)(item + DN_W))[f * 64 + ln] = wv;
                const f32x4 qa = *(const f32x4*)(QFl + oc * LS + dkb), qb = *(const f32x4*)(QFl + oc * LS + dkb + 8); const float e = ce[cp];
                v4u qv; qv.x = pk2bf(qa[0] * e, qa[1] * e); qv.y = pk2bf(qa[2] * e, qa[3] * e); qv.z = pk2bf(qb[0] * e, qb[1] * e); qv.w = pk2bf(qb[2] * e, qb[3] * e);
                ((v4u*)(item + DN_QD))[f * 64 + ln] = qv;
            }
            {
                const int mtK = f >> 2, kst = f & 3, dk = 32 * mtK + r, sb = 16 * kst + 4 * hh;
                float kv[8];
#pragma unroll
                for (int j = 0; j < 8; ++j) { const int sp = sb + (j & 3) + 8 * (j >> 2); const int os = dir ? 63 - sp : sp; kv[j] = KFl[os * LS + dk] * ck[sp]; }
                v4u kq; kq.x = pk2bf(kv[0], kv[1]); kq.y = pk2bf(kv[2], kv[3]); kq.z = pk2bf(kv[4], kv[5]); kq.w = pk2bf(kv[6], kv[7]);
                ((v4u*)(item + DN_KD))[f * 64 + ln] = kq;
            }
        }
    }
    __syncthreads();
}

__device__ __forceinline__ void phase_branch_a(const Params& p, const bf16_t* PROJ, bf16_t* YA, int wave, int lane) {
    const int gw = wave * gridDim.x + blockIdx.x, ngw = gridDim.x * NWAVES;
    const v4u zero4 = {0u, 0u, 0u, 0u};
    for (int tok = gw; tok < NTOK; tok += ngw) {
        const int pos = tok < NCTX ? (tok & 255) : ((tok - NCTX) & 63); const int L = tok < NCTX ? 256 : 64;
        const bool hasL = pos != 0, hasR = pos != L - 1;
#pragma unroll 1
        for (int grp = 0; grp < 2; ++grp) {
            const int ch0 = grp * 512 + lane * 8; const size_t o = (size_t)tok * DM + ch0;
            float bg[8], cc[8], cl[8], cr[8], xc[8], xl[8], xr[8], w0[8], w1[8], w2[8];
            unpack8(*(const v4u*)(PROJ + o), bg);
            unpack8(*(const v4u*)(PROJ + BLK + o), cc); unpack8(hasL ? *(const v4u*)(PROJ + BLK + o - DM) : zero4, cl); unpack8(hasR ? *(const v4u*)(PROJ + BLK + o + DM) : zero4, cr);
            unpack8(*(const v4u*)(PROJ + 2 * BLK + o), xc); unpack8(hasL ? *(const v4u*)(PROJ + 2 * BLK + o - DM) : zero4, xl); unpack8(hasR ? *(const v4u*)(PROJ + 2 * BLK + o + DM) : zero4, xr);
            load8f(p.conv_w + ch0, w0); load8f(p.conv_w + 1024 + ch0, w1); load8f(p.conv_w + 2048 + ch0, w2);
            float y[8];
#pragma unroll
            for (int e = 0; e < 8; ++e) y[e] = bg[e] * (w0[e] * cl[e] * xl[e] + w1[e] * cc[e] * xc[e] + w2[e] * cr[e] * xr[e]);
            v4u ov; ov.x = pk2bf(y[0], y[1]); ov.y = pk2bf(y[2], y[3]); ov.z = pk2bf(y[4], y[5]); ov.w = pk2bf(y[6], y[7]);
            *(v4u*)(YA + o) = ov;
        }
    }
}

__device__ __forceinline__ void dn_scan_item(const Params& p, const unsigned char* DN, const float* GL, float* OF, float* OBk, int it, int lane) {
    const bool lat = it < 128; const int q = lat ? it : it - 128;
    const int jj = q & 3, dir = (q >> 2) & 1, h = (q >> 3) & 7, b = q >> 6;
    const int nch = lat ? 16 : 4, scb = lat ? 64 + 16 * b : 4 * b, tokb = lat ? NCTX + b * 1024 : b * 256;
    const int n = lane & 31, hh = lane >> 5;
    f32x16 S[4];
    if (lat) { const float* s0 = (dir ? p.st_b : p.st_f) + (size_t)(b * 8 + h) * 16384 + 32 * jj + n;
#pragma unroll
        for (int m = 0; m < 4; ++m)
#pragma unroll
            for (int i = 0; i < 16; ++i) S[m][i] = s0[(size_t)(32 * m + crow16(i, hh)) * 128]; }
    else {
#pragma unroll
        for (int m = 0; m < 4; ++m)
#pragma unroll
            for (int i = 0; i < 16; ++i) S[m][i] = 0.f; }
    float* Od = (dir ? OBk : OF) + h * 128 + 32 * jj + n;
#pragma unroll 1
    for (int ci = 0; ci < nch; ++ci) {
        const int no = dir ? nch - 1 - ci : ci; const int id = ((scb + no) * 8 + h) * 2 + dir;
        const unsigned char* item = DN + (size_t)id * DN_ITEM_BYTES;
        const v4u* Wf = (const v4u*)(item + DN_W) + lane; const v4u* Qf = (const v4u*)(item + DN_QD) + lane; const v4u* Kf = (const v4u*)(item + DN_KD) + lane; const v4u* Af = (const v4u*)(item + DN_A) + lane;
        const float gl = GL[id];
        bf16x8 Sb[8];
        Sb[0] = pack_step<0>(S[0]); Sb[1] = pack_step<1>(S[0]); Sb[2] = pack_step<0>(S[1]); Sb[3] = pack_step<1>(S[1]);
        Sb[4] = pack_step<0>(S[2]); Sb[5] = pack_step<1>(S[2]); Sb[6] = pack_step<0>(S[3]); Sb[7] = pack_step<1>(S[3]);
        f32x16 vn[2], o[2];
#pragma unroll
        for (int mt = 0; mt < 2; ++mt) {
            f32x16 ws;
#pragma unroll
            for (int i = 0; i < 16; ++i) { ws[i] = 0.f; o[mt][i] = 0.f; }
#pragma unroll
            for (int ks = 0; ks < 8; ++ks) { ws = MFMA32(__builtin_bit_cast(bf16x8, Wf[(mt * 8 + ks) * 64]), Sb[ks], ws); o[mt] = MFMA32(__builtin_bit_cast(bf16x8, Qf[(mt * 8 + ks) * 64]), Sb[ks], o[mt]); }
            const v4u* up = (const v4u*)(item + DN_U + (size_t)(((jj * 2 + mt) * 64 + lane) * 32));
            const v4u u0 = up[0], u1 = up[1];
            vn[mt][0] = bflo(u0.x) - ws[0]; vn[mt][1] = bfhi(u0.x) - ws[1]; vn[mt][2] = bflo(u0.y) - ws[2]; vn[mt][3] = bfhi(u0.y) - ws[3];
            vn[mt][4] = bflo(u0.z) - ws[4]; vn[mt][5] = bfhi(u0.z) - ws[5]; vn[mt][6] = bflo(u0.w) - ws[6]; vn[mt][7] = bfhi(u0.w) - ws[7];
            vn[mt][8] = bflo(u1.x) - ws[8]; vn[mt][9] = bfhi(u1.x) - ws[9]; vn[mt][10] = bflo(u1.y) - ws[10]; vn[mt][11] = bfhi(u1.y) - ws[11];
            vn[mt][12] = bflo(u1.z) - ws[12]; vn[mt][13] = bfhi(u1.z) - ws[13]; vn[mt][14] = bflo(u1.w) - ws[14]; vn[mt][15] = bfhi(u1.w) - ws[15];
        }
        bf16x8 Vb[4];
        Vb[0] = pack_step<0>(vn[0]); Vb[1] = pack_step<1>(vn[0]); Vb[2] = pack_step<0>(vn[1]); Vb[3] = pack_step<1>(vn[1]);
#pragma unroll
        for (int mt = 0; mt < 2; ++mt)
#pragma unroll
            for (int kst = 0; kst < 4; ++kst) o[mt] = MFMA32(__builtin_bit_cast(bf16x8, Af[(mt * 4 + kst) * 64]), Vb[kst], o[mt]);
#pragma unroll
        for (int m = 0; m < 4; ++m) {
#pragma unroll
            for (int i = 0; i < 16; ++i) S[m][i] *= gl;
#pragma unroll
            for (int kst = 0; kst < 4; ++kst) S[m] = MFMA32(__builtin_bit_cast(bf16x8, Kf[(m * 4 + kst) * 64]), Vb[kst], S[m]);
        }
        const int tok0 = tokb + 64 * no;
#pragma unroll
        for (int mt = 0; mt < 2; ++mt)
#pragma unroll
            for (int i = 0; i < 16; ++i) { const int cp = 32 * mt + crow16(i, hh); const int oc = dir ? 63 - cp : cp; Od[(size_t)(tok0 + oc) * DM] = o[mt][i]; }
    }
    if (!lat) { float* so = p.out + (size_t)NTOK * DM + (size_t)dir * (16 * 8 * 128 * 128) + (size_t)(b * 8 + h) * 16384 + 32 * jj + n;
#pragma unroll
        for (int m = 0; m < 4; ++m)
#pragma unroll
            for (int i = 0; i < 16; ++i) so[(size_t)(32 * m + crow16(i, hh)) * 128] = S[m][i]; }
}

constexpr int SC_BUF = 57344;
__device__ __forceinline__ void dn_scan_group(const Params& p, const unsigned char* DN, const float* GL, float* OF, float* OBk, unsigned char* lds, int grp) {
    int tid_l = threadIdx.x; asm volatile("" : "+v"(tid_l));
    const int tid = tid_l, lane = tid & 63, wave = __builtin_amdgcn_readfirstlane(tid >> 6);
    const bool lat = grp < 32; const int q = lat ? grp : grp - 32;
    const int dir = q & 1, h = (q >> 1) & 7, b = q >> 4;
    const int nch = lat ? 16 : 4, scb = lat ? 64 + 16 * b : 4 * b, tokb = lat ? NCTX + b * 1024 : b * 256;
    if (wave >= 4) {
        const int lt = tid - 256;
        v4u r[14];
        {   const v4u* src = (const v4u*)(DN + (size_t)(((scb + (dir ? nch - 1 : 0)) * 8 + h) * 2 + dir) * DN_ITEM_BYTES) + lt;
#pragma unroll
            for (int k = 0; k < 14; ++k) r[k] = src[256 * k];
            v4u* dst = (v4u*)lds + lt;
#pragma unroll
            for (int k = 0; k < 14; ++k) dst[256 * k] = r[k]; }
        {   const v4u* src = (const v4u*)(DN + (size_t)(((scb + (dir ? nch - 2 : 1)) * 8 + h) * 2 + dir) * DN_ITEM_BYTES) + lt;
#pragma unroll
            for (int k = 0; k < 14; ++k) r[k] = src[256 * k]; }
        __syncthreads();
#pragma unroll 1
        for (int ci = 0; ci < nch; ++ci) {
            if (ci + 1 < nch) { v4u* dst = (v4u*)(lds + ((ci + 1) & 1) * SC_BUF) + lt;
#pragma unroll
                for (int k = 0; k < 14; ++k) dst[256 * k] = r[k]; }
            if (ci + 2 < nch) { const int no = dir ? nch - 3 - ci : ci + 2;
                const v4u* src = (const v4u*)(DN + (size_t)(((scb + no) * 8 + h) * 2 + dir) * DN_ITEM_BYTES) + lt;
#pragma unroll
                for (int k = 0; k < 14; ++k) r[k] = src[256 * k]; }
            __syncthreads();
        }
    } else {
        const int jj = wave, n = lane & 31, hh = lane >> 5;
        f32x16 S[4];
        if (lat) { const float* s0 = (dir ? p.st_b : p.st_f) + (size_t)(b * 8 + h) * 16384 + 32 * jj + n;
#pragma unroll
            for (int m = 0; m < 4; ++m)
#pragma unroll
                for (int i = 0; i < 16; ++i) S[m][i] = s0[(size_t)(32 * m + crow16(i, hh)) * 128]; }
        else {
#pragma unroll
            for (int m = 0; m < 4; ++m)
#pragma unroll
                for (int i = 0; i < 16; ++i) S[m][i] = 0.f; }
        float* Od = (dir ? OBk : OF) + h * 128 + 32 * jj + n;
        v4u un[4]; float gln;
        {   const int id0 = ((scb + (dir ? nch - 1 : 0)) * 8 + h) * 2 + dir; const unsigned char* it0 = DN + (size_t)id0 * DN_ITEM_BYTES + DN_U;
            const v4u* u0 = (const v4u*)(it0 + (size_t)(((jj * 2 + 0) * 64 + lane) * 32)); const v4u* u1 = (const v4u*)(it0 + (size_t)(((jj * 2 + 1) * 64 + lane) * 32));
            un[0] = u0[0]; un[1] = u0[1]; un[2] = u1[0]; un[3] = u1[1]; gln = GL[id0]; }
        __syncthreads();
#pragma unroll 1
        for (int ci = 0; ci < nch; ++ci) {
            const int no = dir ? nch - 1 - ci : ci;
            const float gl = gln;
            const unsigned char* buf = lds + (ci & 1) * SC_BUF;
            const v4u* Wf = (const v4u*)(buf + DN_W) + lane; const v4u* Qf = (const v4u*)(buf + DN_QD) + lane; const v4u* Kf = (const v4u*)(buf + DN_KD) + lane; const v4u* Af = (const v4u*)(buf + DN_A) + lane;
            f32x16 vn[2], o[2];
            {
                bf16x8 Sb[8];
                Sb[0] = pack_step<0>(S[0]); Sb[1] = pack_step<1>(S[0]); Sb[2] = pack_step<0>(S[1]); Sb[3] = pack_step<1>(S[1]);
                Sb[4] = pack_step<0>(S[2]); Sb[5] = pack_step<1>(S[2]); Sb[6] = pack_step<0>(S[3]); Sb[7] = pack_step<1>(S[3]);
#pragma unroll
                for (int mt = 0; mt < 2; ++mt) {
                    f32x16 ws;
#pragma unroll
                    for (int i = 0; i < 16; ++i) { ws[i] = 0.f; o[mt][i] = 0.f; }
#pragma unroll
                    for (int ks = 0; ks < 8; ++ks) { ws = MFMA32(__builtin_bit_cast(bf16x8, Wf[(mt * 8 + ks) * 64]), Sb[ks], ws); o[mt] = MFMA32(__builtin_bit_cast(bf16x8, Qf[(mt * 8 + ks) * 64]), Sb[ks], o[mt]); }
                    const v4u u0 = un[2 * mt], u1 = un[2 * mt + 1];
                    vn[mt][0] = bflo(u0.x) - ws[0]; vn[mt][1] = bfhi(u0.x) - ws[1]; vn[mt][2] = bflo(u0.y) - ws[2]; vn[mt][3] = bfhi(u0.y) - ws[3];
                    vn[mt][4] = bflo(u0.z) - ws[4]; vn[mt][5] = bfhi(u0.z) - ws[5]; vn[mt][6] = bflo(u0.w) - ws[6]; vn[mt][7] = bfhi(u0.w) - ws[7];
                    vn[mt][8] = bflo(u1.x) - ws[8]; vn[mt][9] = bfhi(u1.x) - ws[9]; vn[mt][10] = bflo(u1.y) - ws[10]; vn[mt][11] = bfhi(u1.y) - ws[11];
                    vn[mt][12] = bflo(u1.z) - ws[12]; vn[mt][13] = bfhi(u1.z) - ws[13]; vn[mt][14] = bflo(u1.w) - ws[14]; vn[mt][15] = bfhi(u1.w) - ws[15];
                    __builtin_amdgcn_sched_barrier(0);
                }
            }
            if (ci + 1 < nch) { const int no1 = dir ? nch - 2 - ci : ci + 1; const int id1 = ((scb + no1) * 8 + h) * 2 + dir; const unsigned char* it1 = DN + (size_t)id1 * DN_ITEM_BYTES + DN_U;
                const v4u* u0 = (const v4u*)(it1 + (size_t)(((jj * 2 + 0) * 64 + lane) * 32)); const v4u* u1 = (const v4u*)(it1 + (size_t)(((jj * 2 + 1) * 64 + lane) * 32));
                un[0] = u0[0]; un[1] = u0[1]; un[2] = u1[0]; un[3] = u1[1]; gln = GL[id1]; }
            bf16x8 Vb[4];
            Vb[0] = pack_step<0>(vn[0]); Vb[1] = pack_step<1>(vn[0]); Vb[2] = pack_step<0>(vn[1]); Vb[3] = pack_step<1>(vn[1]);
            __builtin_amdgcn_sched_barrier(0);
#pragma unroll
            for (int mt = 0; mt < 2; ++mt)
#pragma unroll
                for (int kst = 0; kst < 4; ++kst) o[mt] = MFMA32(__builtin_bit_cast(bf16x8, Af[(mt * 4 + kst) * 64]), Vb[kst], o[mt]);
            const int tok0 = tokb + 64 * no;
#pragma unroll
            for (int mt = 0; mt < 2; ++mt)
#pragma unroll
                for (int i = 0; i < 16; ++i) { const int cp = 32 * mt + crow16(i, hh); const int oc = dir ? 63 - cp : cp; Od[(size_t)(tok0 + oc) * DM] = o[mt][i]; }
            __builtin_amdgcn_sched_barrier(0);
#pragma unroll
            for (int m = 0; m < 4; ++m) {
#pragma unroll
                for (int i = 0; i < 16; ++i) S[m][i] *= gl;
#pragma unroll
                for (int kst = 0; kst < 4; ++kst) S[m] = MFMA32(__builtin_bit_cast(bf16x8, Kf[(m * 4 + kst) * 64]), Vb[kst], S[m]);
            }
            __builtin_amdgcn_sched_barrier(0);
            __syncthreads();
        }
        if (!lat) { float* so = p.out + (size_t)NTOK * DM + (size_t)dir * (16 * 8 * 128 * 128) + (size_t)(b * 8 + h) * 16384 + 32 * jj + n;
#pragma unroll
            for (int m = 0; m < 4; ++m)
#pragma unroll
                for (int i = 0; i < 16; ++i) so[(size_t)(32 * m + crow16(i, hh)) * 128] = S[m][i]; }
    }
}
__device__ __forceinline__ void phase_dn_scan(const Params& p, const unsigned char* DN, const float* GL, float* OF, float* OBk, unsigned char* lds) {
    const int bx = blockIdx.x;
    if (gridDim.x >= 256) {
        const int ng = (bx >= 32 && bx < 64) ? 2 : 1;
#pragma unroll 1
        for (int gi = 0; gi < ng; ++gi) dn_scan_group(p, DN, GL, OF, OBk, lds, gi ? 224 + bx : bx);
    } else { for (int g = bx; g < 288; g += gridDim.x) dn_scan_group(p, DN, GL, OF, OBk, lds, g); }
}

__device__ __forceinline__ void phase_ogate(const Params& p, const float* OF, const float* OBk, const bf16_t* Z, bf16_t* OG, int wave, int lane) {
    const int gw = wave * gridDim.x + blockIdx.x, ngw = gridDim.x * NWAVES;
    for (int tok = gw; tok < NTOK; tok += ngw) {
#pragma unroll
        for (int hf = 0; hf < 2; ++hf) {
            const int ch0 = hf * 512 + lane * 8; const size_t o = (size_t)tok * DM + ch0;
            float a[8], b2[8], z[8], nw[8];
            load8f(OF + o, a); load8f(OBk + o, b2); unpack8(*(const v4u*)(Z + o), z); load8f(p.dn_norm_w + (ch0 & 127), nw);
            float ss = 0.f;
#pragma unroll
            for (int e = 0; e < 8; ++e) { a[e] += b2[e]; ss += a[e] * a[e]; }
            const float r = rsqrtf(sum16(ss) * (1.0f / 128.0f) + 1e-6f);
            float y[8];
#pragma unroll
            for (int e = 0; e < 8; ++e) y[e] = a[e] * r * nw[e] * siluf(z[e]);
            v4u ov; ov.x = pk2bf(y[0], y[1]); ov.y = pk2bf(y[2], y[3]); ov.z = pk2bf(y[4], y[5]); ov.w = pk2bf(y[6], y[7]);
            *(v4u*)(OG + o) = ov;
        }
    }
}

template <class Epi> __device__ __forceinline__ void run_gemm(PG8_LAS unsigned char* lds, const bf16_t* A, const bf16_t* Bt, int N, int K, const Epi& E, int nrep, int split = 1) {
    pg8::Gemm g; g.A = A; g.Bt = Bt; g.M = NTOK; g.N = N; g.K = K; g.klen = K / split; g.nsp = N / 256;
    pg8::StaticOrder S; S.init(NTOK, N * split, (int)gridDim.x, (int)blockIdx.x);
    pg8::gemm_phase<Epi, pg8::StaticOrder, false>(lds, g, S, E, nullptr);
    __syncthreads();
}

__global__ void __launch_bounds__(512) fwd_megakernel(Params p) {
    extern __shared__ __attribute__((aligned(16))) unsigned char shm[];
    cg::grid_group grid = cg::this_grid();
    PG8_LAS unsigned char* lds3 = (PG8_LAS unsigned char*)shm;
    const int wave = __builtin_amdgcn_readfirstlane(threadIdx.x >> 6), lane = threadIdx.x & 63;
    unsigned char* ws = p.ws;
    volatile XLAS unsigned* xst = (volatile XLAS unsigned*)(lds3 + (LDS_BYTES - 16));
    if (threadIdx.x == 0) { xst[0] = 0u; xst[1] = 0u; }
    __syncthreads();
    XcdBarrier xb = xcd_barrier_post((unsigned*)(ws + OFF_BAR), xst);
    float* X0 = (float*)(ws + OFF_X0); float* X1 = (float*)(ws + OFF_X1); float* MOD = (float*)(ws + OFF_MOD);
    bf16_t* PROJ = (bf16_t*)(ws + OFF_PROJ); float* EX = (float*)(ws + OFF_EX);
    bf16_t* AM = (bf16_t*)p.out;
    bf16_t* HB = (bf16_t*)(ws + OFF_PROJ);
    float* QF = (float*)(ws + OFF_DN); float* KF = QF + BLK; float* VF = KF + BLK; float* BG = VF + BLK;
    float* OF = (float*)(ws + OFF_PROJ); float* OBk = OF + BLK;
    float* PART = (float*)(ws + 66 * MiB);
    float* T1 = (float*)(PROJ + 4 * BLK);
    float* GLp = (float*)(ws + OFF_EX + 786432);
    bf16_t* OG = (bf16_t*)p.out + BLK; bf16_t* MRG = AM;

#pragma unroll 1
    for (int rep = 0; rep < p.rep_prep; ++rep) { phase_prep(p, shm, wave, lane); __syncthreads(); }
    xcd_barrier(xb);
#pragma unroll 1
    for (int rep = 0; rep < p.rep_thin; ++rep) phase_norm<1>(p, nullptr, X0, p.norm_ffn1, 0, AM, wave, lane);
    xcd_barrier(xb);
    { pg8::EpiSwiglu E; E.H = HB; run_gemm(lds3, AM, (const bf16_t*)(ws + OFF_WGU), 5632, 1024, E, p.rep_gemm); }
    side_transposes(p, shm, wave, lane, 0, 16);
    xcd_barrier(xb);
    { pg8::EpiPartial E; E.P = PART; run_gemm(lds3, HB, (const bf16_t*)(ws + OFF_WD), 1024, FFH, E, p.rep_gemm, 2); }
    side_transposes(p, shm, wave, lane, 1, 192);
    xcd_barrier(xb);
#pragma unroll 1
    for (int rep = 0; rep < p.rep_thin; ++rep) phase_norm<2>(p, X0, X1, p.norm_mix, 3, AM, wave, lane, PART, 2, 0.5f);
    xcd_barrier(xb);
    { pg8::EpiProj E; E.P = PROJ; E.EX = EX; run_gemm(lds3, AM, (const bf16_t*)(ws + OFF_WIN), 9472, 1024, E, p.rep_gemm); }
    xcd_barrier(xb);
#pragma unroll 1
    for (int rep = 0; rep < p.rep_dnpre; ++rep) for (int it = blockIdx.x; it < 768; it += gridDim.x) dn_pre_item(p, PROJ, EX, ws + OFF_DN, GLp, shm, it >> 3, it & 7);
#pragma unroll 1
    for (int rep = 0; rep < p.rep_thin; ++rep) phase_branch_a(p, PROJ, AM, wave, lane);
    xcd_barrier(xb);
#pragma unroll 1
    for (int rep = 0; rep < p.rep_scan; ++rep) phase_dn_scan(p, ws + OFF_DN, GLp, OF, OBk, shm);
    {
        pg8::EpiGate<0> E; E.G = PROJ + 7 * BLK; E.T = T1; E.O = nullptr;
        pg8::Gemm g; g.A = AM; g.Bt = (const bf16_t*)(ws + OFF_WCO); g.M = NTOK; g.N = 1024; g.K = 1024; g.klen = 1024; g.nsp = 4;
        const bool sub = gridDim.x >= 256;
        const int G = sub ? 96 : (int)gridDim.x, c = sub ? (int)blockIdx.x - 64 : (int)blockIdx.x;
        if (c >= 0 && c < G) { pg8::StaticOrder S; S.init(NTOK, 1024, G, c); pg8::gemm_phase<pg8::EpiGate<0>, pg8::StaticOrder, false>(lds3, g, S, E, nullptr); }
        __syncthreads();
    }
    xcd_barrier(xb);
#pragma unroll 1
    for (int rep = 0; rep < p.rep_thin; ++rep) phase_ogate(p, OF, OBk, PROJ + 6 * BLK, OG, wave, lane);
    xcd_barrier(xb);
    { pg8::EpiGate<1> E; E.G = PROJ + 8 * BLK; E.T = T1; E.O = MRG; run_gemm(lds3, OG, (const bf16_t*)(ws + OFF_WDNO), 1024, 1024, E, p.rep_gemm); }
    side_transposes(p, shm, wave, lane, 2, 96);
    xcd_barrier(xb);
    { pg8::EpiPartial E; E.P = PART; run_gemm(lds3, MRG, (const bf16_t*)(ws + OFF_WO), 1024, 1024, E, p.rep_gemm, 2); }
    xcd_barrier(xb);
#pragma unroll 1
    for (int rep = 0; rep < p.rep_thin; ++rep) phase_norm<2>(p, X1, X0, p.norm_ffn2, 6, AM, wave, lane, PART, 5, 1.0f);
    xcd_barrier(xb);
    { pg8::EpiSwiglu E; E.H = HB; run_gemm(lds3, AM, (const bf16_t*)(ws + OFF_WGU), 5632, 1024, E, p.rep_gemm); }
    xcd_barrier(xb);
    { pg8::EpiPartial E; E.P = PART; run_gemm(lds3, HB, (const bf16_t*)(ws + OFF_WD), 1024, FFH, E, p.rep_gemm, 2); }
    xcd_barrier(xb);
#pragma unroll 1
    for (int rep = 0; rep < p.rep_sync; ++rep) grid.sync();
    phase_final_norm(p, X0, PART, p.out, wave, lane);
}

extern "C" void kernel_launch(void* const* d_in, const int* in_sizes, int n_in, void* d_out, int out_size, void* d_ws, size_t ws_size, hipStream_t stream) {
    static int grid_blocks = 0;
    if (grid_blocks == 0) {
        if (n_in != 27 || ws_size < WS_NEED) { fprintf(stderr, "kernel_launch: unexpected n_in %d / ws %zu\n", n_in, ws_size); grid_blocks = -1; return; }
        int dev = 0, cus = 0, per_cu = 0;
        hipGetDevice(&dev); hipDeviceGetAttribute(&cus, hipDeviceAttributeMultiprocessorCount, dev);
        hipFuncSetAttribute((const void*)fwd_megakernel, hipFuncAttributeMaxDynamicSharedMemorySize, LDS_BYTES);
        hipOccupancyMaxActiveBlocksPerMultiprocessor(&per_cu, (const void*)fwd_megakernel, 512, LDS_BYTES);
        if (per_cu < 1) { fprintf(stderr, "kernel_launch: occupancy query says %d blocks/CU\n", per_cu); per_cu = 1; }
        (void)hipGetLastError();
        grid_blocks = cus;
    }
    if (grid_blocks < 0) return;
    Params p{};
    const float** f = (const float**)&p;
    for (int i = 0; i < 27; ++i) f[i] = (const float*)d_in[i];
    p.out = (float*)d_out; p.ws = (unsigned char*)d_ws; p.rep_prep = REP_PREP; p.rep_gemm = REP_GEMM; p.rep_dnpre = REP_DNPRE; p.rep_scan = REP_SCAN; p.rep_thin = REP_THIN; p.rep_sync = REP_SYNC;
    (void)hipMemsetAsync((unsigned char*)d_ws + OFF_BAR, 0, XCD_BAR_WORDS * sizeof(unsigned), stream);
    void* args[] = {&p};
    hipError_t e = hipLaunchCooperativeKernel((const void*)fwd_megakernel, dim3(grid_blocks), dim3(512), args, LDS_BYTES, stream);
    if (e != hipSuccess) fprintf(stderr, "cooperative launch failed: %s (grid %d)\n", hipGetErrorString(e), grid_blocks);
}
```

```cpp
#include <hip/hip_runtime.h>
#include <hip/hip_cooperative_groups.h>
#include <cstdio>
#include <cstdint>
namespace cg = cooperative_groups;
#define REP_PREP 1
#define REP_GEMM 1
#define REP_DNPRE 1
#define REP_SCAN 1
#define REP_THIN 1
#define REP_SYNC 0
namespace pg8 {
#define PG8_LAS __attribute__((address_space(3)))
typedef unsigned short bf16_t;
typedef short bf16x8 __attribute__((ext_vector_type(8)));
typedef float f32x4 __attribute__((ext_vector_type(4)));
typedef unsigned u32x4 __attribute__((ext_vector_type(4)));
constexpr int BM = 256, BK = 64, HALF = 128, HTB = HALF * BK * 2  , STAGE_BYTES = 8 * HTB, NXCD = 8, WGM = 8;

__host__ __device__ __forceinline__ int lds_byte(int r, int c) { const int st = (r >> 4) * 2 + (c >> 5), rr = r & 15, cc = c & 31, ob = rr * 64 + cc * 2; return st * 1024 + (ob ^ (((ob >> 9) & 1) << 5)); }
__host__ __device__ __forceinline__ void stage_rc(int b, int& R, int& C) { const int st = b / 1024, sb = b % 1024, swz = sb ^ (((sb >> 9) & 1) << 5); R = (st >> 1) * 16 + swz / 64; C = (st & 1) * 32 + (swz % 64) / 2; }
__host__ __device__ __forceinline__ int perm32(int rho) { const int n = rho >> 4, i = rho & 15; return 8 * (i >> 2) + 4 * n + (i & 3); }

struct Unit { int pm, pn; };
struct Gemm { const bf16_t* A; const bf16_t* Bt; int M, N, K; int klen, nsp; };

struct StaticOrder {
    int nM, nN, nwg, G, c;
    __host__ __device__ void init(int M, int N, int G_, int c_) { nM = M / BM; nN = N / BM; nwg = nM * nN; G = G_; c = c_; }
    __host__ __device__ bool next(int i, Unit& u) const {
        const long L = (long)i * G + c; if (L >= nwg) return false;
        int wgid = (int)L; { const int q = nwg / NXCD, r = nwg % NXCD, xcd = wgid % NXCD, off = wgid / NXCD; wgid = (xcd < r ? xcd * (q + 1) : r * (q + 1) + (xcd - r) * q) + off; }
        const int nig = WGM * nN, gid = wgid / nig, fm = gid * WGM, gsz = (nM - fm) < WGM ? (nM - fm) : WGM;
        u.pm = fm + ((wgid % nig) % gsz); u.pn = (wgid % nig) / gsz; return true;
    }
    __device__ __forceinline__ void a_ready(const Unit&) const {}
    __device__ __forceinline__ void done(const Unit&) const {}
};
__device__ __forceinline__ unsigned pk2bf(float a, float b) { typedef float f2v __attribute__((ext_vector_type(2))); typedef __bf16 b2v __attribute__((ext_vector_type(2))); f2v v = {a, b}; b2v r = __builtin_convertvector(v, b2v); return __builtin_bit_cast(unsigned, r); }
__device__ __forceinline__ float bflo(unsigned u) { return __uint_as_float(u << 16); }
__device__ __forceinline__ float bfhi(unsigned u) { return __uint_as_float(u & 0xffff0000u); }
__device__ __forceinline__ float siluf(float x) { return x / (1.f + __expf(-x)); }
__device__ __forceinline__ float sigmf(float x) { return 1.f / (1.f + __expf(-x)); }
__device__ __forceinline__ int cond_of_tile(int pm) { return pm < 16 ? 0 : 1 + ((pm - 16) >> 2); }
constexpr int NTOK = 6144, DM = 1024, FFH = 2816, NMOD = 9216;
typedef unsigned u32x2 __attribute__((ext_vector_type(2)));

struct EpiSwiglu {
    static constexpr bool PERM = true, AFTER_DRAIN = false;
    bf16_t* H;
    __device__ __forceinline__ void operator()(const f32x4 (&acc)[2][2][4][2], const Unit& u, int wr, int wc, int fr, int fq) const {
        const int row0 = u.pm * BM + wr * 64 + fr, col0 = u.pn * 128 + wc * 32 + 8 * fq;
#pragma unroll
        for (int ai = 0; ai < 2; ++ai)
#pragma unroll
            for (int m = 0; m < 4; ++m) { bf16_t* rowp = H + (size_t)(row0 + ai * HALF + m * 16) * FFH + col0;
                const f32x4 g0 = acc[ai][0][m][0], u0 = acc[ai][1][m][0], g1 = acc[ai][0][m][1], u1 = acc[ai][1][m][1];
                u32x4 o; o.x = pk2bf(siluf(g0[0]) * u0[0], siluf(g0[1]) * u0[1]); o.y = pk2bf(siluf(g0[2]) * u0[2], siluf(g0[3]) * u0[3]);
                o.z = pk2bf(siluf(g1[0]) * u1[0], siluf(g1[1]) * u1[1]); o.w = pk2bf(siluf(g1[2]) * u1[2], siluf(g1[3]) * u1[3]);
                *(u32x4*)rowp = o; }
    }
};
struct EpiResid {
    static constexpr bool PERM = false, AFTER_DRAIN = false;
    const float* Xin; float* Xout; const float* gate; float scale;
    __device__ __forceinline__ void operator()(const f32x4 (&acc)[2][2][4][2], const Unit& u, int wr, int wc, int fr, int fq) const {
        const int row0 = u.pm * BM + wr * 64 + fr, col0 = u.pn * BM + wc * 32 + 4 * fq;
        const float* gp = gate + (size_t)cond_of_tile(u.pm) * NMOD + col0;
        f32x4 gv[2][2];
#pragma unroll
        for (int bj = 0; bj < 2; ++bj)
#pragma unroll
            for (int n = 0; n < 2; ++n) gv[bj][n] = *(const f32x4*)(gp + bj * HALF + n * 16) * scale;
#pragma unroll
        for (int ai = 0; ai < 2; ++ai)
#pragma unroll
            for (int m = 0; m < 4; ++m) { const size_t off = (size_t)(row0 + ai * HALF + m * 16) * DM + col0;
#pragma unroll
                for (int bj = 0; bj < 2; ++bj)
#pragma unroll
                    for (int n = 0; n < 2; ++n) { const f32x4 x = *(const f32x4*)(Xin + off + bj * HALF + n * 16);
                        *(f32x4*)(Xout + off + bj * HALF + n * 16) = x + gv[bj][n] * acc[ai][bj][m][n]; } }
    }
};
struct EpiProj {
    static constexpr bool PERM = true, AFTER_DRAIN = false;
    bf16_t* P; float* EX;
    __device__ __forceinline__ void operator()(const f32x4 (&acc)[2][2][4][2], const Unit& u, int wr, int wc, int fr, int fq) const {
        const int row0 = u.pm * BM + wr * 64 + fr;
        if (u.pn < 36) {
            bf16_t* base = P + (size_t)(u.pn >> 2) * NTOK * DM; const int col0 = (u.pn & 3) * 256 + wc * 32 + 8 * fq;
#pragma unroll
            for (int ai = 0; ai < 2; ++ai)
#pragma unroll
                for (int m = 0; m < 4; ++m) { bf16_t* rowp = base + (size_t)(row0 + ai * HALF + m * 16) * DM + col0;
#pragma unroll
                    for (int bj = 0; bj < 2; ++bj) { const f32x4 v0 = acc[ai][bj][m][0], v1 = acc[ai][bj][m][1];
                        u32x4 o; o.x = pk2bf(v0[0], v0[1]); o.y = pk2bf(v0[2], v0[3]); o.z = pk2bf(v1[0], v1[1]); o.w = pk2bf(v1[2], v1[3]); *(u32x4*)(rowp + bj * HALF) = o; } }
        } else if (wc == 0) {
#pragma unroll
            for (int ai = 0; ai < 2; ++ai)
#pragma unroll
                for (int m = 0; m < 4; ++m)
#pragma unroll
                    for (int n = 0; n < 2; ++n) *(f32x4*)(EX + (size_t)(row0 + ai * HALF + m * 16) * 32 + 8 * fq + 4 * n) = acc[ai][0][m][n];
        }
    }
};
struct EpiPartial {
    static constexpr bool PERM = false, AFTER_DRAIN = false;
    float* P;
    __device__ __forceinline__ void operator()(const f32x4 (&acc)[2][2][4][2], const Unit& u, int wr, int wc, int fr, int fq) const {
        const int kh = u.pn >> 2, pn = u.pn & 3;
        const int row0 = u.pm * BM + wr * 64 + fr, col0 = pn * BM + wc * 32 + 4 * fq;
        float* base = P + (size_t)kh * NTOK * DM;
#pragma unroll
        for (int ai = 0; ai < 2; ++ai)
#pragma unroll
            for (int m = 0; m < 4; ++m) { float* rowp = base + (size_t)(row0 + ai * HALF + m * 16) * DM + col0;
#pragma unroll
                for (int bj = 0; bj < 2; ++bj)
#pragma unroll
                    for (int n = 0; n < 2; ++n) *(f32x4*)(rowp + bj * HALF + n * 16) = acc[ai][bj][m][n]; }
    }
};
template <int SECOND> struct EpiGate {
    static constexpr bool PERM = false, AFTER_DRAIN = false;
    const bf16_t* G; float* T; bf16_t* O;
    __device__ __forceinline__ void operator()(const f32x4 (&acc)[2][2][4][2], const Unit& u, int wr, int wc, int fr, int fq) const {
        const int row0 = u.pm * BM + wr * 64 + fr, col0 = u.pn * BM + wc * 32 + 4 * fq;
#pragma unroll
        for (int ai = 0; ai < 2; ++ai)
#pragma unroll
            for (int m = 0; m < 4; ++m) { const size_t off = (size_t)(row0 + ai * HALF + m * 16) * DM + col0;
#pragma unroll
                for (int bj = 0; bj < 2; ++bj)
#pragma unroll
                    for (int n = 0; n < 2; ++n) { const size_t o = off + bj * HALF + n * 16; const u32x2 gr = *(const u32x2*)(G + o); const f32x4 a = acc[ai][bj][m][n];
                        f32x4 v; v[0] = sigmf(bflo(gr.x)) * a[0]; v[1] = sigmf(bfhi(gr.x)) * a[1]; v[2] = sigmf(bflo(gr.y)) * a[2]; v[3] = sigmf(bfhi(gr.y)) * a[3];
                        if (SECOND == 0) *(f32x4*)(T + o) = v;
                        else { const f32x4 t = *(const f32x4*)(T + o); v = v + t; u32x2 w; w.x = pk2bf(v[0], v[1]); w.y = pk2bf(v[2], v[3]); *(u32x2*)(O + o) = w; } } }
    }
};

template <class Epi, class Sched, bool STAMP = false>
__device__ __forceinline__ void gemm_phase(PG8_LAS unsigned char* lds, const Gemm g, const Sched& S, const Epi& E, unsigned long long* stamps) {
    int tid_l = threadIdx.x; asm volatile("" : "+v"(tid_l));
    const int tid = tid_l, wid = __builtin_amdgcn_readfirstlane(tid >> 6), lane = tid & 63, wr = wid >> 2, wc = wid & 3, fr = lane & 15, fq = lane >> 4;
    const int K = g.K, nt = g.klen / BK;
    int ts_lo = 0, ts_hi = 0, nts = 0; const unsigned long long rt_entry = STAMP ? (unsigned long long)wall_clock64() : 0ull;
#define PG8_STAMP() do { if (STAMP && wid == 0 && nts < 64) { const unsigned long long _c = (unsigned long long)clock64(); \
        ts_lo = (lane == nts) ? (int)(unsigned)_c : ts_lo; ts_hi = (lane == nts) ? (int)(unsigned)(_c >> 32) : ts_hi; ++nts; } } while (0)
    PG8_STAMP();
    unsigned voffA[2], voffB[2];
#pragma unroll
    for (int i = 0; i < 2; ++i) { int R, C; stage_rc(tid * 16 + i * 8192, R, C); const int Rb = Epi::PERM ? ((R & ~31) + perm32(R & 31)) : R;
        voffA[i] = (unsigned)(R * K + C) * 2u; voffB[i] = (unsigned)(Rb * K + C) * 2u; }
    const size_t kstep = (size_t)(BK * 2);
    const size_t hstep = (size_t)HALF * K * 2;
    const size_t tstep = 2 * hstep;
    const unsigned ldsw = (unsigned)wid * 1024u;
    const int aoff = lds_byte(wr * 64 + fr, fq * 8), boff = lds_byte(wc * 32 + fr, fq * 8);
#define PG8_SA(b, h) (((b) * 2 + (h)) * HTB)
#define PG8_SB(b, h) ((4 + (b) * 2 + (h)) * HTB)
#define PG8_STAGE(bufoff, gbase, voff) do { _Pragma("unroll") for (int _i = 0; _i < 2; ++_i) \
        __builtin_amdgcn_global_load_lds((const unsigned*)((const char*)(gbase) + (voff)[_i]), (PG8_LAS unsigned*)(lds + (bufoff) + ldsw + _i * 8192), 16, 0, 0); } while (0)
#define PG8_LDA(dst, b, h) do { _Pragma("unroll") for (int m = 0; m < 4; ++m) _Pragma("unroll") for (int k = 0; k < 2; ++k) dst[m][k] = *(const PG8_LAS bf16x8*)(lds + PG8_SA(b, h) + aoff + m * 2048 + k * 1024); } while (0)
#define PG8_LDB(dst, b, h) do { _Pragma("unroll") for (int n = 0; n < 2; ++n) _Pragma("unroll") for (int k = 0; k < 2; ++k) dst[n][k] = *(const PG8_LAS bf16x8*)(lds + PG8_SB(b, h) + boff + n * 2048 + k * 1024); } while (0)
#define PG8_MMA(ai, bj, At, Bt) do { __builtin_amdgcn_s_setprio(1); _Pragma("unroll") for (int m = 0; m < 4; ++m) _Pragma("unroll") for (int n = 0; n < 2; ++n) _Pragma("unroll") for (int k = 0; k < 2; ++k) \
        acc[ai][bj][m][n] = __builtin_amdgcn_mfma_f32_16x16x32_bf16(Bt[n][k], At[m][k], acc[ai][bj][m][n], 0, 0, 0); __builtin_amdgcn_s_setprio(0); } while (0)
#define PG8_WAIT_V(n) asm volatile("s_waitcnt vmcnt(" #n ")" ::: "memory")
#define PG8_WAIT_L(n) asm volatile("s_waitcnt lgkmcnt(" #n ")" ::: "memory")
#define PG8_BAR __builtin_amdgcn_s_barrier()
#define PG8_SCHED __builtin_amdgcn_sched_barrier(0)
    Unit cur, nxt; int ui = 0;
    if (!S.next(0, cur)) return;
    f32x4 acc[2][2][4][2];
#pragma unroll
    for (int a = 0; a < 2; ++a)
#pragma unroll
        for (int b = 0; b < 2; ++b)
#pragma unroll
            for (int m = 0; m < 4; ++m)
#pragma unroll
                for (int n = 0; n < 2; ++n) acc[a][b][m][n] = (f32x4){0.f, 0.f, 0.f, 0.f};
    bf16x8 At[4][2], B0[2][2], B1[2][2];
    const size_t khb = (size_t)g.klen * 2;
    const char* cA = (const char*)g.A + (size_t)cur.pm * tstep + (cur.pn >= g.nsp ? khb : 0); const char* cB = (const char*)g.Bt + (size_t)(cur.pn >= g.nsp ? cur.pn - g.nsp : cur.pn) * tstep + (cur.pn >= g.nsp ? khb : 0);
    S.a_ready(cur);
    PG8_STAGE(PG8_SB(0, 0), cB, voffB); PG8_STAGE(PG8_SA(0, 0), cA, voffA); PG8_STAGE(PG8_SB(0, 1), cB + hstep, voffB); PG8_STAGE(PG8_SA(0, 1), cA + hstep, voffA);
    if (wr == 1) PG8_BAR;
    PG8_WAIT_V(4); PG8_BAR;
    PG8_STAGE(PG8_SB(1, 0), cB + kstep, voffB); PG8_STAGE(PG8_SA(1, 0), cA + kstep, voffA); PG8_STAGE(PG8_SB(1, 1), cB + hstep + kstep, voffB);
    PG8_WAIT_V(6); PG8_BAR;
    PG8_STAMP();
    for (;;) {
        const bool has_next = S.next(ui + 1, nxt);
        const char* nA = has_next ? (const char*)g.A + (size_t)nxt.pm * tstep + (nxt.pn >= g.nsp ? khb : 0) : cA; const char* nB = has_next ? (const char*)g.Bt + (size_t)(nxt.pn >= g.nsp ? nxt.pn - g.nsp : nxt.pn) * tstep + (nxt.pn >= g.nsp ? khb : 0) : cB;
        for (int t = 0; t < nt; t += 2) {
            const bool last = (t == nt - 2);
            const char* a1 = cA + (size_t)(t + 1) * kstep;
            const char* a2 = last ? nA : cA + (size_t)(t + 2) * kstep; const char* b2 = last ? nB : cB + (size_t)(t + 2) * kstep;
            const char* a3 = a2 + kstep; const char* b3 = b2 + kstep;
            if (last && has_next) S.a_ready(nxt);
            PG8_LDB(B0, 0, 0); PG8_SCHED; PG8_LDA(At, 0, 0); PG8_STAGE(PG8_SA(1, 1), a1 + hstep, voffA);
            PG8_WAIT_L(8); PG8_BAR; PG8_WAIT_L(0); PG8_MMA(0, 0, At, B0); PG8_BAR; PG8_SCHED;
            PG8_LDB(B1, 0, 1); PG8_STAGE(PG8_SB(0, 0), b2, voffB);
            PG8_BAR; PG8_WAIT_L(0); PG8_MMA(0, 1, At, B1); PG8_BAR;
            PG8_LDA(At, 0, 1); PG8_STAGE(PG8_SA(0, 0), a2, voffA);
            PG8_BAR; PG8_WAIT_L(0); PG8_MMA(1, 0, At, B0); PG8_BAR; PG8_SCHED;
            PG8_STAGE(PG8_SB(0, 1), b2 + hstep, voffB);
            PG8_WAIT_V(6); PG8_BAR; PG8_MMA(1, 1, At, B1); PG8_BAR;
            PG8_LDB(B0, 1, 0); PG8_SCHED; PG8_LDA(At, 1, 0); PG8_STAGE(PG8_SA(0, 1), a2 + hstep, voffA);
            PG8_WAIT_L(8); PG8_BAR; PG8_WAIT_L(0); PG8_MMA(0, 0, At, B0); PG8_BAR; PG8_SCHED;
            PG8_LDB(B1, 1, 1); PG8_STAGE(PG8_SB(1, 0), b3, voffB);
            PG8_BAR; PG8_WAIT_L(0); PG8_MMA(0, 1, At, B1); PG8_BAR;
            PG8_LDA(At, 1, 1); PG8_STAGE(PG8_SA(1, 0), a3, voffA);
            PG8_BAR; PG8_WAIT_L(0); PG8_MMA(1, 0, At, B0); PG8_BAR; PG8_SCHED;
            PG8_STAGE(PG8_SB(1, 1), b3 + hstep, voffB);
            PG8_WAIT_V(6); PG8_BAR; PG8_MMA(1, 1, At, B1); PG8_BAR;
        }
        PG8_STAMP();
        if constexpr (!Epi::AFTER_DRAIN) { E(acc, cur, wr, wc, fr, fq); S.done(cur); }
        PG8_STAMP();
        if (!has_next) break;
#pragma unroll
        for (int a = 0; a < 2; ++a)
#pragma unroll
            for (int b = 0; b < 2; ++b)
#pragma unroll
                for (int m = 0; m < 4; ++m)
#pragma unroll
                    for (int n = 0; n < 2; ++n) acc[a][b][m][n] = (f32x4){0.f, 0.f, 0.f, 0.f};
        cur = nxt; cA = nA; cB = nB; ++ui;
    }
    PG8_WAIT_V(0);
    if (wr == 0) PG8_BAR;
    PG8_BAR;
    if constexpr (Epi::AFTER_DRAIN) { E.fused(acc, cur, wr, wc, fr, fq, lds, wid, lane); S.done(cur); }
    PG8_STAMP();
    if (STAMP && wid == 0) { stamps[lane] = lane < nts ? (((unsigned long long)(unsigned)ts_hi << 32) | (unsigned)ts_lo) : 0ull;
        if (lane == 62) stamps[62] = rt_entry; if (lane == 63) stamps[63] = (unsigned long long)wall_clock64(); }
#undef PG8_STAMP
#undef PG8_SA
#undef PG8_SB
#undef PG8_STAGE
#undef PG8_LDA
#undef PG8_LDB
#undef PG8_MMA
#undef PG8_WAIT_V
#undef PG8_WAIT_L
#undef PG8_BAR
#undef PG8_SCHED
}
}
#define XB_TMO      128
#define XB_XCNT(j)  (256  + 64 * (j))
#define XB_XSUB(j)  (1280 + 64 * (j))
#define XB_XGEN(j)  (2304 + 64 * (j))
#define XB_TOP      3328
#define XB_TOPGEN   3392
#define XCD_BAR_WORDS 3456
#define XB_SPIN_CAP (1u << 18)
#define XLAS __attribute__((address_space(3)))

__device__ __forceinline__ unsigned xb_ld(unsigned* p)              { return __hip_atomic_load(p, __ATOMIC_RELAXED, __HIP_MEMORY_SCOPE_AGENT); }
__device__ __forceinline__ unsigned xb_add(unsigned* p, unsigned v) { return __hip_atomic_fetch_add(p, v, __ATOMIC_RELAXED, __HIP_MEMORY_SCOPE_AGENT); }
__device__ __forceinline__ unsigned xb_xcc_id() { return (unsigned)__builtin_amdgcn_s_getreg((3 << 11) | 20) & 0xFu; }
#define XB_SPIN(cond, bar) do { unsigned _sp = 0; while (cond) { __builtin_amdgcn_s_sleep(1); \
    if ((++_sp & 255u) == 0u) { if (xb_ld(&(bar)[XB_TMO])) break; if (_sp > XB_SPIN_CAP) { atomicAdd(&(bar)[XB_TMO], 1u); break; } } } } while (0)

struct XcdBarrier {
    unsigned* bar; unsigned x;
    volatile XLAS unsigned* st;
};

__device__ __forceinline__ XcdBarrier xcd_barrier_post(unsigned* bar, volatile XLAS unsigned* st) {
    XcdBarrier b; b.bar = bar; b.x = xb_xcc_id(); b.st = st;
    if (threadIdx.x == 0) (void)xb_add(&bar[XB_XCNT(b.x)], 1u);
    return b;
}
__device__ __forceinline__ void xcd_barrier_complete(unsigned* bar, unsigned x, unsigned& nloc, unsigned& nx) {
    const unsigned G = gridDim.x * gridDim.y * gridDim.z;
    unsigned sum, cnt, mine, sp = 0u;
    for (;;) {
        sum = 0u; cnt = 0u; mine = 0u;
#pragma unroll
        for (unsigned j = 0; j < 16; ++j) { const unsigned c = xb_ld(&bar[XB_XCNT(j)]); sum += c; cnt += (c > 0u) ? 1u : 0u; mine = (j == x) ? c : mine; }
        if (sum == G) break;
        __builtin_amdgcn_s_sleep(1);
        if ((++sp & 255u) == 0u) { if (xb_ld(&bar[XB_TMO])) break; if (sp > XB_SPIN_CAP) { atomicAdd(&bar[XB_TMO], 1u); break; } }
    }
    nloc = mine > 0u ? mine : 1u; nx = cnt > 0u ? cnt : 1u;
}

__device__ __forceinline__ void xcd_barrier(const XcdBarrier& b) {
    asm volatile("s_waitcnt vmcnt(0)" ::: "memory");
    __syncthreads();
    if (threadIdx.x == 0) {
        unsigned* bar = b.bar;
        __builtin_amdgcn_s_waitcnt(0);
        unsigned nloc = b.st[0], nx = b.st[1];
        if (nloc == 0u) { xcd_barrier_complete(bar, b.x, nloc, nx); b.st[0] = nloc; b.st[1] = nx; }
        const unsigned old = xb_add(&bar[XB_XSUB(b.x)], 1u);
        const unsigned gen = old / nloc;
        if (old + 1u == (gen + 1u) * nloc) {
            __builtin_amdgcn_fence(__ATOMIC_RELEASE, "agent");
            asm volatile("s_waitcnt vmcnt(0)" ::: "memory");
            const unsigned og = xb_add(&bar[XB_TOP], 1u);
            const unsigned tg = og / nx;
            if (og + 1u == (tg + 1u) * nx) xb_add(&bar[XB_TOPGEN], 1u);
            else XB_SPIN(xb_ld(&bar[XB_TOPGEN]) == tg, bar);
            __builtin_amdgcn_fence(__ATOMIC_ACQUIRE, "agent");
            xb_add(&bar[XB_XGEN(b.x)], 1u);
            asm volatile("s_waitcnt vmcnt(0)" ::: "memory");
        } else {
            XB_SPIN(xb_ld(&bar[XB_XGEN(b.x)]) == gen, bar);
            __builtin_amdgcn_fence(__ATOMIC_ACQUIRE, "agent");
            asm volatile("s_waitcnt vmcnt(0)" ::: "memory");
        }
    }
    __syncthreads();
}


using pg8::bf16_t; using pg8::f32x4; using pg8::pk2bf; using pg8::bflo; using pg8::bfhi; using pg8::siluf; using pg8::sigmf; using pg8::u32x2;
using pg8::NTOK; using pg8::DM; using pg8::FFH; using pg8::NMOD;
typedef unsigned v4u __attribute__((ext_vector_type(4)));
#define LDS_WAIT() asm volatile("s_waitcnt lgkmcnt(0)" ::: "memory")
constexpr int NCTX = 4096, NWAVES = 8, LDS_BYTES = 143360;
constexpr size_t MiB = 1048576;
constexpr size_t OFF_WCO = 0, OFF_WDNO = 2 * MiB, OFF_WO = 4 * MiB;
constexpr size_t OFF_WGU = 6 * MiB;
constexpr size_t OFF_WD = 17 * MiB;
constexpr size_t OFF_WIN = 23 * MiB;
constexpr size_t OFF_X0 = 42 * MiB;
constexpr size_t OFF_DN = 6 * MiB;
constexpr size_t OFF_X1 = 114 * MiB;
constexpr size_t OFF_PROJ = 138 * MiB;
constexpr size_t OFF_EX = 246 * MiB;
constexpr size_t OFF_MOD = 247 * MiB;
constexpr size_t OFF_BAR = 247 * MiB + 512 * 1024;
constexpr size_t WS_NEED = 248 * MiB;
constexpr size_t BLK = (size_t)NTOK * DM;

struct Params {
    const float *x_prompt, *x_sample, *st_f, *st_b, *c, *c_ctx, *ada_w, *ada_b, *norm_ffn1, *f1g, *f1u, *f1d, *norm_mix, *w_in, *conv_w, *conv_out_w,
        *dn_conv_w, *dn_a_log, *dn_dt_bias, *dn_norm_w, *dn_out_w, *w_o, *norm_ffn2, *f2g, *f2u, *f2d, *norm_f;
    float* out; unsigned char* ws; int rep_prep, rep_gemm, rep_dnpre, rep_scan, rep_thin, rep_sync;
};

__device__ __forceinline__ float wave_sum(float v) {
#pragma unroll
    for (int o = 1; o < 64; o <<= 1) v += __shfl_xor(v, o);
    return v;
}
__device__ __forceinline__ float sum16(float v) {
#pragma unroll
    for (int o = 1; o < 16; o <<= 1) v += __shfl_xor(v, o);
    return v;
}
__device__ __forceinline__ void transpose_item(const float* W, int N, int k0, int n0, bf16_t* WT, int Kd, int dst_row0, float* scr, int lane) {
#pragma unroll 8
    for (int i = 0; i < 32; ++i) { const int kk = 2 * i + (lane >> 5); scr[kk * 33 + (lane & 31)] = W[(size_t)(k0 + kk) * N + n0 + (lane & 31)]; }
    LDS_WAIT();
    const int c = lane & 7;
#pragma unroll
    for (int j = 0; j < 4; ++j) { const int n = (lane >> 3) + 8 * j; const float* s = scr + (8 * c) * 33 + n;
        v4u o; o.x = pk2bf(s[0 * 33], s[1 * 33]); o.y = pk2bf(s[2 * 33], s[3 * 33]); o.z = pk2bf(s[4 * 33], s[5 * 33]); o.w = pk2bf(s[6 * 33], s[7 * 33]);
        *(v4u*)(WT + (size_t)(dst_row0 + n) * Kd + k0 + 8 * c) = o; }
    LDS_WAIT();
}
__device__ __forceinline__ void transpose_matrix(const float* W, int K, int N, bf16_t* WT, int mode, int gw, int ngw, float* scr, int lane) {
    const int nblk = N / 32, nitems = (K / 64) * nblk;
    for (int it = gw; it < nitems; it += ngw) {
        const int kb = it / nblk, nb = it % nblk, n0 = nb * 32;
        const int dr = mode == 0 ? n0 : ((n0 >> 7) * 256 + (n0 & 127) + (mode == 2 ? 128 : 0));
        transpose_item(W, N, kb * 64, n0, WT, K, dr, scr, lane);
    }
}

__device__ __forceinline__ void phase_prep(const Params& p, unsigned char* lds, int wave, int lane) {
    unsigned char* ws = p.ws;
    float* scr = (float*)lds + wave * (64 * 33);
    const int gw = wave * gridDim.x + blockIdx.x, ngw = gridDim.x * NWAVES;
    transpose_matrix(p.f1g, 1024, FFH, (bf16_t*)(ws + OFF_WGU), 1, gw, ngw, scr, lane);
    transpose_matrix(p.f1u, 1024, FFH, (bf16_t*)(ws + OFF_WGU), 2, gw, ngw, scr, lane);
    __syncthreads();
    float* sc = (float*)lds;
    float* red = (float*)lds + 3072;
    if ((int)blockIdx.x < 144) {
        for (int i = threadIdx.x; i < 3072; i += 512) { const int cc = i >> 10, k = i & 1023; const float v = cc == 0 ? p.c_ctx[k] : p.c[(cc - 1) * 1024 + k]; sc[i] = siluf(v); }
        __syncthreads();
        for (int it = blockIdx.x; it < 144; it += gridDim.x) {
            const int n = it * 64 + lane; float a0 = 0.f, a1 = 0.f, a2 = 0.f;
            const float* wp = p.ada_w + (size_t)(wave * 128) * NMOD + n;
#pragma unroll 8
            for (int k = 0; k < 128; ++k) { const float wv = wp[(size_t)k * NMOD]; const int kk = wave * 128 + k; a0 += sc[kk] * wv; a1 += sc[1024 + kk] * wv; a2 += sc[2048 + kk] * wv; }
            red[(wave * 3 + 0) * 64 + lane] = a0; red[(wave * 3 + 1) * 64 + lane] = a1; red[(wave * 3 + 2) * 64 + lane] = a2;
            __syncthreads();
            if (threadIdx.x < 192) { const int cc = threadIdx.x >> 6, l = threadIdx.x & 63; float s = 0.f;
#pragma unroll
                for (int w = 0; w < 8; ++w) s += red[(w * 3 + cc) * 64 + l];
                ((float*)(ws + OFF_MOD))[cc * NMOD + it * 64 + l] = s + p.ada_b[it * 64 + l]; }
            __syncthreads();
        }
    }
}


__device__ __forceinline__ void side_transposes(const Params& p, unsigned char* lds, int wave, int lane, int which, int b0) {
    if (gridDim.x < 256) b0 = 0;
    const int nb = (int)gridDim.x - b0, bi = (int)blockIdx.x - b0;
    if (bi < 0) return;
    unsigned char* ws = p.ws;
    float* scr = (float*)lds + wave * (64 * 33);
    const int gw = wave * nb + bi, ngw = nb * NWAVES;
    if (which == 0) {
        transpose_matrix(p.f1d, FFH, 1024, (bf16_t*)(ws + OFF_WD), 0, gw, ngw, scr, lane);
    } else if (which == 1) {
        transpose_matrix(p.w_in, 1024, 9248, (bf16_t*)(ws + OFF_WIN), 0, gw, ngw, scr, lane);
        transpose_matrix(p.conv_out_w, 1024, 1024, (bf16_t*)(ws + OFF_WCO), 0, gw, ngw, scr, lane);
        transpose_matrix(p.dn_out_w, 1024, 1024, (bf16_t*)(ws + OFF_WDNO), 0, gw, ngw, scr, lane);
        transpose_matrix(p.w_o, 1024, 1024, (bf16_t*)(ws + OFF_WO), 0, gw, ngw, scr, lane);
        v4u z = {0u, 0u, 0u, 0u}; v4u* zp = (v4u*)((bf16_t*)(ws + OFF_WIN) + (size_t)9248 * 1024);
        const int nz = 224 * 1024 * 2 / 16;
        for (int i = bi * 512 + (int)threadIdx.x; i < nz; i += nb * 512) zp[i] = z;
    } else {
        transpose_matrix(p.f2g, 1024, FFH, (bf16_t*)(ws + OFF_WGU), 1, gw, ngw, scr, lane);
        transpose_matrix(p.f2u, 1024, FFH, (bf16_t*)(ws + OFF_WGU), 2, gw, ngw, scr, lane);
        transpose_matrix(p.f2d, FFH, 1024, (bf16_t*)(ws + OFF_WD), 0, gw, ngw, scr, lane);
    }
    __syncthreads();
}

template <int FIRST> __device__ __forceinline__ void phase_norm(const Params& p, const float* X, float* X0, const float* nw, int modi, bf16_t* A, int wave, int lane, const float* PART = nullptr, int gatei = 0, float gscale = 0.f) {
    const float* mod = (const float*)(p.ws + OFF_MOD);
    const int gw = wave * gridDim.x + blockIdx.x, ngw = gridDim.x * NWAVES;
    for (int row = gw; row < NTOK; row += ngw) {
        const int cond = row < NCTX ? 0 : 1 + ((row - NCTX) >> 10);
        f32x4 v[4];
        if (FIRST == 1) {
            const float* src = row < NCTX ? p.x_prompt + (size_t)row * DM : p.x_sample + (size_t)(row - NCTX) * DM;
#pragma unroll
            for (int j = 0; j < 4; ++j) v[j] = *(const f32x4*)(src + 4 * lane + 256 * j);
            if (row >= NCTX) {
                const int t = (row - NCTX) & 1023; const float r = (float)(t >> 6), cl = (float)(t & 63);
#pragma unroll
                for (int e = 0; e < 4; ++e) { const int i = 4 * lane + e; const float om = 1.0f / powf(10000.0f, (float)i * (1.0f / 256.0f));
                    v[0][e] += sinf(r * om); v[1][e] += cosf(r * om); v[2][e] += sinf(cl * om); v[3][e] += cosf(cl * om); }
            }
#pragma unroll
            for (int j = 0; j < 4; ++j) *(f32x4*)(X0 + (size_t)row * DM + 4 * lane + 256 * j) = v[j];
        } else if (FIRST == 2) {
            const float* gp = mod + (size_t)cond * NMOD + gatei * 1024;
#pragma unroll
            for (int j = 0; j < 4; ++j) { const size_t o = (size_t)row * DM + 4 * lane + 256 * j;
                const f32x4 x = *(const f32x4*)(X + o), p0 = *(const f32x4*)(PART + o), p1 = *(const f32x4*)(PART + BLK + o), gg = *(const f32x4*)(gp + 4 * lane + 256 * j);
                v[j] = x + (gg * gscale) * (p0 + p1); *(f32x4*)(X0 + o) = v[j]; }
        } else {
#pragma unroll
            for (int j = 0; j < 4; ++j) v[j] = *(const f32x4*)(X + (size_t)row * DM + 4 * lane + 256 * j);
        }
        float ss = 0.f;
#pragma unroll
        for (int j = 0; j < 4; ++j) ss += v[j][0] * v[j][0] + v[j][1] * v[j][1] + v[j][2] * v[j][2] + v[j][3] * v[j][3];
        const float rstd = rsqrtf(wave_sum(ss) * (1.0f / 1024.0f) + 1e-6f);
        const float* sh = mod + (size_t)cond * NMOD + modi * 1024; const float* scp = sh + 1024;
#pragma unroll
        for (int j = 0; j < 4; ++j) { const int d = 4 * lane + 256 * j; const f32x4 w = *(const f32x4*)(nw + d), s1 = *(const f32x4*)(scp + d), s0 = *(const f32x4*)(sh + d);
            f32x4 y;
#pragma unroll
            for (int e = 0; e < 4; ++e) y[e] = v[j][e] * rstd * w[e] * (1.f + s1[e]) + s0[e];
            u32x2 o; o.x = pk2bf(y[0], y[1]); o.y = pk2bf(y[2], y[3]); *(u32x2*)(A + (size_t)row * DM + d) = o; }
    }
}
__device__ __forceinline__ void phase_final_norm(const Params& p, const float* X, const float* PART, float* Y, int wave, int lane) {
    const float* mod = (const float*)(p.ws + OFF_MOD);
    const int gw = wave * gridDim.x + blockIdx.x, ngw = gridDim.x * NWAVES;
    for (int row = gw; row < NTOK; row += ngw) {
        f32x4 v[4]; float ss = 0.f;
#pragma unroll
        for (int j = 0; j < 4; ++j) { const size_t o = (size_t)row * DM + 4 * lane + 256 * j; const int cond = row < NCTX ? 0 : 1 + ((row - NCTX) >> 10);
            const f32x4 x = *(const f32x4*)(X + o), p0 = *(const f32x4*)(PART + o), p1 = *(const f32x4*)(PART + BLK + o), gg = *(const f32x4*)(mod + (size_t)cond * NMOD + 8 * 1024 + 4 * lane + 256 * j);
            v[j] = x + (gg * 0.5f) * (p0 + p1); ss += v[j][0] * v[j][0] + v[j][1] * v[j][1] + v[j][2] * v[j][2] + v[j][3] * v[j][3]; }
        const float rstd = rsqrtf(wave_sum(ss) * (1.0f / 1024.0f) + 1e-6f);
#pragma unroll
        for (int j = 0; j < 4; ++j) { const f32x4 w = *(const f32x4*)(p.norm_f + 4 * lane + 256 * j); *(f32x4*)(Y + (size_t)row * DM + 4 * lane + 256 * j) = v[j] * rstd * w; }
    }
}

__device__ __forceinline__ void unpack8(const v4u r, float (&f)[8]) { f[0] = bflo(r.x); f[1] = bfhi(r.x); f[2] = bflo(r.y); f[3] = bfhi(r.y); f[4] = bflo(r.z); f[5] = bfhi(r.z); f[6] = bflo(r.w); f[7] = bfhi(r.w); }
__device__ __forceinline__ void load8f(const float* p, float (&f)[8]) { const f32x4 a = *(const f32x4*)p, b = *(const f32x4*)(p + 4); f[0] = a[0]; f[1] = a[1]; f[2] = a[2]; f[3] = a[3]; f[4] = b[0]; f[5] = b[1]; f[6] = b[2]; f[7] = b[3]; }
__device__ __forceinline__ void phase_qkv_naive(const Params& p, const bf16_t* PROJ, const float* EX, float* QF, float* KF, float* VF, float* BG, bf16_t* YA, int wave, int lane) {
    const int gw = wave * gridDim.x + blockIdx.x, ngw = gridDim.x * NWAVES;
    const v4u zero4 = {0u, 0u, 0u, 0u};
    for (int tok = gw; tok < NTOK; tok += ngw) {
        const int pos = tok < NCTX ? (tok & 255) : ((tok - NCTX) & 63); const int L = tok < NCTX ? 256 : 64;
        const bool hasL = pos != 0, hasR = pos != L - 1;
#pragma unroll 1
        for (int grp = 0; grp < 6; ++grp) {
            const int part = grp >> 1, ch0 = (grp & 1) * 512 + lane * 8;
            const bf16_t* src = PROJ + (size_t)(3 + part) * BLK + (size_t)tok * DM + ch0;
            float c[8], l[8], r[8], w0[8], w1[8], w2[8], y[8];
            unpack8(*(const v4u*)src, c); unpack8(hasL ? *(const v4u*)(src - DM) : zero4, l); unpack8(hasR ? *(const v4u*)(src + DM) : zero4, r);
            const float* cw = p.dn_conv_w + part * 1024 + ch0;
            load8f(cw, w0); load8f(cw + 3072, w1); load8f(cw + 6144, w2);
            float ss = 0.f;
#pragma unroll
            for (int e = 0; e < 8; ++e) { y[e] = siluf(w0[e] * l[e] + w1[e] * c[e] + w2[e] * r[e]); ss += y[e] * y[e]; }
            if (part < 2) { const float sc = rsqrtf(sum16(ss) + 1e-6f) * (part == 0 ? 0.08838834764831845f : 1.0f);
#pragma unroll
                for (int e = 0; e < 8; ++e) y[e] *= sc; }
            float* dst = (part == 0 ? QF : part == 1 ? KF : VF) + (size_t)tok * DM + ch0;
            f32x4 o0 = {y[0], y[1], y[2], y[3]}, o1 = {y[4], y[5], y[6], y[7]};
            *(f32x4*)dst = o0; *(f32x4*)(dst + 4) = o1;
        }
#pragma unroll 1
        for (int grp = 0; grp < 2; ++grp) {
            const int ch0 = grp * 512 + lane * 8; const size_t o = (size_t)tok * DM + ch0;
            float bg[8], cc[8], cl[8], cr[8], xc[8], xl[8], xr[8], w0[8], w1[8], w2[8];
            unpack8(*(const v4u*)(PROJ + o), bg);
            unpack8(*(const v4u*)(PROJ + BLK + o), cc); unpack8(hasL ? *(const v4u*)(PROJ + BLK + o - DM) : zero4, cl); unpack8(hasR ? *(const v4u*)(PROJ + BLK + o + DM) : zero4, cr);
            unpack8(*(const v4u*)(PROJ + 2 * BLK + o), xc); unpack8(hasL ? *(const v4u*)(PROJ + 2 * BLK + o - DM) : zero4, xl); unpack8(hasR ? *(const v4u*)(PROJ + 2 * BLK + o + DM) : zero4, xr);
            load8f(p.conv_w + ch0, w0); load8f(p.conv_w + 1024 + ch0, w1); load8f(p.conv_w + 2048 + ch0, w2);
            float y[8];
#pragma unroll
            for (int e = 0; e < 8; ++e) y[e] = bg[e] * (w0[e] * cl[e] * xl[e] + w1[e] * cc[e] * xc[e] + w2[e] * cr[e] * xr[e]);
            v4u ov; ov.x = pk2bf(y[0], y[1]); ov.y = pk2bf(y[2], y[3]); ov.z = pk2bf(y[4], y[5]); ov.w = pk2bf(y[6], y[7]);
            *(v4u*)(YA + o) = ov;
        }
        if (lane < 16) {
            const float b_raw = EX[(size_t)tok * 32 + lane], a_raw = EX[(size_t)tok * 32 + 16 + lane];
            const float xx = a_raw + p.dn_dt_bias[lane]; const float sp = xx > 20.f ? xx : log1pf(expf(xx));
            BG[(size_t)tok * 32 + lane] = 1.f / (1.f + expf(-b_raw));
            BG[(size_t)tok * 32 + 16 + lane] = -expf(p.dn_a_log[lane]) * sp;
        }
    }
}

__device__ __forceinline__ void dn_naive_item(const Params& p, const float* QF, const float* KF, const float* VF, const float* BG, float* OF, float* OBk, float* lds, int item) {
    const bool lat = item < 32; const int j = lat ? item : item - 32; const int b = j >> 4, h = (j >> 1) & 7, dir = j & 1;
    const int T = lat ? 1024 : 256; const int tok0 = lat ? NCTX + b * 1024 : b * 256;
    const int tid = threadIdx.x, v = tid & 127, kq = tid >> 7;
    float* qs = lds; float* ks = lds + 128; float* vs = lds + 256; float* gb = lds + 384; float* red = lds + 512; float* red2 = lds + 1024;
    float S[32];
    if (lat) { const float* s0 = (dir ? p.st_b : p.st_f) + ((size_t)(b * 8 + h) * 128) * 128;
#pragma unroll
        for (int i = 0; i < 32; ++i) S[i] = s0[(size_t)(kq * 32 + i) * 128 + v]; }
    else {
#pragma unroll
        for (int i = 0; i < 32; ++i) S[i] = 0.f; }
    float* Od = dir ? OBk : OF;
    for (int t = 0; t < T; ++t) {
        const int tok = tok0 + (dir ? T - 1 - t : t);
        __syncthreads();
        if (tid < 128) qs[tid] = QF[(size_t)tok * DM + h * 128 + tid];
        else if (tid < 256) ks[tid - 128] = KF[(size_t)tok * DM + h * 128 + tid - 128];
        else if (tid < 384) vs[tid - 256] = VF[(size_t)tok * DM + h * 128 + tid - 256];
        else if (tid == 384) gb[0] = BG[(size_t)tok * 32 + dir * 8 + h];
        else if (tid == 385) gb[1] = BG[(size_t)tok * 32 + 16 + dir * 8 + h];
        __syncthreads();
        float part = 0.f;
#pragma unroll
        for (int i = 0; i < 32; ++i) part += ks[kq * 32 + i] * S[i];
        red[kq * 128 + v] = part;
        __syncthreads();
        const float kS = red[v] + red[128 + v] + red[256 + v] + red[384 + v];
        const float eg = expf(gb[1]), beta = gb[0];
        const float delta = beta * (vs[v] - eg * kS);
        float op = 0.f;
#pragma unroll
        for (int i = 0; i < 32; ++i) { S[i] = eg * S[i] + ks[kq * 32 + i] * delta; op += qs[kq * 32 + i] * S[i]; }
        red2[kq * 128 + v] = op;
        __syncthreads();
        if (kq == 0) Od[(size_t)tok * DM + h * 128 + v] = red2[v] + red2[128 + v] + red2[256 + v] + red2[384 + v];
    }
    if (!lat) { float* so = p.out + (size_t)NTOK * DM + (size_t)dir * (16 * 8 * 128 * 128) + ((size_t)(b * 8 + h) * 128) * 128;
#pragma unroll
        for (int i = 0; i < 32; ++i) so[(size_t)(kq * 32 + i) * 128 + v] = S[i]; }
}
__device__ __forceinline__ void phase_dn_naive(const Params& p, const float* QF, const float* KF, const float* VF, const float* BG, float* OF, float* OBk, float* lds) {
    const int bx = blockIdx.x;
    if (gridDim.x >= 256) {
        if (bx < 32) dn_naive_item(p, QF, KF, VF, BG, OF, OBk, lds, bx);
        else if (bx < 256) { dn_naive_item(p, QF, KF, VF, BG, OF, OBk, lds, bx); if (bx < 64) dn_naive_item(p, QF, KF, VF, BG, OF, OBk, lds, 224 + bx); }
    } else { for (int it = bx; it < 288; it += gridDim.x) dn_naive_item(p, QF, KF, VF, BG, OF, OBk, lds, it); }
}

typedef short bf16x8 __attribute__((ext_vector_type(8)));
typedef float f32x16 __attribute__((ext_vector_type(16)));
#define MFMA32(a, b, c) __builtin_amdgcn_mfma_f32_32x32x16_bf16((a), (b), (c), 0, 0, 0)
constexpr int DN_ITEM_BYTES = 73728, DN_W = 0, DN_QD = 16384, DN_KD = 32768, DN_A = 49152, DN_U = 57344;
constexpr int LS = 132;
constexpr int LMS = 68, LMD = 64 * LMS;
constexpr int L_QF = 0, L_KF = 33792, L_VF = 67584, L_LM = 101376, L_CO = 136192;
__device__ __forceinline__ int crow16(int i, int hh) { return (i & 3) + 8 * (i >> 2) + 4 * hh; }
__device__ __forceinline__ bf16x8 frag_from_f32(const float* p) { const f32x4 a = *(const f32x4*)p, b = *(const f32x4*)(p + 4);
    v4u r; r.x = pk2bf(a[0], a[1]); r.y = pk2bf(a[2], a[3]); r.z = pk2bf(b[0], b[1]); r.w = pk2bf(b[2], b[3]); return __builtin_bit_cast(bf16x8, r); }
template <int S> __device__ __forceinline__ bf16x8 pack_step(const f32x16& x) {
    v4u r; r.x = pk2bf(x[8 * S + 0], x[8 * S + 1]); r.y = pk2bf(x[8 * S + 2], x[8 * S + 3]); r.z = pk2bf(x[8 * S + 4], x[8 * S + 5]); r.w = pk2bf(x[8 * S + 6], x[8 * S + 7]); return __builtin_bit_cast(bf16x8, r); }

__device__ __forceinline__ void split_hi_lo(const float* p, bf16x8& hi, bf16x8& lo) {
    const f32x4 a = *(const f32x4*)p, b = *(const f32x4*)(p + 4);
    v4u h; h.x = pk2bf(a[0], a[1]); h.y = pk2bf(a[2], a[3]); h.z = pk2bf(b[0], b[1]); h.w = pk2bf(b[2], b[3]);
    v4u l; l.x = pk2bf(a[0] - bflo(h.x), a[1] - bfhi(h.x)); l.y = pk2bf(a[2] - bflo(h.y), a[3] - bfhi(h.y)); l.z = pk2bf(b[0] - bflo(h.z), b[1] - bfhi(h.z)); l.w = pk2bf(b[2] - bflo(h.w), b[3] - bfhi(h.w));
    hi = __builtin_bit_cast(bf16x8, h); lo = __builtin_bit_cast(bf16x8, l);
}
__device__ __forceinline__ void dn_pre_item(const Params& p, const bf16_t* PROJ, const float* EX, unsigned char* DN, float* GL, unsigned char* lds, int sc, int h) {
    int tid_l = threadIdx.x; asm volatile("" : "+v"(tid_l));
    const int tid = tid_l, lane = tid & 63, wave = tid >> 6;
    const bool ctx = sc < 64; const int nn = ctx ? (sc & 3) : ((sc - 64) & 15);
    const int tok0 = ctx ? (sc >> 2) * 256 + 64 * nn : NCTX + ((sc - 64) >> 4) * 1024 + 64 * nn;
    float* QFl = (float*)(lds + L_QF); float* KFl = (float*)(lds + L_KF); float* VFl = (float*)(lds + L_VF); float* LM = (float*)(lds + L_LM);
    float* CB = (float*)(lds + L_CO);
    float* CG = CB + 128;
    float* CW = CB + 256;
    float* CE = CB + 384;
    float* CK = CB + 512;
    const v4u zero4 = {0u, 0u, 0u, 0u};
    unsigned char* item0 = DN + (size_t)((sc * 8 + h) * 2) * DN_ITEM_BYTES;
#pragma unroll 2
    for (int jj = 0; jj < 6; ++jj) {
        const int pr = tid + 512 * jj, c = pr / 48, cg = pr % 48, part = cg >> 4, d0 = (cg & 15) * 8;
        const bool hasL = c > 0 || (ctx && nn > 0), hasR = c < 63 || (ctx && nn < 3);
        const bf16_t* src = PROJ + (size_t)(3 + part) * BLK + (size_t)(tok0 + c) * DM + h * 128 + d0;
        float cc[8], l[8], r[8], w0[8], w1[8], w2[8], y[8];
        unpack8(*(const v4u*)src, cc); unpack8(hasL ? *(const v4u*)(src - DM) : zero4, l); unpack8(hasR ? *(const v4u*)(src + DM) : zero4, r);
        const float* cw = p.dn_conv_w + part * 1024 + h * 128 + d0;
        load8f(cw, w0); load8f(cw + 3072, w1); load8f(cw + 6144, w2);
        float ss = 0.f;
#pragma unroll
        for (int e = 0; e < 8; ++e) { y[e] = siluf(w0[e] * l[e] + w1[e] * cc[e] + w2[e] * r[e]); ss += y[e] * y[e]; }
        const float tot = sum16(ss);
        if (part < 2) { const float scl = rsqrtf(tot + 1e-6f) * (part == 0 ? 0.08838834764831845f : 1.0f);
#pragma unroll
            for (int e = 0; e < 8; ++e) y[e] *= scl; }
        float* dst = (part == 0 ? QFl : part == 1 ? KFl : VFl) + c * LS + d0;
        f32x4 o0 = {y[0], y[1], y[2], y[3]}, o1 = {y[4], y[5], y[6], y[7]};
        *(f32x4*)dst = o0; *(f32x4*)(dst + 4) = o1;
    }
    if (wave < 2) {
        const int d = wave, oc = d ? 63 - lane : lane; const size_t tk = (size_t)(tok0 + oc) * 32;
        const float b_raw = EX[tk + d * 8 + h], a_raw = EX[tk + 16 + d * 8 + h];
        const float xx = a_raw + p.dn_dt_bias[d * 8 + h]; const float sp = xx > 20.f ? xx : log1pf(expf(xx));
        const float beta = 1.f / (1.f + expf(-b_raw)); float g = -expf(p.dn_a_log[d * 8 + h]) * sp;
#pragma unroll
        for (int o = 1; o < 64; o <<= 1) { const float t = __shfl_up(g, o); if (lane >= o) g += t; }
        const float glast = __shfl(g, 63); const float eg = expf(g);
        CB[d * 64 + lane] = beta; CG[d * 64 + lane] = g; CW[d * 64 + lane] = beta * eg; CE[d * 64 + lane] = eg; CK[d * 64 + lane] = expf(glast - g);
        if (lane == 0) GL[(sc * 8 + h) * 2 + d] = expf(glast);
    }
    __syncthreads();
    const int dir = wave >> 2;
    unsigned char* item = item0 + (size_t)dir * DN_ITEM_BYTES;
    {
        const int w4 = wave & 3, mt = w4 >> 1, nt = w4 & 1, r = lane & 31, hh = lane >> 5;
        const int ia = 32 * mt + r, ib = 32 * nt + r; const int ca = dir ? 63 - ia : ia, cb = dir ? 63 - ib : ib;
        f32x16 kk, pp;
#pragma unroll
        for (int i = 0; i < 16; ++i) { kk[i] = 0.f; pp[i] = 0.f; }
#pragma unroll
        for (int ks = 0; ks < 8; ++ks) {
            const bf16x8 ka = frag_from_f32(KFl + ca * LS + 16 * ks + 8 * hh), kb = frag_from_f32(KFl + cb * LS + 16 * ks + 8 * hh), qb = frag_from_f32(QFl + cb * LS + 16 * ks + 8 * hh);
            kk = MFMA32(ka, kb, kk); pp = MFMA32(ka, qb, pp);
        }
        const float* gcd = CG + dir * 64; const float* btd = CB + dir * 64;
        const float g_col = gcd[ib];
        f32x16 pv;
#pragma unroll
        for (int i = 0; i < 16; ++i) {
            const int row = 32 * mt + crow16(i, hh); const float g_row = gcd[row];
            LM[dir * LMD + row * LMS + ib] = (ib < row) ? btd[row] * kk[i] * expf(g_row - g_col) : 0.f;
            pv[i] = (row <= ib) ? pp[i] * expf(g_col - g_row) : 0.f;
        }
        v4u* af = (v4u*)(item + DN_A);
        af[(nt * 4 + mt * 2 + 0) * 64 + lane] = __builtin_bit_cast(v4u, pack_step<0>(pv));
        af[(nt * 4 + mt * 2 + 1) * 64 + lane] = __builtin_bit_cast(v4u, pack_step<1>(pv));
    }
    __syncthreads();
    float x[64];
    if (wave < 2) {
        const float* Lm = LM + wave * LMD;
#pragma unroll
        for (int c = 0; c < 64; ++c) {
            float acc = (c == lane) ? 1.f : 0.f;
#pragma unroll
            for (int s = 0; s < c; ++s) acc -= Lm[c * LMS + s] * x[s];
            x[c] = acc;
        }
    } else {
#pragma unroll 1
        for (int idx = tid - 128; idx < 4096; idx += 384) {
            const int d = idx >> 11, kd = (idx >> 10) & 1, f = (idx >> 6) & 15, ln = idx & 63, r = ln & 31, hh = ln >> 5;
            unsigned char* itd = item0 + (size_t)d * DN_ITEM_BYTES;
            if (kd == 0) {
                const int mt = f >> 3, ks8 = f & 7, cp = 32 * mt + r, oc = d ? 63 - cp : cp, dkb = 16 * ks8 + 4 * hh;
                const f32x4 qa = *(const f32x4*)(QFl + oc * LS + dkb), qb = *(const f32x4*)(QFl + oc * LS + dkb + 8); const float e = CE[d * 64 + cp];
                v4u qv; qv.x = pk2bf(qa[0] * e, qa[1] * e); qv.y = pk2bf(qa[2] * e, qa[3] * e); qv.z = pk2bf(qb[0] * e, qb[1] * e); qv.w = pk2bf(qb[2] * e, qb[3] * e);
                ((v4u*)(itd + DN_QD))[f * 64 + ln] = qv;
            } else {
                const int mtK = f >> 2, kst = f & 3, dk = 32 * mtK + r, sb = 16 * kst + 4 * hh;
                float kv[8];
#pragma unroll
                for (int j = 0; j < 8; ++j) { const int sp = sb + (j & 3) + 8 * (j >> 2); const int os = d ? 63 - sp : sp; kv[j] = KFl[os * LS + dk] * CK[d * 64 + sp]; }
                v4u kq; kq.x = pk2bf(kv[0], kv[1]); kq.y = pk2bf(kv[2], kv[3]); kq.z = pk2bf(kv[4], kv[5]); kq.w = pk2bf(kv[6], kv[7]);
                ((v4u*)(itd + DN_KD))[f * 64 + ln] = kq;
            }
        }
    }
    __syncthreads();
    if (wave < 2) {
#pragma unroll
        for (int c = 0; c < 64; ++c) LM[wave * LMD + c * LMS + lane] = x[c];
    }
    __syncthreads();
    {
        const int w4 = wave & 3, r = lane & 31, hh = lane >> 5;
        const float* TI = LM + dir * LMD; const float* cbd = CB + dir * 64; const float* cwd = CW + dir * 64;
#pragma unroll 1
        for (int tt = 0; tt < 2; ++tt) {
            {
                const int tix = w4 * 2 + tt, jj = tix >> 1, mt = tix & 1;
                f32x16 acc;
#pragma unroll
                for (int i = 0; i < 16; ++i) acc[i] = 0.f;
#pragma unroll
                for (int ks = 0; ks < 4; ++ks) {
                    bf16x8 ah, al; split_hi_lo(TI + (32 * mt + r) * LMS + 16 * ks + 8 * hh, ah, al);
                    float bv[8];
#pragma unroll
                    for (int j = 0; j < 8; ++j) { const int s = 16 * ks + 8 * hh + j; const int os = dir ? 63 - s : s; bv[j] = VFl[os * LS + 32 * jj + r] * cbd[s]; }
                    v4u bb; bb.x = pk2bf(bv[0], bv[1]); bb.y = pk2bf(bv[2], bv[3]); bb.z = pk2bf(bv[4], bv[5]); bb.w = pk2bf(bv[6], bv[7]);
                    const bf16x8 b = __builtin_bit_cast(bf16x8, bb);
                    acc = MFMA32(ah, b, acc); acc = MFMA32(al, b, acc);
                }
                v4u lo, hi;
                lo.x = pk2bf(acc[0], acc[1]); lo.y = pk2bf(acc[2], acc[3]); lo.z = pk2bf(acc[4], acc[5]); lo.w = pk2bf(acc[6], acc[7]);
                hi.x = pk2bf(acc[8], acc[9]); hi.y = pk2bf(acc[10], acc[11]); hi.z = pk2bf(acc[12], acc[13]); hi.w = pk2bf(acc[14], acc[15]);
                v4u* dst = (v4u*)(item + DN_U + (size_t)(((jj * 2 + mt) * 64 + lane) * 32));
                dst[0] = lo; dst[1] = hi;
            }
            {
                const int tix = w4 * 2 + tt, mtK = tix >> 1, nt = tix & 1;
                f32x16 acc;
#pragma unroll
                for (int i = 0; i < 16; ++i) acc[i] = 0.f;
#pragma unroll
                for (int ks = 0; ks < 4; ++ks) {
                    bf16x8 bh, bl; split_hi_lo(TI + (32 * nt + r) * LMS + 16 * ks + 8 * hh, bh, bl);
                    float av[8];
#pragma unroll
                    for (int j = 0; j < 8; ++j) { const int s = 16 * ks + 8 * hh + j; const int os = dir ? 63 - s : s; av[j] = KFl[os * LS + 32 * mtK + r] * cwd[s]; }
                    v4u aa; aa.x = pk2bf(av[0], av[1]); aa.y = pk2bf(av[2], av[3]); aa.z = pk2bf(av[4], av[5]); aa.w = pk2bf(av[6], av[7]);
                    const bf16x8 a = __builtin_bit_cast(bf16x8, aa);
                    acc = MFMA32(a, bh, acc); acc = MFMA32(a, bl, acc);
                }
                v4u* wf = (v4u*)(item + DN_W);
                wf[(nt * 8 + mtK * 2 + 0) * 64 + lane] = __builtin_bit_cast(v4u, pack_step<0>(acc));
                wf[(nt * 8 + mtK * 2 + 1) * 64 + lane] = __builtin_bit_cast(v4u, pack_step<1>(acc));
            }
        }
    }
    __syncthreads();
}

__device__ __forceinline__ void phase_branch_a(const Params& p, const bf16_t* PROJ, bf16_t* YA, int wave, int lane) {
    const int gw = wave * gridDim.x + blockIdx.x, ngw = gridDim.x * NWAVES;
    const v4u zero4 = {0u, 0u, 0u, 0u};
    for (int tok = gw; tok < NTOK; tok += ngw) {
        const int pos = tok < NCTX ? (tok & 255) : ((tok - NCTX) & 63); const int L = tok < NCTX ? 256 : 64;
        const bool hasL = pos != 0, hasR = pos != L - 1;
#pragma unroll 1
        for (int grp = 0; grp < 2; ++grp) {
            const int ch0 = grp * 512 + lane * 8; const size_t o = (size_t)tok * DM + ch0;
            float bg[8], cc[8], cl[8], cr[8], xc[8], xl[8], xr[8], w0[8], w1[8], w2[8];
            unpack8(*(const v4u*)(PROJ + o), bg);
            unpack8(*(const v4u*)(PROJ + BLK + o), cc); unpack8(hasL ? *(const v4u*)(PROJ + BLK + o - DM) : zero4, cl); unpack8(hasR ? *(const v4u*)(PROJ + BLK + o + DM) : zero4, cr);
            unpack8(*(const v4u*)(PROJ + 2 * BLK + o), xc); unpack8(hasL ? *(const v4u*)(PROJ + 2 * BLK + o - DM) : zero4, xl); unpack8(hasR ? *(const v4u*)(PROJ + 2 * BLK + o + DM) : zero4, xr);
            load8f(p.conv_w + ch0, w0); load8f(p.conv_w + 1024 + ch0, w1); load8f(p.conv_w + 2048 + ch0, w2);
            float y[8];
#pragma unroll
            for (int e = 0; e < 8; ++e) y[e] = bg[e] * (w0[e] * cl[e] * xl[e] + w1[e] * cc[e] * xc[e] + w2[e] * cr[e] * xr[e]);
            v4u ov; ov.x = pk2bf(y[0], y[1]); ov.y = pk2bf(y[2], y[3]); ov.z = pk2bf(y[4], y[5]); ov.w = pk2bf(y[6], y[7]);
            *(v4u*)(YA + o) = ov;
        }
    }
}

__device__ __forceinline__ void dn_scan_item(const Params& p, const unsigned char* DN, const float* GL, float* OF, float* OBk, int it, int lane) {
    const bool lat = it < 128; const int q = lat ? it : it - 128;
    const int jj = q & 3, dir = (q >> 2) & 1, h = (q >> 3) & 7, b = q >> 6;
    const int nch = lat ? 16 : 4, scb = lat ? 64 + 16 * b : 4 * b, tokb = lat ? NCTX + b * 1024 : b * 256;
    const int n = lane & 31, hh = lane >> 5;
    f32x16 S[4];
    if (lat) { const float* s0 = (dir ? p.st_b : p.st_f) + (size_t)(b * 8 + h) * 16384 + 32 * jj + n;
#pragma unroll
        for (int m = 0; m < 4; ++m)
#pragma unroll
            for (int i = 0; i < 16; ++i) S[m][i] = s0[(size_t)(32 * m + crow16(i, hh)) * 128]; }
    else {
#pragma unroll
        for (int m = 0; m < 4; ++m)
#pragma unroll
            for (int i = 0; i < 16; ++i) S[m][i] = 0.f; }
    float* Od = (dir ? OBk : OF) + h * 128 + 32 * jj + n;
#pragma unroll 1
    for (int ci = 0; ci < nch; ++ci) {
        const int no = dir ? nch - 1 - ci : ci; const int id = ((scb + no) * 8 + h) * 2 + dir;
        const unsigned char* item = DN + (size_t)id * DN_ITEM_BYTES;
        const v4u* Wf = (const v4u*)(item + DN_W) + lane; const v4u* Qf = (const v4u*)(item + DN_QD) + lane; const v4u* Kf = (const v4u*)(item + DN_KD) + lane; const v4u* Af = (const v4u*)(item + DN_A) + lane;
        const float gl = GL[id];
        bf16x8 Sb[8];
        Sb[0] = pack_step<0>(S[0]); Sb[1] = pack_step<1>(S[0]); Sb[2] = pack_step<0>(S[1]); Sb[3] = pack_step<1>(S[1]);
        Sb[4] = pack_step<0>(S[2]); Sb[5] = pack_step<1>(S[2]); Sb[6] = pack_step<0>(S[3]); Sb[7] = pack_step<1>(S[3]);
        f32x16 vn[2], o[2];
#pragma unroll
        for (int mt = 0; mt < 2; ++mt) {
            f32x16 ws;
#pragma unroll
            for (int i = 0; i < 16; ++i) { ws[i] = 0.f; o[mt][i] = 0.f; }
#pragma unroll
            for (int ks = 0; ks < 8; ++ks) { ws = MFMA32(__builtin_bit_cast(bf16x8, Wf[(mt * 8 + ks) * 64]), Sb[ks], ws); o[mt] = MFMA32(__builtin_bit_cast(bf16x8, Qf[(mt * 8 + ks) * 64]), Sb[ks], o[mt]); }
            const v4u* up = (const v4u*)(item + DN_U + (size_t)(((jj * 2 + mt) * 64 + lane) * 32));
            const v4u u0 = up[0], u1 = up[1];
            vn[mt][0] = bflo(u0.x) - ws[0]; vn[mt][1] = bfhi(u0.x) - ws[1]; vn[mt][2] = bflo(u0.y) - ws[2]; vn[mt][3] = bfhi(u0.y) - ws[3];
            vn[mt][4] = bflo(u0.z) - ws[4]; vn[mt][5] = bfhi(u0.z) - ws[5]; vn[mt][6] = bflo(u0.w) - ws[6]; vn[mt][7] = bfhi(u0.w) - ws[7];
            vn[mt][8] = bflo(u1.x) - ws[8]; vn[mt][9] = bfhi(u1.x) - ws[9]; vn[mt][10] = bflo(u1.y) - ws[10]; vn[mt][11] = bfhi(u1.y) - ws[11];
            vn[mt][12] = bflo(u1.z) - ws[12]; vn[mt][13] = bfhi(u1.z) - ws[13]; vn[mt][14] = bflo(u1.w) - ws[14]; vn[mt][15] = bfhi(u1.w) - ws[15];
        }
        bf16x8 Vb[4];
        Vb[0] = pack_step<0>(vn[0]); Vb[1] = pack_step<1>(vn[0]); Vb[2] = pack_step<0>(vn[1]); Vb[3] = pack_step<1>(vn[1]);
#pragma unroll
        for (int mt = 0; mt < 2; ++mt)
#pragma unroll
            for (int kst = 0; kst < 4; ++kst) o[mt] = MFMA32(__builtin_bit_cast(bf16x8, Af[(mt * 4 + kst) * 64]), Vb[kst], o[mt]);
#pragma unroll
        for (int m = 0; m < 4; ++m) {
#pragma unroll
            for (int i = 0; i < 16; ++i) S[m][i] *= gl;
#pragma unroll
            for (int kst = 0; kst < 4; ++kst) S[m] = MFMA32(__builtin_bit_cast(bf16x8, Kf[(m * 4 + kst) * 64]), Vb[kst], S[m]);
        }
        const int tok0 = tokb + 64 * no;
#pragma unroll
        for (int mt = 0; mt < 2; ++mt)
#pragma unroll
            for (int i = 0; i < 16; ++i) { const int cp = 32 * mt + crow16(i, hh); const int oc = dir ? 63 - cp : cp; Od[(size_t)(tok0 + oc) * DM] = o[mt][i]; }
    }
    if (!lat) { float* so = p.out + (size_t)NTOK * DM + (size_t)dir * (16 * 8 * 128 * 128) + (size_t)(b * 8 + h) * 16384 + 32 * jj + n;
#pragma unroll
        for (int m = 0; m < 4; ++m)
#pragma unroll
            for (int i = 0; i < 16; ++i) so[(size_t)(32 * m + crow16(i, hh)) * 128] = S[m][i]; }
}

constexpr int SC_BUF = 57344;
__device__ __forceinline__ void dn_scan_group(const Params& p, const unsigned char* DN, const float* GL, float* OF, float* OBk, unsigned char* lds, int grp) {
    int tid_l = threadIdx.x; asm volatile("" : "+v"(tid_l));
    const int tid = tid_l, lane = tid & 63, wave = __builtin_amdgcn_readfirstlane(tid >> 6);
    const bool lat = grp < 32; const int q = lat ? grp : grp - 32;
    const int dir = q & 1, h = (q >> 1) & 7, b = q >> 4;
    const int nch = lat ? 16 : 4, scb = lat ? 64 + 16 * b : 4 * b, tokb = lat ? NCTX + b * 1024 : b * 256;
    if (wave >= 4) {
        const int lt = tid - 256;
        v4u r[14];
        {   const v4u* src = (const v4u*)(DN + (size_t)(((scb + (dir ? nch - 1 : 0)) * 8 + h) * 2 + dir) * DN_ITEM_BYTES) + lt;
#pragma unroll
            for (int k = 0; k < 14; ++k) r[k] = src[256 * k];
            v4u* dst = (v4u*)lds + lt;
#pragma unroll
            for (int k = 0; k < 14; ++k) dst[256 * k] = r[k]; }
        {   const v4u* src = (const v4u*)(DN + (size_t)(((scb + (dir ? nch - 2 : 1)) * 8 + h) * 2 + dir) * DN_ITEM_BYTES) + lt;
#pragma unroll
            for (int k = 0; k < 14; ++k) r[k] = src[256 * k]; }
        __syncthreads();
#pragma unroll 1
        for (int ci = 0; ci < nch; ++ci) {
            if (ci + 1 < nch) { v4u* dst = (v4u*)(lds + ((ci + 1) & 1) * SC_BUF) + lt;
#pragma unroll
                for (int k = 0; k < 14; ++k) dst[256 * k] = r[k]; }
            if (ci + 2 < nch) { const int no = dir ? nch - 3 - ci : ci + 2;
                const v4u* src = (const v4u*)(DN + (size_t)(((scb + no) * 8 + h) * 2 + dir) * DN_ITEM_BYTES) + lt;
#pragma unroll
                for (int k = 0; k < 14; ++k) r[k] = src[256 * k]; }
            __syncthreads();
        }
    } else {
        const int jj = wave, n = lane & 31, hh = lane >> 5;
        f32x16 S[4];
        if (lat) { const float* s0 = (dir ? p.st_b : p.st_f) + (size_t)(b * 8 + h) * 16384 + 32 * jj + n;
#pragma unroll
            for (int m = 0; m < 4; ++m)
#pragma unroll
                for (int i = 0; i < 16; ++i) S[m][i] = s0[(size_t)(32 * m + crow16(i, hh)) * 128]; }
        else {
#pragma unroll
            for (int m = 0; m < 4; ++m)
#pragma unroll
                for (int i = 0; i < 16; ++i) S[m][i] = 0.f; }
        float* Od = (dir ? OBk : OF) + h * 128 + 32 * jj + n;
        v4u un[4]; float gln;
        {   const int id0 = ((scb + (dir ? nch - 1 : 0)) * 8 + h) * 2 + dir; const unsigned char* it0 = DN + (size_t)id0 * DN_ITEM_BYTES + DN_U;
            const v4u* u0 = (const v4u*)(it0 + (size_t)(((jj * 2 + 0) * 64 + lane) * 32)); const v4u* u1 = (const v4u*)(it0 + (size_t)(((jj * 2 + 1) * 64 + lane) * 32));
            un[0] = u0[0]; un[1] = u0[1]; un[2] = u1[0]; un[3] = u1[1]; gln = GL[id0]; }
        __syncthreads();
#pragma unroll 1
        for (int ci = 0; ci < nch; ++ci) {
            const int no = dir ? nch - 1 - ci : ci;
            const float gl = gln;
            const unsigned char* buf = lds + (ci & 1) * SC_BUF;
            const v4u* Wf = (const v4u*)(buf + DN_W) + lane; const v4u* Qf = (const v4u*)(buf + DN_QD) + lane; const v4u* Kf = (const v4u*)(buf + DN_KD) + lane; const v4u* Af = (const v4u*)(buf + DN_A) + lane;
            f32x16 vn[2], o[2];
            {
                bf16x8 Sb[8];
                Sb[0] = pack_step<0>(S[0]); Sb[1] = pack_step<1>(S[0]); Sb[2] = pack_step<0>(S[1]); Sb[3] = pack_step<1>(S[1]);
                Sb[4] = pack_step<0>(S[2]); Sb[5] = pack_step<1>(S[2]); Sb[6] = pack_step<0>(S[3]); Sb[7] = pack_step<1>(S[3]);
#pragma unroll
                for (int mt = 0; mt < 2; ++mt) {
                    f32x16 ws;
#pragma unroll
                    for (int i = 0; i < 16; ++i) { ws[i] = 0.f; o[mt][i] = 0.f; }
#pragma unroll
                    for (int ks = 0; ks < 8; ++ks) { ws = MFMA32(__builtin_bit_cast(bf16x8, Wf[(mt * 8 + ks) * 64]), Sb[ks], ws); o[mt] = MFMA32(__builtin_bit_cast(bf16x8, Qf[(mt * 8 + ks) * 64]), Sb[ks], o[mt]); }
                    const v4u u0 = un[2 * mt], u1 = un[2 * mt + 1];
                    vn[mt][0] = bflo(u0.x) - ws[0]; vn[mt][1] = bfhi(u0.x) - ws[1]; vn[mt][2] = bflo(u0.y) - ws[2]; vn[mt][3] = bfhi(u0.y) - ws[3];
                    vn[mt][4] = bflo(u0.z) - ws[4]; vn[mt][5] = bfhi(u0.z) - ws[5]; vn[mt][6] = bflo(u0.w) - ws[6]; vn[mt][7] = bfhi(u0.w) - ws[7];
                    vn[mt][8] = bflo(u1.x) - ws[8]; vn[mt][9] = bfhi(u1.x) - ws[9]; vn[mt][10] = bflo(u1.y) - ws[10]; vn[mt][11] = bfhi(u1.y) - ws[11];
                    vn[mt][12] = bflo(u1.z) - ws[12]; vn[mt][13] = bfhi(u1.z) - ws[13]; vn[mt][14] = bflo(u1.w) - ws[14]; vn[mt][15] = bfhi(u1.w) - ws[15];
                    __builtin_amdgcn_sched_barrier(0);
                }
            }
            if (ci + 1 < nch) { const int no1 = dir ? nch - 2 - ci : ci + 1; const int id1 = ((scb + no1) * 8 + h) * 2 + dir; const unsigned char* it1 = DN + (size_t)id1 * DN_ITEM_BYTES + DN_U;
                const v4u* u0 = (const v4u*)(it1 + (size_t)(((jj * 2 + 0) * 64 + lane) * 32)); const v4u* u1 = (const v4u*)(it1 + (size_t)(((jj * 2 + 1) * 64 + lane) * 32));
                un[0] = u0[0]; un[1] = u0[1]; un[2] = u1[0]; un[3] = u1[1]; gln = GL[id1]; }
            bf16x8 Vb[4];
            Vb[0] = pack_step<0>(vn[0]); Vb[1] = pack_step<1>(vn[0]); Vb[2] = pack_step<0>(vn[1]); Vb[3] = pack_step<1>(vn[1]);
            __builtin_amdgcn_sched_barrier(0);
#pragma unroll
            for (int mt = 0; mt < 2; ++mt)
#pragma unroll
                for (int kst = 0; kst < 4; ++kst) o[mt] = MFMA32(__builtin_bit_cast(bf16x8, Af[(mt * 4 + kst) * 64]), Vb[kst], o[mt]);
            const int tok0 = tokb + 64 * no;
#pragma unroll
            for (int mt = 0; mt < 2; ++mt)
#pragma unroll
                for (int i = 0; i < 16; ++i) { const int cp = 32 * mt + crow16(i, hh); const int oc = dir ? 63 - cp : cp; Od[(size_t)(tok0 + oc) * DM] = o[mt][i]; }
            __builtin_amdgcn_sched_barrier(0);
#pragma unroll
            for (int m = 0; m < 4; ++m) {
#pragma unroll
                for (int i = 0; i < 16; ++i) S[m][i] *= gl;
#pragma unroll
                for (int kst = 0; kst < 4; ++kst) S[m] = MFMA32(__builtin_bit_cast(bf16x8, Kf[(m * 4 + kst) * 64]), Vb[kst], S[m]);
            }
            __builtin_amdgcn_sched_barrier(0);
            __syncthreads();
        }
        if (!lat) { float* so = p.out + (size_t)NTOK * DM + (size_t)dir * (16 * 8 * 128 * 128) + (size_t)(b * 8 + h) * 16384 + 32 * jj + n;
#pragma unroll
            for (int m = 0; m < 4; ++m)
#pragma unroll
                for (int i = 0; i < 16; ++i) so[(size_t)(32 * m + crow16(i, hh)) * 128] = S[m][i]; }
    }
}
__device__ __forceinline__ void phase_dn_scan(const Params& p, const unsigned char* DN, const float* GL, float* OF, float* OBk, unsigned char* lds) {
    const int bx = blockIdx.x;
    if (gridDim.x >= 256) {
        const int ng = (bx >= 32 && bx < 64) ? 2 : 1;
#pragma unroll 1
        for (int gi = 0; gi < ng; ++gi) dn_scan_group(p, DN, GL, OF, OBk, lds, gi ? 224 + bx : bx);
    } else { for (int g = bx; g < 288; g += gridDim.x) dn_scan_group(p, DN, GL, OF, OBk, lds, g); }
}

__device__ __forceinline__ void phase_ogate(const Params& p, const float* OF, const float* OBk, const bf16_t* Z, bf16_t* OG, int wave, int lane) {
    const int gw = wave * gridDim.x + blockIdx.x, ngw = gridDim.x * NWAVES;
    for (int tok = gw; tok < NTOK; tok += ngw) {
#pragma unroll
        for (int hf = 0; hf < 2; ++hf) {
            const int ch0 = hf * 512 + lane * 8; const size_t o = (size_t)tok * DM + ch0;
            float a[8], b2[8], z[8], nw[8];
            load8f(OF + o, a); load8f(OBk + o, b2); unpack8(*(const v4u*)(Z + o), z); load8f(p.dn_norm_w + (ch0 & 127), nw);
            float ss = 0.f;
#pragma unroll
            for (int e = 0; e < 8; ++e) { a[e] += b2[e]; ss += a[e] * a[e]; }
            const float r = rsqrtf(sum16(ss) * (1.0f / 128.0f) + 1e-6f);
            float y[8];
#pragma unroll
            for (int e = 0; e < 8; ++e) y[e] = a[e] * r * nw[e] * siluf(z[e]);
            v4u ov; ov.x = pk2bf(y[0], y[1]); ov.y = pk2bf(y[2], y[3]); ov.z = pk2bf(y[4], y[5]); ov.w = pk2bf(y[6], y[7]);
            *(v4u*)(OG + o) = ov;
        }
    }
}

template <class Epi> __device__ __forceinline__ void run_gemm(PG8_LAS unsigned char* lds, const bf16_t* A, const bf16_t* Bt, int N, int K, const Epi& E, int nrep, int split = 1) {
    pg8::Gemm g; g.A = A; g.Bt = Bt; g.M = NTOK; g.N = N; g.K = K; g.klen = K / split; g.nsp = N / 256;
    pg8::StaticOrder S; S.init(NTOK, N * split, (int)gridDim.x, (int)blockIdx.x);
    pg8::gemm_phase<Epi, pg8::StaticOrder, false>(lds, g, S, E, nullptr);
    __syncthreads();
}

__global__ void __launch_bounds__(512) fwd_megakernel(Params p) {
    extern __shared__ __attribute__((aligned(16))) unsigned char shm[];
    cg::grid_group grid = cg::this_grid();
    PG8_LAS unsigned char* lds3 = (PG8_LAS unsigned char*)shm;
    const int wave = __builtin_amdgcn_readfirstlane(threadIdx.x >> 6), lane = threadIdx.x & 63;
    unsigned char* ws = p.ws;
    volatile XLAS unsigned* xst = (volatile XLAS unsigned*)(lds3 + (LDS_BYTES - 16));
    if (threadIdx.x == 0) { xst[0] = 0u; xst[1] = 0u; }
    __syncthreads();
    XcdBarrier xb = xcd_barrier_post((unsigned*)(ws + OFF_BAR), xst);
    float* X0 = (float*)(ws + OFF_X0); float* X1 = (float*)(ws + OFF_X1); float* MOD = (float*)(ws + OFF_MOD);
    bf16_t* PROJ = (bf16_t*)(ws + OFF_PROJ); float* EX = (float*)(ws + OFF_EX);
    bf16_t* AM = (bf16_t*)p.out;
    bf16_t* HB = (bf16_t*)(ws + OFF_PROJ);
    float* QF = (float*)(ws + OFF_DN); float* KF = QF + BLK; float* VF = KF + BLK; float* BG = VF + BLK;
    float* OF = (float*)(ws + OFF_PROJ); float* OBk = OF + BLK;
    float* PART = (float*)(ws + 66 * MiB);
    float* T1 = (float*)(PROJ + 4 * BLK);
    float* GLp = (float*)(ws + OFF_EX + 786432);
    bf16_t* OG = (bf16_t*)p.out + BLK; bf16_t* MRG = AM;

#pragma unroll 1
    for (int rep = 0; rep < p.rep_prep; ++rep) { phase_prep(p, shm, wave, lane); __syncthreads(); }
    xcd_barrier(xb);
#pragma unroll 1
    for (int rep = 0; rep < p.rep_thin; ++rep) phase_norm<1>(p, nullptr, X0, p.norm_ffn1, 0, AM, wave, lane);
    xcd_barrier(xb);
    { pg8::EpiSwiglu E; E.H = HB; run_gemm(lds3, AM, (const bf16_t*)(ws + OFF_WGU), 5632, 1024, E, p.rep_gemm); }
    side_transposes(p, shm, wave, lane, 0, 16);
    xcd_barrier(xb);
    { pg8::EpiPartial E; E.P = PART; run_gemm(lds3, HB, (const bf16_t*)(ws + OFF_WD), 1024, FFH, E, p.rep_gemm, 2); }
    side_transposes(p, shm, wave, lane, 1, 192);
    xcd_barrier(xb);
#pragma unroll 1
    for (int rep = 0; rep < p.rep_thin; ++rep) phase_norm<2>(p, X0, X1, p.norm_mix, 3, AM, wave, lane, PART, 2, 0.5f);
    xcd_barrier(xb);
    { pg8::EpiProj E; E.P = PROJ; E.EX = EX; run_gemm(lds3, AM, (const bf16_t*)(ws + OFF_WIN), 9472, 1024, E, p.rep_gemm); }
    xcd_barrier(xb);
#pragma unroll 1
    for (int rep = 0; rep < p.rep_dnpre; ++rep) for (int it = blockIdx.x; it < 768; it += gridDim.x) dn_pre_item(p, PROJ, EX, ws + OFF_DN, GLp, shm, it >> 3, it & 7);
#pragma unroll 1
    for (int rep = 0; rep < p.rep_thin; ++rep) phase_branch_a(p, PROJ, AM, wave, lane);
    xcd_barrier(xb);
#pragma unroll 1
    for (int rep = 0; rep < p.rep_scan; ++rep) phase_dn_scan(p, ws + OFF_DN, GLp, OF, OBk, shm);
    {
        pg8::EpiGate<0> E; E.G = PROJ + 7 * BLK; E.T = T1; E.O = nullptr;
        pg8::Gemm g; g.A = AM; g.Bt = (const bf16_t*)(ws + OFF_WCO); g.M = NTOK; g.N = 1024; g.K = 1024; g.klen = 1024; g.nsp = 4;
        const bool sub = gridDim.x >= 256;
        const int G = sub ? 96 : (int)gridDim.x, c = sub ? (int)blockIdx.x - 64 : (int)blockIdx.x;
        if (c >= 0 && c < G) { pg8::StaticOrder S; S.init(NTOK, 1024, G, c); pg8::gemm_phase<pg8::EpiGate<0>, pg8::StaticOrder, false>(lds3, g, S, E, nullptr); }
        __syncthreads();
    }
    xcd_barrier(xb);
#pragma unroll 1
    for (int rep = 0; rep < p.rep_thin; ++rep) phase_ogate(p, OF, OBk, PROJ + 6 * BLK, OG, wave, lane);
    xcd_barrier(xb);
    { pg8::EpiGate<1> E; E.G = PROJ + 8 * BLK; E.T = T1; E.O = MRG; run_gemm(lds3, OG, (const bf16_t*)(ws + OFF_WDNO), 1024, 1024, E, p.rep_gemm); }
    side_transposes(p, shm, wave, lane, 2, 96);
    xcd_barrier(xb);
    { pg8::EpiPartial E; E.P = PART; run_gemm(lds3, MRG, (const bf16_t*)(ws + OFF_WO), 1024, 1024, E, p.rep_gemm, 2); }
    xcd_barrier(xb);
#pragma unroll 1
    for (int rep = 0; rep < p.rep_thin; ++rep) phase_norm<2>(p, X1, X0, p.norm_ffn2, 6, AM, wave, lane, PART, 5, 1.0f);
    xcd_barrier(xb);
    { pg8::EpiSwiglu E; E.H = HB; run_gemm(lds3, AM, (const bf16_t*)(ws + OFF_WGU), 5632, 1024, E, p.rep_gemm); }
    xcd_barrier(xb);
    { pg8::EpiPartial E; E.P = PART; run_gemm(lds3, HB, (const bf16_t*)(ws + OFF_WD), 1024, FFH, E, p.rep_gemm, 2); }
    xcd_barrier(xb);
#pragma unroll 1
    for (int rep = 0; rep < p.rep_sync; ++rep) grid.sync();
    phase_final_norm(p, X0, PART, p.out, wave, lane);
}

extern "C" void kernel_launch(void* const* d_in, const int* in_sizes, int n_in, void* d_out, int out_size, void* d_ws, size_t ws_size, hipStream_t stream) {
    static int grid_blocks = 0;
    if (grid_blocks == 0) {
        if (n_in != 27 || ws_size < WS_NEED) { fprintf(stderr, "kernel_launch: unexpected n_in %d / ws %zu\n", n_in, ws_size); grid_blocks = -1; return; }
        int dev = 0, cus = 0, per_cu = 0;
        hipGetDevice(&dev); hipDeviceGetAttribute(&cus, hipDeviceAttributeMultiprocessorCount, dev);
        hipFuncSetAttribute((const void*)fwd_megakernel, hipFuncAttributeMaxDynamicSharedMemorySize, LDS_BYTES);
        hipOccupancyMaxActiveBlocksPerMultiprocessor(&per_cu, (const void*)fwd_megakernel, 512, LDS_BYTES);
        if (per_cu < 1) { fprintf(stderr, "kernel_launch: occupancy query says %d blocks/CU\n", per_cu); per_cu = 1; }
        (void)hipGetLastError();
        grid_blocks = cus;
    }
    if (grid_blocks < 0) return;
    Params p{};
    const float** f = (const float**)&p;
    for (int i = 0; i < 27; ++i) f[i] = (const float*)d_in[i];
    p.out = (float*)d_out; p.ws = (unsigned char*)d_ws; p.rep_prep = REP_PREP; p.rep_gemm = REP_GEMM; p.rep_dnpre = REP_DNPRE; p.rep_scan = REP_SCAN; p.rep_thin = REP_THIN; p.rep_sync = REP_SYNC;
    (void)hipMemsetAsync((unsigned char*)d_ws + OFF_BAR, 0, XCD_BAR_WORDS * sizeof(unsigned), stream);
    void* args[] = {&p};
    hipError_t e = hipLaunchCooperativeKernel((const void*)fwd_megakernel, dim3(grid_blocks), dim3(512), args, LDS_BYTES, stream);
    if (e != hipSuccess) fprintf(stderr, "cooperative launch failed: %s (grid %d)\n", hipGetErrorString(e), grid_blocks);
}
```

```cpp
#include <hip/hip_runtime.h>
#include <hip/hip_cooperative_groups.h>
#include <cstdio>
#include <cstdint>
namespace cg = cooperative_groups;
#define REP_PREP 1
#define REP_GEMM 1
#define REP_DNPRE 1
#define REP_SCAN 1
#define REP_THIN 1
#define REP_SYNC 0
namespace pg8 {
#define PG8_LAS __attribute__((address_space(3)))
typedef unsigned short bf16_t;
typedef short bf16x8 __attribute__((ext_vector_type(8)));
typedef float f32x4 __attribute__((ext_vector_type(4)));
typedef unsigned u32x4 __attribute__((ext_vector_type(4)));
constexpr int BM = 256, BK = 64, HALF = 128, HTB = HALF * BK * 2  , STAGE_BYTES = 8 * HTB, NXCD = 8, WGM = 8;

__host__ __device__ __forceinline__ int lds_byte(int r, int c) { const int st = (r >> 4) * 2 + (c >> 5), rr = r & 15, cc = c & 31, ob = rr * 64 + cc * 2; return st * 1024 + (ob ^ (((ob >> 9) & 1) << 5)); }
__host__ __device__ __forceinline__ void stage_rc(int b, int& R, int& C) { const int st = b / 1024, sb = b % 1024, swz = sb ^ (((sb >> 9) & 1) << 5); R = (st >> 1) * 16 + swz / 64; C = (st & 1) * 32 + (swz % 64) / 2; }
__host__ __device__ __forceinline__ int perm32(int rho) { const int n = rho >> 4, i = rho & 15; return 8 * (i >> 2) + 4 * n + (i & 3); }

struct Unit { int pm, pn; };
struct Gemm { const bf16_t* A; const bf16_t* Bt; int M, N, K; int klen, nsp; };

struct StaticOrder {
    int nM, nN, nwg, G, c;
    __host__ __device__ void init(int M, int N, int G_, int c_) { nM = M / BM; nN = N / BM; nwg = nM * nN; G = G_; c = c_; }
    __host__ __device__ bool next(int i, Unit& u) const {
        const long L = (long)i * G + c; if (L >= nwg) return false;
        int wgid = (int)L; { const int q = nwg / NXCD, r = nwg % NXCD, xcd = wgid % NXCD, off = wgid / NXCD; wgid = (xcd < r ? xcd * (q + 1) : r * (q + 1) + (xcd - r) * q) + off; }
        const int nig = WGM * nN, gid = wgid / nig, fm = gid * WGM, gsz = (nM - fm) < WGM ? (nM - fm) : WGM;
        u.pm = fm + ((wgid % nig) % gsz); u.pn = (wgid % nig) / gsz; return true;
    }
    __device__ __forceinline__ void a_ready(const Unit&) const {}
    __device__ __forceinline__ void done(const Unit&) const {}
};
__device__ __forceinline__ unsigned pk2bf(float a, float b) { typedef float f2v __attribute__((ext_vector_type(2))); typedef __bf16 b2v __attribute__((ext_vector_type(2))); f2v v = {a, b}; b2v r = __builtin_convertvector(v, b2v); return __builtin_bit_cast(unsigned, r); }
__device__ __forceinline__ float bflo(unsigned u) { return __uint_as_float(u << 16); }
__device__ __forceinline__ float bfhi(unsigned u) { return __uint_as_float(u & 0xffff0000u); }
__device__ __forceinline__ float sigmf(float x) { return __builtin_amdgcn_rcpf(1.f + __expf(-x)); }
__device__ __forceinline__ float siluf(float x) { return x * sigmf(x); }
__device__ __forceinline__ int cond_of_tile(int pm) { return pm < 16 ? 0 : 1 + ((pm - 16) >> 2); }
constexpr int NTOK = 6144, DM = 1024, FFH = 2816, NMOD = 9216;
typedef unsigned u32x2 __attribute__((ext_vector_type(2)));

struct EpiSwiglu {
    static constexpr bool PERM = true, AFTER_DRAIN = false;
    bf16_t* H;
    __device__ __forceinline__ void operator()(const f32x4 (&acc)[2][2][4][2], const Unit& u, int wr, int wc, int fr, int fq) const {
        const int row0 = u.pm * BM + wr * 64 + fr, col0 = u.pn * 128 + wc * 32 + 8 * fq;
#pragma unroll
        for (int ai = 0; ai < 2; ++ai)
#pragma unroll
            for (int m = 0; m < 4; ++m) { bf16_t* rowp = H + (size_t)(row0 + ai * HALF + m * 16) * FFH + col0;
                const f32x4 g0 = acc[ai][0][m][0], u0 = acc[ai][1][m][0], g1 = acc[ai][0][m][1], u1 = acc[ai][1][m][1];
                u32x4 o; o.x = pk2bf(siluf(g0[0]) * u0[0], siluf(g0[1]) * u0[1]); o.y = pk2bf(siluf(g0[2]) * u0[2], siluf(g0[3]) * u0[3]);
                o.z = pk2bf(siluf(g1[0]) * u1[0], siluf(g1[1]) * u1[1]); o.w = pk2bf(siluf(g1[2]) * u1[2], siluf(g1[3]) * u1[3]);
                *(u32x4*)rowp = o; }
    }
};
struct EpiResid {
    static constexpr bool PERM = false, AFTER_DRAIN = false;
    const float* Xin; float* Xout; const float* gate; float scale;
    __device__ __forceinline__ void operator()(const f32x4 (&acc)[2][2][4][2], const Unit& u, int wr, int wc, int fr, int fq) const {
        const int row0 = u.pm * BM + wr * 64 + fr, col0 = u.pn * BM + wc * 32 + 4 * fq;
        const float* gp = gate + (size_t)cond_of_tile(u.pm) * NMOD + col0;
        f32x4 gv[2][2];
#pragma unroll
        for (int bj = 0; bj < 2; ++bj)
#pragma unroll
            for (int n = 0; n < 2; ++n) gv[bj][n] = *(const f32x4*)(gp + bj * HALF + n * 16) * scale;
#pragma unroll
        for (int ai = 0; ai < 2; ++ai)
#pragma unroll
            for (int m = 0; m < 4; ++m) { const size_t off = (size_t)(row0 + ai * HALF + m * 16) * DM + col0;
#pragma unroll
                for (int bj = 0; bj < 2; ++bj)
#pragma unroll
                    for (int n = 0; n < 2; ++n) { const f32x4 x = *(const f32x4*)(Xin + off + bj * HALF + n * 16);
                        *(f32x4*)(Xout + off + bj * HALF + n * 16) = x + gv[bj][n] * acc[ai][bj][m][n]; } }
    }
};
struct EpiProj {
    static constexpr bool PERM = true, AFTER_DRAIN = false;
    bf16_t* P; float* EX;
    __device__ __forceinline__ void operator()(const f32x4 (&acc)[2][2][4][2], const Unit& u, int wr, int wc, int fr, int fq) const {
        const int row0 = u.pm * BM + wr * 64 + fr;
        if (u.pn < 36) {
            bf16_t* base = P + (size_t)(u.pn >> 2) * NTOK * DM; const int col0 = (u.pn & 3) * 256 + wc * 32 + 8 * fq;
#pragma unroll
            for (int ai = 0; ai < 2; ++ai)
#pragma unroll
                for (int m = 0; m < 4; ++m) { bf16_t* rowp = base + (size_t)(row0 + ai * HALF + m * 16) * DM + col0;
#pragma unroll
                    for (int bj = 0; bj < 2; ++bj) { const f32x4 v0 = acc[ai][bj][m][0], v1 = acc[ai][bj][m][1];
                        u32x4 o; o.x = pk2bf(v0[0], v0[1]); o.y = pk2bf(v0[2], v0[3]); o.z = pk2bf(v1[0], v1[1]); o.w = pk2bf(v1[2], v1[3]); *(u32x4*)(rowp + bj * HALF) = o; } }
        } else if (wc == 0) {
#pragma unroll
            for (int ai = 0; ai < 2; ++ai)
#pragma unroll
                for (int m = 0; m < 4; ++m)
#pragma unroll
                    for (int n = 0; n < 2; ++n) *(f32x4*)(EX + (size_t)(row0 + ai * HALF + m * 16) * 32 + 8 * fq + 4 * n) = acc[ai][0][m][n];
        }
    }
};
struct EpiPartial {
    static constexpr bool PERM = true, AFTER_DRAIN = false;
    bf16_t* P;
    __device__ __forceinline__ void operator()(const f32x4 (&acc)[2][2][4][2], const Unit& u, int wr, int wc, int fr, int fq) const {
        const int kh = u.pn >> 2, pn = u.pn & 3;
        const int row0 = u.pm * BM + wr * 64 + fr, col0 = pn * BM + wc * 32 + 8 * fq;
        bf16_t* base = P + (size_t)kh * NTOK * DM;
#pragma unroll
        for (int ai = 0; ai < 2; ++ai)
#pragma unroll
            for (int m = 0; m < 4; ++m) { bf16_t* rowp = base + (size_t)(row0 + ai * HALF + m * 16) * DM + col0;
#pragma unroll
                for (int bj = 0; bj < 2; ++bj) { const f32x4 v0 = acc[ai][bj][m][0], v1 = acc[ai][bj][m][1];
                    u32x4 o; o.x = pk2bf(v0[0], v0[1]); o.y = pk2bf(v0[2], v0[3]); o.z = pk2bf(v1[0], v1[1]); o.w = pk2bf(v1[2], v1[3]); *(u32x4*)(rowp + bj * HALF) = o; } }
    }
};
template <int SECOND> struct EpiGate {
    static constexpr bool PERM = false, AFTER_DRAIN = false;
    const bf16_t* G; float* T; bf16_t* O;
    __device__ __forceinline__ void operator()(const f32x4 (&acc)[2][2][4][2], const Unit& u, int wr, int wc, int fr, int fq) const {
        const int row0 = u.pm * BM + wr * 64 + fr, col0 = u.pn * BM + wc * 32 + 4 * fq;
#pragma unroll
        for (int ai = 0; ai < 2; ++ai)
#pragma unroll
            for (int m = 0; m < 4; ++m) { const size_t off = (size_t)(row0 + ai * HALF + m * 16) * DM + col0;
#pragma unroll
                for (int bj = 0; bj < 2; ++bj)
#pragma unroll
                    for (int n = 0; n < 2; ++n) { const size_t o = off + bj * HALF + n * 16; const u32x2 gr = *(const u32x2*)(G + o); const f32x4 a = acc[ai][bj][m][n];
                        f32x4 v; v[0] = sigmf(bflo(gr.x)) * a[0]; v[1] = sigmf(bfhi(gr.x)) * a[1]; v[2] = sigmf(bflo(gr.y)) * a[2]; v[3] = sigmf(bfhi(gr.y)) * a[3];
                        if (SECOND == 0) *(f32x4*)(T + o) = v;
                        else { const f32x4 t = *(const f32x4*)(T + o); v = v + t; u32x2 w; w.x = pk2bf(v[0], v[1]); w.y = pk2bf(v[2], v[3]); *(u32x2*)(O + o) = w; } } }
    }
};

template <class Epi, class Sched, bool STAMP = false>
__device__ __forceinline__ void gemm_phase(PG8_LAS unsigned char* lds, const Gemm g, const Sched& S, const Epi& E, unsigned long long* stamps) {
    int tid_l = threadIdx.x; asm volatile("" : "+v"(tid_l));
    const int tid = tid_l, wid = __builtin_amdgcn_readfirstlane(tid >> 6), lane = tid & 63, wr = wid >> 2, wc = wid & 3, fr = lane & 15, fq = lane >> 4;
    const int K = g.K, nt = g.klen / BK;
    int ts_lo = 0, ts_hi = 0, nts = 0; const unsigned long long rt_entry = STAMP ? (unsigned long long)wall_clock64() : 0ull;
#define PG8_STAMP() do { if (STAMP && wid == 0 && nts < 64) { const unsigned long long _c = (unsigned long long)clock64(); \
        ts_lo = (lane == nts) ? (int)(unsigned)_c : ts_lo; ts_hi = (lane == nts) ? (int)(unsigned)(_c >> 32) : ts_hi; ++nts; } } while (0)
    PG8_STAMP();
    unsigned voffA[2], voffB[2];
#pragma unroll
    for (int i = 0; i < 2; ++i) { int R, C; stage_rc(tid * 16 + i * 8192, R, C); const int Rb = Epi::PERM ? ((R & ~31) + perm32(R & 31)) : R;
        voffA[i] = (unsigned)(R * K + C) * 2u; voffB[i] = (unsigned)(Rb * K + C) * 2u; }
    const size_t kstep = (size_t)(BK * 2);
    const size_t hstep = (size_t)HALF * K * 2;
    const size_t tstep = 2 * hstep;
    const unsigned ldsw = (unsigned)wid * 1024u;
    const int aoff = lds_byte(wr * 64 + fr, fq * 8), boff = lds_byte(wc * 32 + fr, fq * 8);
#define PG8_SA(b, h) (((b) * 2 + (h)) * HTB)
#define PG8_SB(b, h) ((4 + (b) * 2 + (h)) * HTB)
#define PG8_STAGE(bufoff, gbase, voff) do { _Pragma("unroll") for (int _i = 0; _i < 2; ++_i) \
        __builtin_amdgcn_global_load_lds((const unsigned*)((const char*)(gbase) + (voff)[_i]), (PG8_LAS unsigned*)(lds + (bufoff) + ldsw + _i * 8192), 16, 0, 0); } while (0)
#define PG8_LDA(dst, b, h) do { _Pragma("unroll") for (int m = 0; m < 4; ++m) _Pragma("unroll") for (int k = 0; k < 2; ++k) dst[m][k] = *(const PG8_LAS bf16x8*)(lds + PG8_SA(b, h) + aoff + m * 2048 + k * 1024); } while (0)
#define PG8_LDB(dst, b, h) do { _Pragma("unroll") for (int n = 0; n < 2; ++n) _Pragma("unroll") for (int k = 0; k < 2; ++k) dst[n][k] = *(const PG8_LAS bf16x8*)(lds + PG8_SB(b, h) + boff + n * 2048 + k * 1024); } while (0)
#define PG8_MMA(ai, bj, At, Bt) do { __builtin_amdgcn_s_setprio(1); _Pragma("unroll") for (int m = 0; m < 4; ++m) _Pragma("unroll") for (int n = 0; n < 2; ++n) _Pragma("unroll") for (int k = 0; k < 2; ++k) \
        acc[ai][bj][m][n] = __builtin_amdgcn_mfma_f32_16x16x32_bf16(Bt[n][k], At[m][k], acc[ai][bj][m][n], 0, 0, 0); __builtin_amdgcn_s_setprio(0); } while (0)
#define PG8_WAIT_V(n) asm volatile("s_waitcnt vmcnt(" #n ")" ::: "memory")
#define PG8_WAIT_L(n) asm volatile("s_waitcnt lgkmcnt(" #n ")" ::: "memory")
#define PG8_BAR __builtin_amdgcn_s_barrier()
#define PG8_SCHED __builtin_amdgcn_sched_barrier(0)
    Unit cur, nxt; int ui = 0;
    if (!S.next(0, cur)) return;
    f32x4 acc[2][2][4][2];
#pragma unroll
    for (int a = 0; a < 2; ++a)
#pragma unroll
        for (int b = 0; b < 2; ++b)
#pragma unroll
            for (int m = 0; m < 4; ++m)
#pragma unroll
                for (int n = 0; n < 2; ++n) acc[a][b][m][n] = (f32x4){0.f, 0.f, 0.f, 0.f};
    bf16x8 At[4][2], B0[2][2], B1[2][2];
    const size_t khb = (size_t)g.klen * 2;
    const char* cA = (const char*)g.A + (size_t)cur.pm * tstep + (cur.pn >= g.nsp ? khb : 0); const char* cB = (const char*)g.Bt + (size_t)(cur.pn >= g.nsp ? cur.pn - g.nsp : cur.pn) * tstep + (cur.pn >= g.nsp ? khb : 0);
    S.a_ready(cur);
    PG8_STAGE(PG8_SB(0, 0), cB, voffB); PG8_STAGE(PG8_SA(0, 0), cA, voffA); PG8_STAGE(PG8_SB(0, 1), cB + hstep, voffB); PG8_STAGE(PG8_SA(0, 1), cA + hstep, voffA);
    if (wr == 1) PG8_BAR;
    PG8_WAIT_V(4); PG8_BAR;
    PG8_STAGE(PG8_SB(1, 0), cB + kstep, voffB); PG8_STAGE(PG8_SA(1, 0), cA + kstep, voffA); PG8_STAGE(PG8_SB(1, 1), cB + hstep + kstep, voffB);
    PG8_WAIT_V(6); PG8_BAR;
    PG8_STAMP();
    for (;;) {
        const bool has_next = S.next(ui + 1, nxt);
        const char* nA = has_next ? (const char*)g.A + (size_t)nxt.pm * tstep + (nxt.pn >= g.nsp ? khb : 0) : cA; const char* nB = has_next ? (const char*)g.Bt + (size_t)(nxt.pn >= g.nsp ? nxt.pn - g.nsp : nxt.pn) * tstep + (nxt.pn >= g.nsp ? khb : 0) : cB;
        for (int t = 0; t < nt; t += 2) {
            const bool last = (t == nt - 2);
            const char* a1 = cA + (size_t)(t + 1) * kstep;
            const char* a2 = last ? nA : cA + (size_t)(t + 2) * kstep; const char* b2 = last ? nB : cB + (size_t)(t + 2) * kstep;
            const char* a3 = a2 + kstep; const char* b3 = b2 + kstep;
            if (last && has_next) S.a_ready(nxt);
            PG8_LDB(B0, 0, 0); PG8_SCHED; PG8_LDA(At, 0, 0); PG8_STAGE(PG8_SA(1, 1), a1 + hstep, voffA);
            PG8_WAIT_L(8); PG8_BAR; PG8_WAIT_L(0); PG8_MMA(0, 0, At, B0); PG8_BAR; PG8_SCHED;
            PG8_LDB(B1, 0, 1); PG8_STAGE(PG8_SB(0, 0), b2, voffB);
            PG8_BAR; PG8_WAIT_L(0); PG8_MMA(0, 1, At, B1); PG8_BAR;
            PG8_LDA(At, 0, 1); PG8_STAGE(PG8_SA(0, 0), a2, voffA);
            PG8_BAR; PG8_WAIT_L(0); PG8_MMA(1, 0, At, B0); PG8_BAR; PG8_SCHED;
            PG8_STAGE(PG8_SB(0, 1), b2 + hstep, voffB);
            PG8_WAIT_V(6); PG8_BAR; PG8_MMA(1, 1, At, B1); PG8_BAR;
            PG8_LDB(B0, 1, 0); PG8_SCHED; PG8_LDA(At, 1, 0); PG8_STAGE(PG8_SA(0, 1), a2 + hstep, voffA);
            PG8_WAIT_L(8); PG8_BAR; PG8_WAIT_L(0); PG8_MMA(0, 0, At, B0); PG8_BAR; PG8_SCHED;
            PG8_LDB(B1, 1, 1); PG8_STAGE(PG8_SB(1, 0), b3, voffB);
            PG8_BAR; PG8_WAIT_L(0); PG8_MMA(0, 1, At, B1); PG8_BAR;
            PG8_LDA(At, 1, 1); PG8_STAGE(PG8_SA(1, 0), a3, voffA);
            PG8_BAR; PG8_WAIT_L(0); PG8_MMA(1, 0, At, B0); PG8_BAR; PG8_SCHED;
            PG8_STAGE(PG8_SB(1, 1), b3 + hstep, voffB);
            PG8_WAIT_V(6); PG8_BAR; PG8_MMA(1, 1, At, B1); PG8_BAR;
        }
        PG8_STAMP();
        if constexpr (!Epi::AFTER_DRAIN) { E(acc, cur, wr, wc, fr, fq); S.done(cur); }
        PG8_STAMP();
        if (!has_next) break;
#pragma unroll
        for (int a = 0; a < 2; ++a)
#pragma unroll
            for (int b = 0; b < 2; ++b)
#pragma unroll
                for (int m = 0; m < 4; ++m)
#pragma unroll
                    for (int n = 0; n < 2; ++n) acc[a][b][m][n] = (f32x4){0.f, 0.f, 0.f, 0.f};
        cur = nxt; cA = nA; cB = nB; ++ui;
    }
    PG8_WAIT_V(0);
    if (wr == 0) PG8_BAR;
    PG8_BAR;
    if constexpr (Epi::AFTER_DRAIN) { E.fused(acc, cur, wr, wc, fr, fq, lds, wid, lane); S.done(cur); }
    PG8_STAMP();
    if (STAMP && wid == 0) { stamps[lane] = lane < nts ? (((unsigned long long)(unsigned)ts_hi << 32) | (unsigned)ts_lo) : 0ull;
        if (lane == 62) stamps[62] = rt_entry; if (lane == 63) stamps[63] = (unsigned long long)wall_clock64(); }
#undef PG8_STAMP
#undef PG8_SA
#undef PG8_SB
#undef PG8_STAGE
#undef PG8_LDA
#undef PG8_LDB
#undef PG8_MMA
#undef PG8_WAIT_V
#undef PG8_WAIT_L
#undef PG8_BAR
#undef PG8_SCHED
}
}
#define XB_TMO      128
#define XB_XCNT(j)  (256  + 64 * (j))
#define XB_XSUB(j)  (1280 + 64 * (j))
#define XB_XGEN(j)  (2304 + 64 * (j))
#define XB_TOP      3328
#define XB_TOPGEN   3392
#define XCD_BAR_WORDS 3456
#define XB_SPIN_CAP (1u << 18)
#define XLAS __attribute__((address_space(3)))

__device__ __forceinline__ unsigned xb_ld(unsigned* p)              { return __hip_atomic_load(p, __ATOMIC_RELAXED, __HIP_MEMORY_SCOPE_AGENT); }
__device__ __forceinline__ unsigned xb_add(unsigned* p, unsigned v) { return __hip_atomic_fetch_add(p, v, __ATOMIC_RELAXED, __HIP_MEMORY_SCOPE_AGENT); }
__device__ __forceinline__ unsigned xb_xcc_id() { return (unsigned)__builtin_amdgcn_s_getreg((3 << 11) | 20) & 0xFu; }
#define XB_SPIN(cond, bar) do { unsigned _sp = 0; while (cond) { __builtin_amdgcn_s_sleep(1); \
    if ((++_sp & 255u) == 0u) { if (xb_ld(&(bar)[XB_TMO])) break; if (_sp > XB_SPIN_CAP) { atomicAdd(&(bar)[XB_TMO], 1u); break; } } } } while (0)

struct XcdBarrier {
    unsigned* bar; unsigned x;
    volatile XLAS unsigned* st;
};

__device__ __forceinline__ XcdBarrier xcd_barrier_post(unsigned* bar, volatile XLAS unsigned* st) {
    XcdBarrier b; b.bar = bar; b.x = xb_xcc_id(); b.st = st;
    if (threadIdx.x == 0) (void)xb_add(&bar[XB_XCNT(b.x)], 1u);
    return b;
}
__device__ __forceinline__ void xcd_barrier_complete(unsigned* bar, unsigned x, unsigned& nloc, unsigned& nx) {
    const unsigned G = gridDim.x * gridDim.y * gridDim.z;
    unsigned sum, cnt, mine, sp = 0u;
    for (;;) {
        sum = 0u; cnt = 0u; mine = 0u;
#pragma unroll
        for (unsigned j = 0; j < 16; ++j) { const unsigned c = xb_ld(&bar[XB_XCNT(j)]); sum += c; cnt += (c > 0u) ? 1u : 0u; mine = (j == x) ? c : mine; }
        if (sum == G) break;
        __builtin_amdgcn_s_sleep(1);
        if ((++sp & 255u) == 0u) { if (xb_ld(&bar[XB_TMO])) break; if (sp > XB_SPIN_CAP) { atomicAdd(&bar[XB_TMO], 1u); break; } }
    }
    nloc = mine > 0u ? mine : 1u; nx = cnt > 0u ? cnt : 1u;
}

__device__ __forceinline__ void xcd_barrier(const XcdBarrier& b) {
    asm volatile("s_waitcnt vmcnt(0)" ::: "memory");
    __syncthreads();
    if (threadIdx.x == 0) {
        unsigned* bar = b.bar;
        __builtin_amdgcn_s_waitcnt(0);
        unsigned nloc = b.st[0], nx = b.st[1];
        if (nloc == 0u) { xcd_barrier_complete(bar, b.x, nloc, nx); b.st[0] = nloc; b.st[1] = nx; }
        const unsigned old = xb_add(&bar[XB_XSUB(b.x)], 1u);
        const unsigned gen = old / nloc;
        if (old + 1u == (gen + 1u) * nloc) {
            __builtin_amdgcn_fence(__ATOMIC_RELEASE, "agent");
            asm volatile("s_waitcnt vmcnt(0)" ::: "memory");
            const unsigned og = xb_add(&bar[XB_TOP], 1u);
            const unsigned tg = og / nx;
            if (og + 1u == (tg + 1u) * nx) xb_add(&bar[XB_TOPGEN], 1u);
            else XB_SPIN(xb_ld(&bar[XB_TOPGEN]) == tg, bar);
            __builtin_amdgcn_fence(__ATOMIC_ACQUIRE, "agent");
            xb_add(&bar[XB_XGEN(b.x)], 1u);
            asm volatile("s_waitcnt vmcnt(0)" ::: "memory");
        } else {
            XB_SPIN(xb_ld(&bar[XB_XGEN(b.x)]) == gen, bar);
            __builtin_amdgcn_fence(__ATOMIC_ACQUIRE, "agent");
            asm volatile("s_waitcnt vmcnt(0)" ::: "memory");
        }
    }
    __syncthreads();
}


using pg8::bf16_t; using pg8::f32x4; using pg8::pk2bf; using pg8::bflo; using pg8::bfhi; using pg8::siluf; using pg8::sigmf; using pg8::u32x2;
using pg8::NTOK; using pg8::DM; using pg8::FFH; using pg8::NMOD;
typedef unsigned v4u __attribute__((ext_vector_type(4)));
#define LDS_WAIT() asm volatile("s_waitcnt lgkmcnt(0)" ::: "memory")
constexpr int NCTX = 4096, NWAVES = 8, LDS_BYTES = 143360;
constexpr size_t MiB = 1048576;
constexpr size_t OFF_WCO = 0, OFF_WDNO = 2 * MiB, OFF_WO = 4 * MiB;
constexpr size_t OFF_WGU = 6 * MiB;
constexpr size_t OFF_WD = 17 * MiB;
constexpr size_t OFF_WIN = 23 * MiB;
constexpr size_t OFF_X0 = 42 * MiB;
constexpr size_t OFF_DN = 6 * MiB;
constexpr size_t OFF_X1 = 114 * MiB;
constexpr size_t OFF_PROJ = 138 * MiB;
constexpr size_t OFF_EX = 246 * MiB;
constexpr size_t OFF_MOD = 247 * MiB;
constexpr size_t OFF_BAR = 247 * MiB + 512 * 1024;
constexpr size_t WS_NEED = 248 * MiB;
constexpr size_t BLK = (size_t)NTOK * DM;

struct Params {
    const float *x_prompt, *x_sample, *st_f, *st_b, *c, *c_ctx, *ada_w, *ada_b, *norm_ffn1, *f1g, *f1u, *f1d, *norm_mix, *w_in, *conv_w, *conv_out_w,
        *dn_conv_w, *dn_a_log, *dn_dt_bias, *dn_norm_w, *dn_out_w, *w_o, *norm_ffn2, *f2g, *f2u, *f2d, *norm_f;
    float* out; unsigned char* ws; int rep_prep, rep_gemm, rep_dnpre, rep_scan, rep_thin, rep_sync;
};

__device__ __forceinline__ float wave_sum(float v) {
#pragma unroll
    for (int o = 1; o < 64; o <<= 1) v += __shfl_xor(v, o);
    return v;
}
__device__ __forceinline__ float sum16(float v) {
#pragma unroll
    for (int o = 1; o < 16; o <<= 1) v += __shfl_xor(v, o);
    return v;
}
__device__ __forceinline__ void transpose_item(const float* W, int N, int k0, int n0, bf16_t* WT, int Kd, int dst_row0, float* scr, int lane) {
#pragma unroll 8
    for (int i = 0; i < 32; ++i) { const int kk = 2 * i + (lane >> 5); scr[kk * 33 + (lane & 31)] = W[(size_t)(k0 + kk) * N + n0 + (lane & 31)]; }
    LDS_WAIT();
    const int c = lane & 7;
#pragma unroll
    for (int j = 0; j < 4; ++j) { const int n = (lane >> 3) + 8 * j; const float* s = scr + (8 * c) * 33 + n;
        v4u o; o.x = pk2bf(s[0 * 33], s[1 * 33]); o.y = pk2bf(s[2 * 33], s[3 * 33]); o.z = pk2bf(s[4 * 33], s[5 * 33]); o.w = pk2bf(s[6 * 33], s[7 * 33]);
        *(v4u*)(WT + (size_t)(dst_row0 + n) * Kd + k0 + 8 * c) = o; }
    LDS_WAIT();
}
__device__ __forceinline__ void transpose_matrix(const float* W, int K, int N, bf16_t* WT, int mode, int gw, int ngw, float* scr, int lane) {
    const int nblk = N / 32, nitems = (K / 64) * nblk;
    for (int it = gw; it < nitems; it += ngw) {
        const int kb = it / nblk, nb = it % nblk, n0 = nb * 32;
        const int dr = mode == 0 ? n0 : ((n0 >> 7) * 256 + (n0 & 127) + (mode == 2 ? 128 : 0));
        transpose_item(W, N, kb * 64, n0, WT, K, dr, scr, lane);
    }
}

__device__ __forceinline__ void phase_prep(const Params& p, unsigned char* lds, int wave, int lane) {
    unsigned char* ws = p.ws;
    float* scr = (float*)lds + wave * (64 * 33);
    const int gw = wave * gridDim.x + blockIdx.x, ngw = gridDim.x * NWAVES;
    transpose_matrix(p.f1g, 1024, FFH, (bf16_t*)(ws + OFF_WGU), 1, gw, ngw, scr, lane);
    transpose_matrix(p.f1u, 1024, FFH, (bf16_t*)(ws + OFF_WGU), 2, gw, ngw, scr, lane);
    __syncthreads();
    float* sc = (float*)lds;
    float* red = (float*)lds + 3072;
    if ((int)blockIdx.x < 144) {
        for (int i = threadIdx.x; i < 3072; i += 512) { const int cc = i >> 10, k = i & 1023; const float v = cc == 0 ? p.c_ctx[k] : p.c[(cc - 1) * 1024 + k]; sc[i] = siluf(v); }
        __syncthreads();
        for (int it = blockIdx.x; it < 144; it += gridDim.x) {
            const int n = it * 64 + lane; float a0 = 0.f, a1 = 0.f, a2 = 0.f;
            const float* wp = p.ada_w + (size_t)(wave * 128) * NMOD + n;
#pragma unroll 8
            for (int k = 0; k < 128; ++k) { const float wv = wp[(size_t)k * NMOD]; const int kk = wave * 128 + k; a0 += sc[kk] * wv; a1 += sc[1024 + kk] * wv; a2 += sc[2048 + kk] * wv; }
            red[(wave * 3 + 0) * 64 + lane] = a0; red[(wave * 3 + 1) * 64 + lane] = a1; red[(wave * 3 + 2) * 64 + lane] = a2;
            __syncthreads();
            if (threadIdx.x < 192) { const int cc = threadIdx.x >> 6, l = threadIdx.x & 63; float s = 0.f;
#pragma unroll
                for (int w = 0; w < 8; ++w) s += red[(w * 3 + cc) * 64 + l];
                ((float*)(ws + OFF_MOD))[cc * NMOD + it * 64 + l] = s + p.ada_b[it * 64 + l]; }
            __syncthreads();
        }
    }
}


__device__ __forceinline__ void side_transposes(const Params& p, unsigned char* lds, int wave, int lane, int which, int b0) {
    if (gridDim.x < 256) b0 = 0;
    const int nb = (int)gridDim.x - b0, bi = (int)blockIdx.x - b0;
    if (bi < 0) return;
    unsigned char* ws = p.ws;
    float* scr = (float*)lds + wave * (64 * 33);
    const int gw = wave * nb + bi, ngw = nb * NWAVES;
    if (which == 0) {
        transpose_matrix(p.f1d, FFH, 1024, (bf16_t*)(ws + OFF_WD), 0, gw, ngw, scr, lane);
    } else if (which == 1) {
        transpose_matrix(p.w_in, 1024, 9248, (bf16_t*)(ws + OFF_WIN), 0, gw, ngw, scr, lane);
        transpose_matrix(p.conv_out_w, 1024, 1024, (bf16_t*)(ws + OFF_WCO), 0, gw, ngw, scr, lane);
        transpose_matrix(p.dn_out_w, 1024, 1024, (bf16_t*)(ws + OFF_WDNO), 0, gw, ngw, scr, lane);
        transpose_matrix(p.w_o, 1024, 1024, (bf16_t*)(ws + OFF_WO), 0, gw, ngw, scr, lane);
        v4u z = {0u, 0u, 0u, 0u}; v4u* zp = (v4u*)((bf16_t*)(ws + OFF_WIN) + (size_t)9248 * 1024);
        const int nz = 224 * 1024 * 2 / 16;
        for (int i = bi * 512 + (int)threadIdx.x; i < nz; i += nb * 512) zp[i] = z;
    } else {
        transpose_matrix(p.f2g, 1024, FFH, (bf16_t*)(ws + OFF_WGU), 1, gw, ngw, scr, lane);
        transpose_matrix(p.f2u, 1024, FFH, (bf16_t*)(ws + OFF_WGU), 2, gw, ngw, scr, lane);
        transpose_matrix(p.f2d, FFH, 1024, (bf16_t*)(ws + OFF_WD), 0, gw, ngw, scr, lane);
    }
    __syncthreads();
}

template <int FIRST> __device__ __forceinline__ void phase_norm(const Params& p, const float* X, float* X0, const float* nw, int modi, bf16_t* A, int wave, int lane, const bf16_t* PART = nullptr, int gatei = 0, float gscale = 0.f) {
    const float* mod = (const float*)(p.ws + OFF_MOD);
    const int gw = wave * gridDim.x + blockIdx.x, ngw = gridDim.x * NWAVES;
    for (int row = gw; row < NTOK; row += ngw) {
        const int cond = row < NCTX ? 0 : 1 + ((row - NCTX) >> 10);
        f32x4 v[4];
        if (FIRST == 1) {
            const float* src = row < NCTX ? p.x_prompt + (size_t)row * DM : p.x_sample + (size_t)(row - NCTX) * DM;
#pragma unroll
            for (int j = 0; j < 4; ++j) v[j] = *(const f32x4*)(src + 4 * lane + 256 * j);
            if (row >= NCTX) {
                const int t = (row - NCTX) & 1023; const float r = (float)(t >> 6), cl = (float)(t & 63);
#pragma unroll
                for (int e = 0; e < 4; ++e) { const int i = 4 * lane + e; const float om = 1.0f / powf(10000.0f, (float)i * (1.0f / 256.0f));
                    v[0][e] += sinf(r * om); v[1][e] += cosf(r * om); v[2][e] += sinf(cl * om); v[3][e] += cosf(cl * om); }
            }
#pragma unroll
            for (int j = 0; j < 4; ++j) *(f32x4*)(X0 + (size_t)row * DM + 4 * lane + 256 * j) = v[j];
        } else if (FIRST == 2) {
            const float* gp = mod + (size_t)cond * NMOD + gatei * 1024;
#pragma unroll
            for (int j = 0; j < 4; ++j) { const size_t o = (size_t)row * DM + 4 * lane + 256 * j;
                const f32x4 x = *(const f32x4*)(X + o), gg = *(const f32x4*)(gp + 4 * lane + 256 * j); const u32x2 q0 = *(const u32x2*)(PART + o), q1 = *(const u32x2*)(PART + BLK + o);
                f32x4 ps; ps[0] = bflo(q0.x) + bflo(q1.x); ps[1] = bfhi(q0.x) + bfhi(q1.x); ps[2] = bflo(q0.y) + bflo(q1.y); ps[3] = bfhi(q0.y) + bfhi(q1.y);
                v[j] = x + (gg * gscale) * ps; *(f32x4*)(X0 + o) = v[j]; }
        } else {
#pragma unroll
            for (int j = 0; j < 4; ++j) v[j] = *(const f32x4*)(X + (size_t)row * DM + 4 * lane + 256 * j);
        }
        float ss = 0.f;
#pragma unroll
        for (int j = 0; j < 4; ++j) ss += v[j][0] * v[j][0] + v[j][1] * v[j][1] + v[j][2] * v[j][2] + v[j][3] * v[j][3];
        const float rstd = rsqrtf(wave_sum(ss) * (1.0f / 1024.0f) + 1e-6f);
        const float* sh = mod + (size_t)cond * NMOD + modi * 1024; const float* scp = sh + 1024;
#pragma unroll
        for (int j = 0; j < 4; ++j) { const int d = 4 * lane + 256 * j; const f32x4 w = *(const f32x4*)(nw + d), s1 = *(const f32x4*)(scp + d), s0 = *(const f32x4*)(sh + d);
            f32x4 y;
#pragma unroll
            for (int e = 0; e < 4; ++e) y[e] = v[j][e] * rstd * w[e] * (1.f + s1[e]) + s0[e];
            u32x2 o; o.x = pk2bf(y[0], y[1]); o.y = pk2bf(y[2], y[3]); *(u32x2*)(A + (size_t)row * DM + d) = o; }
    }
}
__device__ __forceinline__ void phase_final_norm(const Params& p, const float* X, const bf16_t* PART, float* Y, int wave, int lane) {
    const float* mod = (const float*)(p.ws + OFF_MOD);
    const int gw = wave * gridDim.x + blockIdx.x, ngw = gridDim.x * NWAVES;
    for (int row = gw; row < NTOK; row += ngw) {
        f32x4 v[4]; float ss = 0.f;
#pragma unroll
        for (int j = 0; j < 4; ++j) { const size_t o = (size_t)row * DM + 4 * lane + 256 * j; const int cond = row < NCTX ? 0 : 1 + ((row - NCTX) >> 10);
            const f32x4 x = *(const f32x4*)(X + o), gg = *(const f32x4*)(mod + (size_t)cond * NMOD + 8 * 1024 + 4 * lane + 256 * j); const u32x2 q0 = *(const u32x2*)(PART + o), q1 = *(const u32x2*)(PART + BLK + o);
            f32x4 ps; ps[0] = bflo(q0.x) + bflo(q1.x); ps[1] = bfhi(q0.x) + bfhi(q1.x); ps[2] = bflo(q0.y) + bflo(q1.y); ps[3] = bfhi(q0.y) + bfhi(q1.y);
            v[j] = x + (gg * 0.5f) * ps; ss += v[j][0] * v[j][0] + v[j][1] * v[j][1] + v[j][2] * v[j][2] + v[j][3] * v[j][3]; }
        const float rstd = rsqrtf(wave_sum(ss) * (1.0f / 1024.0f) + 1e-6f);
#pragma unroll
        for (int j = 0; j < 4; ++j) { const f32x4 w = *(const f32x4*)(p.norm_f + 4 * lane + 256 * j); *(f32x4*)(Y + (size_t)row * DM + 4 * lane + 256 * j) = v[j] * rstd * w; }
    }
}

__device__ __forceinline__ void unpack8(const v4u r, float (&f)[8]) { f[0] = bflo(r.x); f[1] = bfhi(r.x); f[2] = bflo(r.y); f[3] = bfhi(r.y); f[4] = bflo(r.z); f[5] = bfhi(r.z); f[6] = bflo(r.w); f[7] = bfhi(r.w); }
__device__ __forceinline__ void load8f(const float* p, float (&f)[8]) { const f32x4 a = *(const f32x4*)p, b = *(const f32x4*)(p + 4); f[0] = a[0]; f[1] = a[1]; f[2] = a[2]; f[3] = a[3]; f[4] = b[0]; f[5] = b[1]; f[6] = b[2]; f[7] = b[3]; }
__device__ __forceinline__ void phase_qkv_naive(const Params& p, const bf16_t* PROJ, const float* EX, float* QF, float* KF, float* VF, float* BG, bf16_t* YA, int wave, int lane) {
    const int gw = wave * gridDim.x + blockIdx.x, ngw = gridDim.x * NWAVES;
    const v4u zero4 = {0u, 0u, 0u, 0u};
    for (int tok = gw; tok < NTOK; tok += ngw) {
        const int pos = tok < NCTX ? (tok & 255) : ((tok - NCTX) & 63); const int L = tok < NCTX ? 256 : 64;
        const bool hasL = pos != 0, hasR = pos != L - 1;
#pragma unroll 1
        for (int grp = 0; grp < 6; ++grp) {
            const int part = grp >> 1, ch0 = (grp & 1) * 512 + lane * 8;
            const bf16_t* src = PROJ + (size_t)(3 + part) * BLK + (size_t)tok * DM + ch0;
            float c[8], l[8], r[8], w0[8], w1[8], w2[8], y[8];
            unpack8(*(const v4u*)src, c); unpack8(hasL ? *(const v4u*)(src - DM) : zero4, l); unpack8(hasR ? *(const v4u*)(src + DM) : zero4, r);
            const float* cw = p.dn_conv_w + part * 1024 + ch0;
            load8f(cw, w0); load8f(cw + 3072, w1); load8f(cw + 6144, w2);
            float ss = 0.f;
#pragma unroll
            for (int e = 0; e < 8; ++e) { y[e] = siluf(w0[e] * l[e] + w1[e] * c[e] + w2[e] * r[e]); ss += y[e] * y[e]; }
            if (part < 2) { const float sc = rsqrtf(sum16(ss) + 1e-6f) * (part == 0 ? 0.08838834764831845f : 1.0f);
#pragma unroll
                for (int e = 0; e < 8; ++e) y[e] *= sc; }
            float* dst = (part == 0 ? QF : part == 1 ? KF : VF) + (size_t)tok * DM + ch0;
            f32x4 o0 = {y[0], y[1], y[2], y[3]}, o1 = {y[4], y[5], y[6], y[7]};
            *(f32x4*)dst = o0; *(f32x4*)(dst + 4) = o1;
        }
#pragma unroll 1
        for (int grp = 0; grp < 2; ++grp) {
            const int ch0 = grp * 512 + lane * 8; const size_t o = (size_t)tok * DM + ch0;
            float bg[8], cc[8], cl[8], cr[8], xc[8], xl[8], xr[8], w0[8], w1[8], w2[8];
            unpack8(*(const v4u*)(PROJ + o), bg);
            unpack8(*(const v4u*)(PROJ + BLK + o), cc); unpack8(hasL ? *(const v4u*)(PROJ + BLK + o - DM) : zero4, cl); unpack8(hasR ? *(const v4u*)(PROJ + BLK + o + DM) : zero4, cr);
            unpack8(*(const v4u*)(PROJ + 2 * BLK + o), xc); unpack8(hasL ? *(const v4u*)(PROJ + 2 * BLK + o - DM) : zero4, xl); unpack8(hasR ? *(const v4u*)(PROJ + 2 * BLK + o + DM) : zero4, xr);
            load8f(p.conv_w + ch0, w0); load8f(p.conv_w + 1024 + ch0, w1); load8f(p.conv_w + 2048 + ch0, w2);
            float y[8];
#pragma unroll
            for (int e = 0; e < 8; ++e) y[e] = bg[e] * (w0[e] * cl[e] * xl[e] + w1[e] * cc[e] * xc[e] + w2[e] * cr[e] * xr[e]);
            v4u ov; ov.x = pk2bf(y[0], y[1]); ov.y = pk2bf(y[2], y[3]); ov.z = pk2bf(y[4], y[5]); ov.w = pk2bf(y[6], y[7]);
            *(v4u*)(YA + o) = ov;
        }
        if (lane < 16) {
            const float b_raw = EX[(size_t)tok * 32 + lane], a_raw = EX[(size_t)tok * 32 + 16 + lane];
            const float xx = a_raw + p.dn_dt_bias[lane]; const float sp = xx > 20.f ? xx : log1pf(expf(xx));
            BG[(size_t)tok * 32 + lane] = 1.f / (1.f + expf(-b_raw));
            BG[(size_t)tok * 32 + 16 + lane] = -expf(p.dn_a_log[lane]) * sp;
        }
    }
}

__device__ __forceinline__ void dn_naive_item(const Params& p, const float* QF, const float* KF, const float* VF, const float* BG, float* OF, float* OBk, float* lds, int item) {
    const bool lat = item < 32; const int j = lat ? item : item - 32; const int b = j >> 4, h = (j >> 1) & 7, dir = j & 1;
    const int T = lat ? 1024 : 256; const int tok0 = lat ? NCTX + b * 1024 : b * 256;
    const int tid = threadIdx.x, v = tid & 127, kq = tid >> 7;
    float* qs = lds; float* ks = lds + 128; float* vs = lds + 256; float* gb = lds + 384; float* red = lds + 512; float* red2 = lds + 1024;
    float S[32];
    if (lat) { const float* s0 = (dir ? p.st_b : p.st_f) + ((size_t)(b * 8 + h) * 128) * 128;
#pragma unroll
        for (int i = 0; i < 32; ++i) S[i] = s0[(size_t)(kq * 32 + i) * 128 + v]; }
    else {
#pragma unroll
        for (int i = 0; i < 32; ++i) S[i] = 0.f; }
    float* Od = dir ? OBk : OF;
    for (int t = 0; t < T; ++t) {
        const int tok = tok0 + (dir ? T - 1 - t : t);
        __syncthreads();
        if (tid < 128) qs[tid] = QF[(size_t)tok * DM + h * 128 + tid];
        else if (tid < 256) ks[tid - 128] = KF[(size_t)tok * DM + h * 128 + tid - 128];
        else if (tid < 384) vs[tid - 256] = VF[(size_t)tok * DM + h * 128 + tid - 256];
        else if (tid == 384) gb[0] = BG[(size_t)tok * 32 + dir * 8 + h];
        else if (tid == 385) gb[1] = BG[(size_t)tok * 32 + 16 + dir * 8 + h];
        __syncthreads();
        float part = 0.f;
#pragma unroll
        for (int i = 0; i < 32; ++i) part += ks[kq * 32 + i] * S[i];
        red[kq * 128 + v] = part;
        __syncthreads();
        const float kS = red[v] + red[128 + v] + red[256 + v] + red[384 + v];
        const float eg = expf(gb[1]), beta = gb[0];
        const float delta = beta * (vs[v] - eg * kS);
        float op = 0.f;
#pragma unroll
        for (int i = 0; i < 32; ++i) { S[i] = eg * S[i] + ks[kq * 32 + i] * delta; op += qs[kq * 32 + i] * S[i]; }
        red2[kq * 128 + v] = op;
        __syncthreads();
        if (kq == 0) Od[(size_t)tok * DM + h * 128 + v] = red2[v] + red2[128 + v] + red2[256 + v] + red2[384 + v];
    }
    if (!lat) { float* so = p.out + (size_t)NTOK * DM + (size_t)dir * (16 * 8 * 128 * 128) + ((size_t)(b * 8 + h) * 128) * 128;
#pragma unroll
        for (int i = 0; i < 32; ++i) so[(size_t)(kq * 32 + i) * 128 + v] = S[i]; }
}
__device__ __forceinline__ void phase_dn_naive(const Params& p, const float* QF, const float* KF, const float* VF, const float* BG, float* OF, float* OBk, float* lds) {
    const int bx = blockIdx.x;
    if (gridDim.x >= 256) {
        if (bx < 32) dn_naive_item(p, QF, KF, VF, BG, OF, OBk, lds, bx);
        else if (bx < 256) { dn_naive_item(p, QF, KF, VF, BG, OF, OBk, lds, bx); if (bx < 64) dn_naive_item(p, QF, KF, VF, BG, OF, OBk, lds, 224 + bx); }
    } else { for (int it = bx; it < 288; it += gridDim.x) dn_naive_item(p, QF, KF, VF, BG, OF, OBk, lds, it); }
}

typedef short bf16x8 __attribute__((ext_vector_type(8)));
typedef float f32x16 __attribute__((ext_vector_type(16)));
#define MFMA32(a, b, c) __builtin_amdgcn_mfma_f32_32x32x16_bf16((a), (b), (c), 0, 0, 0)
constexpr int DN_ITEM_BYTES = 73728, DN_W = 0, DN_QD = 16384, DN_KD = 32768, DN_A = 49152, DN_U = 57344;
constexpr int LS = 132;
constexpr int LMS = 68, LMD = 64 * LMS;
constexpr int L_QF = 0, L_KF = 33792, L_VF = 67584, L_LM = 101376, L_CO = 136192;
__device__ __forceinline__ int crow16(int i, int hh) { return (i & 3) + 8 * (i >> 2) + 4 * hh; }
__device__ __forceinline__ bf16x8 frag_from_f32(const float* p) { const f32x4 a = *(const f32x4*)p, b = *(const f32x4*)(p + 4);
    v4u r; r.x = pk2bf(a[0], a[1]); r.y = pk2bf(a[2], a[3]); r.z = pk2bf(b[0], b[1]); r.w = pk2bf(b[2], b[3]); return __builtin_bit_cast(bf16x8, r); }
template <int S> __device__ __forceinline__ bf16x8 pack_step(const f32x16& x) {
    v4u r; r.x = pk2bf(x[8 * S + 0], x[8 * S + 1]); r.y = pk2bf(x[8 * S + 2], x[8 * S + 3]); r.z = pk2bf(x[8 * S + 4], x[8 * S + 5]); r.w = pk2bf(x[8 * S + 6], x[8 * S + 7]); return __builtin_bit_cast(bf16x8, r); }

__device__ __forceinline__ void split_hi_lo(const float* p, bf16x8& hi, bf16x8& lo) {
    const f32x4 a = *(const f32x4*)p, b = *(const f32x4*)(p + 4);
    v4u h; h.x = pk2bf(a[0], a[1]); h.y = pk2bf(a[2], a[3]); h.z = pk2bf(b[0], b[1]); h.w = pk2bf(b[2], b[3]);
    v4u l; l.x = pk2bf(a[0] - bflo(h.x), a[1] - bfhi(h.x)); l.y = pk2bf(a[2] - bflo(h.y), a[3] - bfhi(h.y)); l.z = pk2bf(b[0] - bflo(h.z), b[1] - bfhi(h.z)); l.w = pk2bf(b[2] - bflo(h.w), b[3] - bfhi(h.w));
    hi = __builtin_bit_cast(bf16x8, h); lo = __builtin_bit_cast(bf16x8, l);
}
__device__ __forceinline__ void dn_pre_item(const Params& p, const bf16_t* PROJ, const float* EX, unsigned char* DN, float* GL, unsigned char* lds, int sc, int h) {
    int tid_l = threadIdx.x; asm volatile("" : "+v"(tid_l));
    const int tid = tid_l, lane = tid & 63, wave = tid >> 6;
    const bool ctx = sc < 64; const int nn = ctx ? (sc & 3) : ((sc - 64) & 15);
    const int tok0 = ctx ? (sc >> 2) * 256 + 64 * nn : NCTX + ((sc - 64) >> 4) * 1024 + 64 * nn;
    float* QFl = (float*)(lds + L_QF); float* KFl = (float*)(lds + L_KF); float* VFl = (float*)(lds + L_VF); float* LM = (float*)(lds + L_LM);
    float* CB = (float*)(lds + L_CO);
    float* CG = CB + 128;
    float* CW = CB + 256;
    float* CE = CB + 384;
    float* CK = CB + 512;
    const v4u zero4 = {0u, 0u, 0u, 0u};
    unsigned char* item0 = DN + (size_t)((sc * 8 + h) * 2) * DN_ITEM_BYTES;
#pragma unroll 2
    for (int jj = 0; jj < 6; ++jj) {
        const int pr = tid + 512 * jj, c = pr / 48, cg = pr % 48, part = cg >> 4, d0 = (cg & 15) * 8;
        const bool hasL = c > 0 || (ctx && nn > 0), hasR = c < 63 || (ctx && nn < 3);
        const bf16_t* src = PROJ + (size_t)(3 + part) * BLK + (size_t)(tok0 + c) * DM + h * 128 + d0;
        float cc[8], l[8], r[8], w0[8], w1[8], w2[8], y[8];
        unpack8(*(const v4u*)src, cc); unpack8(hasL ? *(const v4u*)(src - DM) : zero4, l); unpack8(hasR ? *(const v4u*)(src + DM) : zero4, r);
        const float* cw = p.dn_conv_w + part * 1024 + h * 128 + d0;
        load8f(cw, w0); load8f(cw + 3072, w1); load8f(cw + 6144, w2);
        float ss = 0.f;
#pragma unroll
        for (int e = 0; e < 8; ++e) { y[e] = siluf(w0[e] * l[e] + w1[e] * cc[e] + w2[e] * r[e]); ss += y[e] * y[e]; }
        const float tot = sum16(ss);
        if (part < 2) { const float scl = rsqrtf(tot + 1e-6f) * (part == 0 ? 0.08838834764831845f : 1.0f);
#pragma unroll
            for (int e = 0; e < 8; ++e) y[e] *= scl; }
        float* dst = (part == 0 ? QFl : part == 1 ? KFl : VFl) + c * LS + d0;
        f32x4 o0 = {y[0], y[1], y[2], y[3]}, o1 = {y[4], y[5], y[6], y[7]};
        *(f32x4*)dst = o0; *(f32x4*)(dst + 4) = o1;
    }
    if (wave < 2) {
        const int d = wave, oc = d ? 63 - lane : lane; const size_t tk = (size_t)(tok0 + oc) * 32;
        const float b_raw = EX[tk + d * 8 + h], a_raw = EX[tk + 16 + d * 8 + h];
        const float xx = a_raw + p.dn_dt_bias[d * 8 + h]; const float sp = xx > 20.f ? xx : log1pf(expf(xx));
        const float beta = 1.f / (1.f + expf(-b_raw)); float g = -expf(p.dn_a_log[d * 8 + h]) * sp;
#pragma unroll
        for (int o = 1; o < 64; o <<= 1) { const float t = __shfl_up(g, o); if (lane >= o) g += t; }
        const float glast = __shfl(g, 63); const float eg = expf(g);
        CB[d * 64 + lane] = beta; CG[d * 64 + lane] = g; CW[d * 64 + lane] = beta * eg; CE[d * 64 + lane] = eg; CK[d * 64 + lane] = expf(glast - g);
        if (lane == 0) GL[(sc * 8 + h) * 2 + d] = expf(glast);
    }
    __syncthreads();
    const int dir = wave >> 2;
    unsigned char* item = item0 + (size_t)dir * DN_ITEM_BYTES;
    {
        const int w4 = wave & 3, mt = w4 >> 1, nt = w4 & 1, r = lane & 31, hh = lane >> 5;
        const int ia = 32 * mt + r, ib = 32 * nt + r; const int ca = dir ? 63 - ia : ia, cb = dir ? 63 - ib : ib;
        f32x16 kk, pp;
#pragma unroll
        for (int i = 0; i < 16; ++i) { kk[i] = 0.f; pp[i] = 0.f; }
#pragma unroll
        for (int ks = 0; ks < 8; ++ks) {
            const bf16x8 ka = frag_from_f32(KFl + ca * LS + 16 * ks + 8 * hh), kb = frag_from_f32(KFl + cb * LS + 16 * ks + 8 * hh), qb = frag_from_f32(QFl + cb * LS + 16 * ks + 8 * hh);
            kk = MFMA32(ka, kb, kk); pp = MFMA32(ka, qb, pp);
        }
        const float* gcd = CG + dir * 64; const float* btd = CB + dir * 64;
        const float g_col = gcd[ib];
        f32x16 pv;
#pragma unroll
        for (int i = 0; i < 16; ++i) {
            const int row = 32 * mt + crow16(i, hh); const float g_row = gcd[row];
            LM[dir * LMD + row * LMS + ib] = (ib < row) ? btd[row] * kk[i] * expf(g_row - g_col) : 0.f;
            pv[i] = (row <= ib) ? pp[i] * expf(g_col - g_row) : 0.f;
        }
        v4u* af = (v4u*)(item + DN_A);
        af[(nt * 4 + mt * 2 + 0) * 64 + lane] = __builtin_bit_cast(v4u, pack_step<0>(pv));
        af[(nt * 4 + mt * 2 + 1) * 64 + lane] = __builtin_bit_cast(v4u, pack_step<1>(pv));
    }
    __syncthreads();
    float x[64];
    if (wave < 2) {
        const float* Lm = LM + wave * LMD;
#pragma unroll
        for (int c = 0; c < 64; ++c) {
            float acc = (c == lane) ? 1.f : 0.f;
#pragma unroll
            for (int s = 0; s < c; ++s) acc -= Lm[c * LMS + s] * x[s];
            x[c] = acc;
        }
    } else {
#pragma unroll 1
        for (int idx = tid - 128; idx < 4096; idx += 384) {
            const int d = idx >> 11, kd = (idx >> 10) & 1, f = (idx >> 6) & 15, ln = idx & 63, r = ln & 31, hh = ln >> 5;
            unsigned char* itd = item0 + (size_t)d * DN_ITEM_BYTES;
            if (kd == 0) {
                const int mt = f >> 3, ks8 = f & 7, cp = 32 * mt + r, oc = d ? 63 - cp : cp, dkb = 16 * ks8 + 4 * hh;
                const f32x4 qa = *(const f32x4*)(QFl + oc * LS + dkb), qb = *(const f32x4*)(QFl + oc * LS + dkb + 8); const float e = CE[d * 64 + cp];
                v4u qv; qv.x = pk2bf(qa[0] * e, qa[1] * e); qv.y = pk2bf(qa[2] * e, qa[3] * e); qv.z = pk2bf(qb[0] * e, qb[1] * e); qv.w = pk2bf(qb[2] * e, qb[3] * e);
                ((v4u*)(itd + DN_QD))[f * 64 + ln] = qv;
            } else {
                const int mtK = f >> 2, kst = f & 3, dk = 32 * mtK + r, sb = 16 * kst + 4 * hh;
                float kv[8];
#pragma unroll
                for (int j = 0; j < 8; ++j) { const int sp = sb + (j & 3) + 8 * (j >> 2); const int os = d ? 63 - sp : sp; kv[j] = KFl[os * LS + dk] * CK[d * 64 + sp]; }
                v4u kq; kq.x = pk2bf(kv[0], kv[1]); kq.y = pk2bf(kv[2], kv[3]); kq.z = pk2bf(kv[4], kv[5]); kq.w = pk2bf(kv[6], kv[7]);
                ((v4u*)(itd + DN_KD))[f * 64 + ln] = kq;
            }
        }
    }
    __syncthreads();
    if (wave < 2) {
#pragma unroll
        for (int c = 0; c < 64; ++c) LM[wave * LMD + c * LMS + lane] = x[c];
    }
    __syncthreads();
    {
        const int w4 = wave & 3, r = lane & 31, hh = lane >> 5;
        const float* TI = LM + dir * LMD; const float* cbd = CB + dir * 64; const float* cwd = CW + dir * 64;
#pragma unroll 1
        for (int tt = 0; tt < 2; ++tt) {
            {
                const int tix = w4 * 2 + tt, jj = tix >> 1, mt = tix & 1;
                f32x16 acc;
#pragma unroll
                for (int i = 0; i < 16; ++i) acc[i] = 0.f;
#pragma unroll
                for (int ks = 0; ks < 4; ++ks) {
                    bf16x8 ah, al; split_hi_lo(TI + (32 * mt + r) * LMS + 16 * ks + 8 * hh, ah, al);
                    float bv[8];
#pragma unroll
                    for (int j = 0; j < 8; ++j) { const int s = 16 * ks + 8 * hh + j; const int os = dir ? 63 - s : s; bv[j] = VFl[os * LS + 32 * jj + r] * cbd[s]; }
                    v4u bb; bb.x = pk2bf(bv[0], bv[1]); bb.y = pk2bf(bv[2], bv[3]); bb.z = pk2bf(bv[4], bv[5]); bb.w = pk2bf(bv[6], bv[7]);
                    const bf16x8 b = __builtin_bit_cast(bf16x8, bb);
                    acc = MFMA32(ah, b, acc); acc = MFMA32(al, b, acc);
                }
                v4u lo, hi;
                lo.x = pk2bf(acc[0], acc[1]); lo.y = pk2bf(acc[2], acc[3]); lo.z = pk2bf(acc[4], acc[5]); lo.w = pk2bf(acc[6], acc[7]);
                hi.x = pk2bf(acc[8], acc[9]); hi.y = pk2bf(acc[10], acc[11]); hi.z = pk2bf(acc[12], acc[13]); hi.w = pk2bf(acc[14], acc[15]);
                v4u* dst = (v4u*)(item + DN_U + (size_t)(((jj * 2 + mt) * 64 + lane) * 32));
                dst[0] = lo; dst[1] = hi;
            }
            {
                const int tix = w4 * 2 + tt, mtK = tix >> 1, nt = tix & 1;
                f32x16 acc;
#pragma unroll
                for (int i = 0; i < 16; ++i) acc[i] = 0.f;
#pragma unroll
                for (int ks = 0; ks < 4; ++ks) {
                    bf16x8 bh, bl; split_hi_lo(TI + (32 * nt + r) * LMS + 16 * ks + 8 * hh, bh, bl);
                    float av[8];
#pragma unroll
                    for (int j = 0; j < 8; ++j) { const int s = 16 * ks + 8 * hh + j; const int os = dir ? 63 - s : s; av[j] = KFl[os * LS + 32 * mtK + r] * cwd[s]; }
                    v4u aa; aa.x = pk2bf(av[0], av[1]); aa.y = pk2bf(av[2], av[3]); aa.z = pk2bf(av[4], av[5]); aa.w = pk2bf(av[6], av[7]);
                    const bf16x8 a = __builtin_bit_cast(bf16x8, aa);
                    acc = MFMA32(a, bh, acc); acc = MFMA32(a, bl, acc);
                }
                v4u* wf = (v4u*)(item + DN_W);
                wf[(nt * 8 + mtK * 2 + 0) * 64 + lane] = __builtin_bit_cast(v4u, pack_step<0>(acc));
                wf[(nt * 8 + mtK * 2 + 1) * 64 + lane] = __builtin_bit_cast(v4u, pack_step<1>(acc));
            }
        }
    }
    __syncthreads();
}

__device__ __forceinline__ void phase_branch_a(const Params& p, const bf16_t* PROJ, bf16_t* YA, int wave, int lane) {
    const int gw = wave * gridDim.x + blockIdx.x, ngw = gridDim.x * NWAVES;
    const v4u zero4 = {0u, 0u, 0u, 0u};
    for (int tok = gw; tok < NTOK; tok += ngw) {
        const int pos = tok < NCTX ? (tok & 255) : ((tok - NCTX) & 63); const int L = tok < NCTX ? 256 : 64;
        const bool hasL = pos != 0, hasR = pos != L - 1;
#pragma unroll 1
        for (int grp = 0; grp < 2; ++grp) {
            const int ch0 = grp * 512 + lane * 8; const size_t o = (size_t)tok * DM + ch0;
            float bg[8], cc[8], cl[8], cr[8], xc[8], xl[8], xr[8], w0[8], w1[8], w2[8];
            unpack8(*(const v4u*)(PROJ + o), bg);
            unpack8(*(const v4u*)(PROJ + BLK + o), cc); unpack8(hasL ? *(const v4u*)(PROJ + BLK + o - DM) : zero4, cl); unpack8(hasR ? *(const v4u*)(PROJ + BLK + o + DM) : zero4, cr);
            unpack8(*(const v4u*)(PROJ + 2 * BLK + o), xc); unpack8(hasL ? *(const v4u*)(PROJ + 2 * BLK + o - DM) : zero4, xl); unpack8(hasR ? *(const v4u*)(PROJ + 2 * BLK + o + DM) : zero4, xr);
            load8f(p.conv_w + ch0, w0); load8f(p.conv_w + 1024 + ch0, w1); load8f(p.conv_w + 2048 + ch0, w2);
            float y[8];
#pragma unroll
            for (int e = 0; e < 8; ++e) y[e] = bg[e] * (w0[e] * cl[e] * xl[e] + w1[e] * cc[e] * xc[e] + w2[e] * cr[e] * xr[e]);
            v4u ov; ov.x = pk2bf(y[0], y[1]); ov.y = pk2bf(y[2], y[3]); ov.z = pk2bf(y[4], y[5]); ov.w = pk2bf(y[6], y[7]);
            *(v4u*)(YA + o) = ov;
        }
    }
}

__device__ __forceinline__ void dn_scan_item(const Params& p, const unsigned char* DN, const float* GL, float* OF, float* OBk, int it, int lane) {
    const bool lat = it < 128; const int q = lat ? it : it - 128;
    const int jj = q & 3, dir = (q >> 2) & 1, h = (q >> 3) & 7, b = q >> 6;
    const int nch = lat ? 16 : 4, scb = lat ? 64 + 16 * b : 4 * b, tokb = lat ? NCTX + b * 1024 : b * 256;
    const int n = lane & 31, hh = lane >> 5;
    f32x16 S[4];
    if (lat) { const float* s0 = (dir ? p.st_b : p.st_f) + (size_t)(b * 8 + h) * 16384 + 32 * jj + n;
#pragma unroll
        for (int m = 0; m < 4; ++m)
#pragma unroll
            for (int i = 0; i < 16; ++i) S[m][i] = s0[(size_t)(32 * m + crow16(i, hh)) * 128]; }
    else {
#pragma unroll
        for (int m = 0; m < 4; ++m)
#pragma unroll
            for (int i = 0; i < 16; ++i) S[m][i] = 0.f; }
    float* Od = (dir ? OBk : OF) + h * 128 + 32 * jj + n;
#pragma unroll 1
    for (int ci = 0; ci < nch; ++ci) {
        const int no = dir ? nch - 1 - ci : ci; const int id = ((scb + no) * 8 + h) * 2 + dir;
        const unsigned char* item = DN + (size_t)id * DN_ITEM_BYTES;
        const v4u* Wf = (const v4u*)(item + DN_W) + lane; const v4u* Qf = (const v4u*)(item + DN_QD) + lane; const v4u* Kf = (const v4u*)(item + DN_KD) + lane; const v4u* Af = (const v4u*)(item + DN_A) + lane;
        const float gl = GL[id];
        bf16x8 Sb[8];
        Sb[0] = pack_step<0>(S[0]); Sb[1] = pack_step<1>(S[0]); Sb[2] = pack_step<0>(S[1]); Sb[3] = pack_step<1>(S[1]);
        Sb[4] = pack_step<0>(S[2]); Sb[5] = pack_step<1>(S[2]); Sb[6] = pack_step<0>(S[3]); Sb[7] = pack_step<1>(S[3]);
        f32x16 vn[2], o[2];
#pragma unroll
        for (int mt = 0; mt < 2; ++mt) {
            f32x16 ws;
#pragma unroll
            for (int i = 0; i < 16; ++i) { ws[i] = 0.f; o[mt][i] = 0.f; }
#pragma unroll
            for (int ks = 0; ks < 8; ++ks) { ws = MFMA32(__builtin_bit_cast(bf16x8, Wf[(mt * 8 + ks) * 64]), Sb[ks], ws); o[mt] = MFMA32(__builtin_bit_cast(bf16x8, Qf[(mt * 8 + ks) * 64]), Sb[ks], o[mt]); }
            const v4u* up = (const v4u*)(item + DN_U + (size_t)(((jj * 2 + mt) * 64 + lane) * 32));
            const v4u u0 = up[0], u1 = up[1];
            vn[mt][0] = bflo(u0.x) - ws[0]; vn[mt][1] = bfhi(u0.x) - ws[1]; vn[mt][2] = bflo(u0.y) - ws[2]; vn[mt][3] = bfhi(u0.y) - ws[3];
            vn[mt][4] = bflo(u0.z) - ws[4]; vn[mt][5] = bfhi(u0.z) - ws[5]; vn[mt][6] = bflo(u0.w) - ws[6]; vn[mt][7] = bfhi(u0.w) - ws[7];
            vn[mt][8] = bflo(u1.x) - ws[8]; vn[mt][9] = bfhi(u1.x) - ws[9]; vn[mt][10] = bflo(u1.y) - ws[10]; vn[mt][11] = bfhi(u1.y) - ws[11];
            vn[mt][12] = bflo(u1.z) - ws[12]; vn[mt][13] = bfhi(u1.z) - ws[13]; vn[mt][14] = bflo(u1.w) - ws[14]; vn[mt][15] = bfhi(u1.w) - ws[15];
        }
        bf16x8 Vb[4];
        Vb[0] = pack_step<0>(vn[0]); Vb[1] = pack_step<1>(vn[0]); Vb[2] = pack_step<0>(vn[1]); Vb[3] = pack_step<1>(vn[1]);
#pragma unroll
        for (int mt = 0; mt < 2; ++mt)
#pragma unroll
            for (int kst = 0; kst < 4; ++kst) o[mt] = MFMA32(__builtin_bit_cast(bf16x8, Af[(mt * 4 + kst) * 64]), Vb[kst], o[mt]);
#pragma unroll
        for (int m = 0; m < 4; ++m) {
#pragma unroll
            for (int i = 0; i < 16; ++i) S[m][i] *= gl;
#pragma unroll
            for (int kst = 0; kst < 4; ++kst) S[m] = MFMA32(__builtin_bit_cast(bf16x8, Kf[(m * 4 + kst) * 64]), Vb[kst], S[m]);
        }
        const int tok0 = tokb + 64 * no;
#pragma unroll
        for (int mt = 0; mt < 2; ++mt)
#pragma unroll
            for (int i = 0; i < 16; ++i) { const int cp = 32 * mt + crow16(i, hh); const int oc = dir ? 63 - cp : cp; Od[(size_t)(tok0 + oc) * DM] = o[mt][i]; }
    }
    if (!lat) { float* so = p.out + (size_t)NTOK * DM + (size_t)dir * (16 * 8 * 128 * 128) + (size_t)(b * 8 + h) * 16384 + 32 * jj + n;
#pragma unroll
        for (int m = 0; m < 4; ++m)
#pragma unroll
            for (int i = 0; i < 16; ++i) so[(size_t)(32 * m + crow16(i, hh)) * 128] = S[m][i]; }
}

constexpr int SC_BUF = 57344;
__device__ __forceinline__ void dn_scan_group(const Params& p, const unsigned char* DN, const float* GL, float* OF, float* OBk, unsigned char* lds, int grp) {
    int tid_l = threadIdx.x; asm volatile("" : "+v"(tid_l));
    const int tid = tid_l, lane = tid & 63, wave = __builtin_amdgcn_readfirstlane(tid >> 6);
    const bool lat = grp < 32; const int q = lat ? grp : grp - 32;
    const int dir = q & 1, h = (q >> 1) & 7, b = q >> 4;
    const int nch = lat ? 16 : 4, scb = lat ? 64 + 16 * b : 4 * b, tokb = lat ? NCTX + b * 1024 : b * 256;
    if (wave >= 4) {
        const int lt = tid - 256;
        v4u r[14];
        {   const v4u* src = (const v4u*)(DN + (size_t)(((scb + (dir ? nch - 1 : 0)) * 8 + h) * 2 + dir) * DN_ITEM_BYTES) + lt;
#pragma unroll
            for (int k = 0; k < 14; ++k) r[k] = src[256 * k];
            v4u* dst = (v4u*)lds + lt;
#pragma unroll
            for (int k = 0; k < 14; ++k) dst[256 * k] = r[k]; }
        {   const v4u* src = (const v4u*)(DN + (size_t)(((scb + (dir ? nch - 2 : 1)) * 8 + h) * 2 + dir) * DN_ITEM_BYTES) + lt;
#pragma unroll
            for (int k = 0; k < 14; ++k) r[k] = src[256 * k]; }
        __syncthreads();
#pragma unroll 1
        for (int ci = 0; ci < nch; ++ci) {
            if (ci + 1 < nch) { v4u* dst = (v4u*)(lds + ((ci + 1) & 1) * SC_BUF) + lt;
#pragma unroll
                for (int k = 0; k < 14; ++k) dst[256 * k] = r[k]; }
            if (ci + 2 < nch) { const int no = dir ? nch - 3 - ci : ci + 2;
                const v4u* src = (const v4u*)(DN + (size_t)(((scb + no) * 8 + h) * 2 + dir) * DN_ITEM_BYTES) + lt;
#pragma unroll
                for (int k = 0; k < 14; ++k) r[k] = src[256 * k]; }
            __syncthreads();
        }
    } else {
        const int jj = wave, n = lane & 31, hh = lane >> 5;
        f32x16 S[4];
        if (lat) { const float* s0 = (dir ? p.st_b : p.st_f) + (size_t)(b * 8 + h) * 16384 + 32 * jj + n;
#pragma unroll
            for (int m = 0; m < 4; ++m)
#pragma unroll
                for (int i = 0; i < 16; ++i) S[m][i] = s0[(size_t)(32 * m + crow16(i, hh)) * 128]; }
        else {
#pragma unroll
            for (int m = 0; m < 4; ++m)
#pragma unroll
                for (int i = 0; i < 16; ++i) S[m][i] = 0.f; }
        float* Od = (dir ? OBk : OF) + h * 128 + 32 * jj + n;
        v4u un[4]; float gln;
        {   const int id0 = ((scb + (dir ? nch - 1 : 0)) * 8 + h) * 2 + dir; const unsigned char* it0 = DN + (size_t)id0 * DN_ITEM_BYTES + DN_U;
            const v4u* u0 = (const v4u*)(it0 + (size_t)(((jj * 2 + 0) * 64 + lane) * 32)); const v4u* u1 = (const v4u*)(it0 + (size_t)(((jj * 2 + 1) * 64 + lane) * 32));
            un[0] = u0[0]; un[1] = u0[1]; un[2] = u1[0]; un[3] = u1[1]; gln = GL[id0]; }
        __syncthreads();
#pragma unroll 1
        for (int ci = 0; ci < nch; ++ci) {
            const int no = dir ? nch - 1 - ci : ci;
            const float gl = gln;
            const unsigned char* buf = lds + (ci & 1) * SC_BUF;
            const v4u* Wf = (const v4u*)(buf + DN_W) + lane; const v4u* Qf = (const v4u*)(buf + DN_QD) + lane; const v4u* Kf = (const v4u*)(buf + DN_KD) + lane; const v4u* Af = (const v4u*)(buf + DN_A) + lane;
            f32x16 vn[2], o[2];
            {
                bf16x8 Sb[8];
                Sb[0] = pack_step<0>(S[0]); Sb[1] = pack_step<1>(S[0]); Sb[2] = pack_step<0>(S[1]); Sb[3] = pack_step<1>(S[1]);
                Sb[4] = pack_step<0>(S[2]); Sb[5] = pack_step<1>(S[2]); Sb[6] = pack_step<0>(S[3]); Sb[7] = pack_step<1>(S[3]);
#pragma unroll
                for (int mt = 0; mt < 2; ++mt) {
                    f32x16 ws;
#pragma unroll
                    for (int i = 0; i < 16; ++i) { ws[i] = 0.f; o[mt][i] = 0.f; }
#pragma unroll
                    for (int ks = 0; ks < 8; ++ks) { ws = MFMA32(__builtin_bit_cast(bf16x8, Wf[(mt * 8 + ks) * 64]), Sb[ks], ws); o[mt] = MFMA32(__builtin_bit_cast(bf16x8, Qf[(mt * 8 + ks) * 64]), Sb[ks], o[mt]); }
                    const v4u u0 = un[2 * mt], u1 = un[2 * mt + 1];
                    vn[mt][0] = bflo(u0.x) - ws[0]; vn[mt][1] = bfhi(u0.x) - ws[1]; vn[mt][2] = bflo(u0.y) - ws[2]; vn[mt][3] = bfhi(u0.y) - ws[3];
                    vn[mt][4] = bflo(u0.z) - ws[4]; vn[mt][5] = bfhi(u0.z) - ws[5]; vn[mt][6] = bflo(u0.w) - ws[6]; vn[mt][7] = bfhi(u0.w) - ws[7];
                    vn[mt][8] = bflo(u1.x) - ws[8]; vn[mt][9] = bfhi(u1.x) - ws[9]; vn[mt][10] = bflo(u1.y) - ws[10]; vn[mt][11] = bfhi(u1.y) - ws[11];
                    vn[mt][12] = bflo(u1.z) - ws[12]; vn[mt][13] = bfhi(u1.z) - ws[13]; vn[mt][14] = bflo(u1.w) - ws[14]; vn[mt][15] = bfhi(u1.w) - ws[15];
                    __builtin_amdgcn_sched_barrier(0);
                }
            }
            if (ci + 1 < nch) { const int no1 = dir ? nch - 2 - ci : ci + 1; const int id1 = ((scb + no1) * 8 + h) * 2 + dir; const unsigned char* it1 = DN + (size_t)id1 * DN_ITEM_BYTES + DN_U;
                const v4u* u0 = (const v4u*)(it1 + (size_t)(((jj * 2 + 0) * 64 + lane) * 32)); const v4u* u1 = (const v4u*)(it1 + (size_t)(((jj * 2 + 1) * 64 + lane) * 32));
                un[0] = u0[0]; un[1] = u0[1]; un[2] = u1[0]; un[3] = u1[1]; gln = GL[id1]; }
            bf16x8 Vb[4];
            Vb[0] = pack_step<0>(vn[0]); Vb[1] = pack_step<1>(vn[0]); Vb[2] = pack_step<0>(vn[1]); Vb[3] = pack_step<1>(vn[1]);
            __builtin_amdgcn_sched_barrier(0);
#pragma unroll
            for (int mt = 0; mt < 2; ++mt)
#pragma unroll
                for (int kst = 0; kst < 4; ++kst) o[mt] = MFMA32(__builtin_bit_cast(bf16x8, Af[(mt * 4 + kst) * 64]), Vb[kst], o[mt]);
            const int tok0 = tokb + 64 * no;
#pragma unroll
            for (int mt = 0; mt < 2; ++mt)
#pragma unroll
                for (int i = 0; i < 16; ++i) { const int cp = 32 * mt + crow16(i, hh); const int oc = dir ? 63 - cp : cp; Od[(size_t)(tok0 + oc) * DM] = o[mt][i]; }
            __builtin_amdgcn_sched_barrier(0);
#pragma unroll
            for (int m = 0; m < 4; ++m) {
#pragma unroll
                for (int i = 0; i < 16; ++i) S[m][i] *= gl;
#pragma unroll
                for (int kst = 0; kst < 4; ++kst) S[m] = MFMA32(__builtin_bit_cast(bf16x8, Kf[(m * 4 + kst) * 64]), Vb[kst], S[m]);
            }
            __builtin_amdgcn_sched_barrier(0);
            __syncthreads();
        }
        if (!lat) { float* so = p.out + (size_t)NTOK * DM + (size_t)dir * (16 * 8 * 128 * 128) + (size_t)(b * 8 + h) * 16384 + 32 * jj + n;
#pragma unroll
            for (int m = 0; m < 4; ++m)
#pragma unroll
                for (int i = 0; i < 16; ++i) so[(size_t)(32 * m + crow16(i, hh)) * 128] = S[m][i]; }
    }
}
__device__ __forceinline__ void phase_dn_scan(const Params& p, const unsigned char* DN, const float* GL, float* OF, float* OBk, unsigned char* lds) {
    const int bx = blockIdx.x;
    if (gridDim.x >= 256) {
        const int ng = (bx >= 32 && bx < 64) ? 2 : 1;
#pragma unroll 1
        for (int gi = 0; gi < ng; ++gi) dn_scan_group(p, DN, GL, OF, OBk, lds, gi ? 224 + bx : bx);
    } else { for (int g = bx; g < 288; g += gridDim.x) dn_scan_group(p, DN, GL, OF, OBk, lds, g); }
}

__device__ __forceinline__ void phase_ogate(const Params& p, const float* OF, const float* OBk, const bf16_t* Z, bf16_t* OG, int wave, int lane) {
    const int gw = wave * gridDim.x + blockIdx.x, ngw = gridDim.x * NWAVES;
    for (int tok = gw; tok < NTOK; tok += ngw) {
#pragma unroll
        for (int hf = 0; hf < 2; ++hf) {
            const int ch0 = hf * 512 + lane * 8; const size_t o = (size_t)tok * DM + ch0;
            float a[8], b2[8], z[8], nw[8];
            load8f(OF + o, a); load8f(OBk + o, b2); unpack8(*(const v4u*)(Z + o), z); load8f(p.dn_norm_w + (ch0 & 127), nw);
            float ss = 0.f;
#pragma unroll
            for (int e = 0; e < 8; ++e) { a[e] += b2[e]; ss += a[e] * a[e]; }
            const float r = rsqrtf(sum16(ss) * (1.0f / 128.0f) + 1e-6f);
            float y[8];
#pragma unroll
            for (int e = 0; e < 8; ++e) y[e] = a[e] * r * nw[e] * siluf(z[e]);
            v4u ov; ov.x = pk2bf(y[0], y[1]); ov.y = pk2bf(y[2], y[3]); ov.z = pk2bf(y[4], y[5]); ov.w = pk2bf(y[6], y[7]);
            *(v4u*)(OG + o) = ov;
        }
    }
}

template <class Epi> __device__ __forceinline__ void run_gemm(PG8_LAS unsigned char* lds, const bf16_t* A, const bf16_t* Bt, int N, int K, const Epi& E, int nrep, int split = 1) {
    pg8::Gemm g; g.A = A; g.Bt = Bt; g.M = NTOK; g.N = N; g.K = K; g.klen = K / split; g.nsp = N / 256;
    pg8::StaticOrder S; S.init(NTOK, N * split, (int)gridDim.x, (int)blockIdx.x);
    pg8::gemm_phase<Epi, pg8::StaticOrder, false>(lds, g, S, E, nullptr);
    __syncthreads();
}

__global__ void __launch_bounds__(512) fwd_megakernel(Params p) {
    extern __shared__ __attribute__((aligned(16))) unsigned char shm[];
    cg::grid_group grid = cg::this_grid();
    PG8_LAS unsigned char* lds3 = (PG8_LAS unsigned char*)shm;
    const int wave = __builtin_amdgcn_readfirstlane(threadIdx.x >> 6), lane = threadIdx.x & 63;
    unsigned char* ws = p.ws;
    volatile XLAS unsigned* xst = (volatile XLAS unsigned*)(lds3 + (LDS_BYTES - 16));
    if (threadIdx.x == 0) { xst[0] = 0u; xst[1] = 0u; }
    __syncthreads();
    XcdBarrier xb = xcd_barrier_post((unsigned*)(ws + OFF_BAR), xst);
    float* X0 = (float*)(ws + OFF_X0); float* X1 = (float*)(ws + OFF_X1); float* MOD = (float*)(ws + OFF_MOD);
    bf16_t* PROJ = (bf16_t*)(ws + OFF_PROJ); float* EX = (float*)(ws + OFF_EX);
    bf16_t* AM = (bf16_t*)p.out;
    bf16_t* HB = (bf16_t*)(ws + OFF_PROJ);
    float* QF = (float*)(ws + OFF_DN); float* KF = QF + BLK; float* VF = KF + BLK; float* BG = VF + BLK;
    float* OF = (float*)(ws + OFF_PROJ); float* OBk = OF + BLK;
    bf16_t* PART = (bf16_t*)(ws + 66 * MiB);
    float* T1 = (float*)(PROJ + 4 * BLK);
    float* GLp = (float*)(ws + OFF_EX + 786432);
    bf16_t* OG = (bf16_t*)p.out + BLK; bf16_t* MRG = AM;

#pragma unroll 1
    for (int rep = 0; rep < p.rep_prep; ++rep) { phase_prep(p, shm, wave, lane); __syncthreads(); }
    xcd_barrier(xb);
#pragma unroll 1
    for (int rep = 0; rep < p.rep_thin; ++rep) phase_norm<1>(p, nullptr, X0, p.norm_ffn1, 0, AM, wave, lane);
    xcd_barrier(xb);
    { pg8::EpiSwiglu E; E.H = HB; run_gemm(lds3, AM, (const bf16_t*)(ws + OFF_WGU), 5632, 1024, E, p.rep_gemm); }
    side_transposes(p, shm, wave, lane, 0, 16);
    xcd_barrier(xb);
    { pg8::EpiPartial E; E.P = PART; run_gemm(lds3, HB, (const bf16_t*)(ws + OFF_WD), 1024, FFH, E, p.rep_gemm, 2); }
    side_transposes(p, shm, wave, lane, 1, 192);
    xcd_barrier(xb);
#pragma unroll 1
    for (int rep = 0; rep < p.rep_thin; ++rep) phase_norm<2>(p, X0, X1, p.norm_mix, 3, AM, wave, lane, PART, 2, 0.5f);
    xcd_barrier(xb);
    { pg8::EpiProj E; E.P = PROJ; E.EX = EX; run_gemm(lds3, AM, (const bf16_t*)(ws + OFF_WIN), 9472, 1024, E, p.rep_gemm); }
    xcd_barrier(xb);
#pragma unroll 1
    for (int rep = 0; rep < p.rep_dnpre; ++rep) for (int it = blockIdx.x; it < 768; it += gridDim.x) dn_pre_item(p, PROJ, EX, ws + OFF_DN, GLp, shm, it >> 3, it & 7);
#pragma unroll 1
    for (int rep = 0; rep < p.rep_thin; ++rep) phase_branch_a(p, PROJ, AM, wave, lane);
    xcd_barrier(xb);
#pragma unroll 1
    for (int rep = 0; rep < p.rep_scan; ++rep) phase_dn_scan(p, ws + OFF_DN, GLp, OF, OBk, shm);
    {
        pg8::EpiGate<0> E; E.G = PROJ + 7 * BLK; E.T = T1; E.O = nullptr;
        pg8::Gemm g; g.A = AM; g.Bt = (const bf16_t*)(ws + OFF_WCO); g.M = NTOK; g.N = 1024; g.K = 1024; g.klen = 1024; g.nsp = 4;
        const bool sub = gridDim.x >= 256;
        const int G = sub ? 96 : (int)gridDim.x, c = sub ? (int)blockIdx.x - 64 : (int)blockIdx.x;
        if (c >= 0 && c < G) { pg8::StaticOrder S; S.init(NTOK, 1024, G, c); pg8::gemm_phase<pg8::EpiGate<0>, pg8::StaticOrder, false>(lds3, g, S, E, nullptr); }
        __syncthreads();
    }
    xcd_barrier(xb);
#pragma unroll 1
    for (int rep = 0; rep < p.rep_thin; ++rep) phase_ogate(p, OF, OBk, PROJ + 6 * BLK, OG, wave, lane);
    xcd_barrier(xb);
    { pg8::EpiGate<1> E; E.G = PROJ + 8 * BLK; E.T = T1; E.O = MRG; run_gemm(lds3, OG, (const bf16_t*)(ws + OFF_WDNO), 1024, 1024, E, p.rep_gemm); }
    side_transposes(p, shm, wave, lane, 2, 96);
    xcd_barrier(xb);
    { pg8::EpiPartial E; E.P = PART; run_gemm(lds3, MRG, (const bf16_t*)(ws + OFF_WO), 1024, 1024, E, p.rep_gemm, 2); }
    xcd_barrier(xb);
#pragma unroll 1
    for (int rep = 0; rep < p.rep_thin; ++rep) phase_norm<2>(p, X1, X0, p.norm_ffn2, 6, AM, wave, lane, PART, 5, 1.0f);
    xcd_barrier(xb);
    { pg8::EpiSwiglu E; E.H = HB; run_gemm(lds3, AM, (const bf16_t*)(ws + OFF_WGU), 5632, 1024, E, p.rep_gemm); }
    xcd_barrier(xb);
    { pg8::EpiPartial E; E.P = PART; run_gemm(lds3, HB, (const bf16_t*)(ws + OFF_WD), 1024, FFH, E, p.rep_gemm, 2); }
    xcd_barrier(xb);
#pragma unroll 1
    for (int rep = 0; rep < p.rep_sync; ++rep) grid.sync();
    phase_final_norm(p, X0, PART, p.out, wave, lane);
}

extern "C" void kernel_launch(void* const* d_in, const int* in_sizes, int n_in, void* d_out, int out_size, void* d_ws, size_t ws_size, hipStream_t stream) {
    static int grid_blocks = 0;
    if (grid_blocks == 0) {
        if (n_in != 27 || ws_size < WS_NEED) { fprintf(stderr, "kernel_launch: unexpected n_in %d / ws %zu\n", n_in, ws_size); grid_blocks = -1; return; }
        int dev = 0, cus = 0, per_cu = 0;
        hipGetDevice(&dev); hipDeviceGetAttribute(&cus, hipDeviceAttributeMultiprocessorCount, dev);
        hipFuncSetAttribute((const void*)fwd_megakernel, hipFuncAttributeMaxDynamicSharedMemorySize, LDS_BYTES);
        hipOccupancyMaxActiveBlocksPerMultiprocessor(&per_cu, (const void*)fwd_megakernel, 512, LDS_BYTES);
        if (per_cu < 1) { fprintf(stderr, "kernel_launch: occupancy query says %d blocks/CU\n", per_cu); per_cu = 1; }
        (void)hipGetLastError();
        grid_blocks = cus;
    }
    if (grid_blocks < 0) return;
    Params p{};
    const float** f = (const float**)&p;
    for (int i = 0; i < 27; ++i) f[i] = (const float*)d_in[i];
    p.out = (float*)d_out; p.ws = (unsigned char*)d_ws; p.rep_prep = REP_PREP; p.rep_gemm = REP_GEMM; p.rep_dnpre = REP_DNPRE; p.rep_scan = REP_SCAN; p.rep_thin = REP_THIN; p.rep_sync = REP_SYNC;
    (void)hipMemsetAsync((unsigned char*)d_ws + OFF_BAR, 0, XCD_BAR_WORDS * sizeof(unsigned), stream);
    void* args[] = {&p};
    hipError_t e = hipLaunchCooperativeKernel((const void*)fwd_megakernel, dim3(grid_blocks), dim3(512), args, LDS_BYTES, stream);
    if (e != hipSuccess) fprintf(stderr, "cooperative launch failed: %s (grid %d)\n", hipGetErrorString(e), grid_blocks);
}
```

```cpp
#include <hip/hip_runtime.h>
#include <hip/hip_cooperative_groups.h>
#include <cstdio>
#include <cstdint>
namespace cg = cooperative_groups;
#define REP_PREP 1
#define REP_GEMM 1
#define REP_DNPRE 1
#define REP_SCAN 1
#define REP_THIN 1
#define REP_SYNC 0
namespace pg8 {
#define PG8_LAS __attribute__((address_space(3)))
typedef unsigned short bf16_t;
typedef short bf16x8 __attribute__((ext_vector_type(8)));
typedef float f32x4 __attribute__((ext_vector_type(4)));
typedef unsigned u32x4 __attribute__((ext_vector_type(4)));
constexpr int BM = 256, BK = 64, HALF = 128, HTB = HALF * BK * 2  , STAGE_BYTES = 8 * HTB, NXCD = 8, WGM = 8;

__host__ __device__ __forceinline__ int lds_byte(int r, int c) { const int st = (r >> 4) * 2 + (c >> 5), rr = r & 15, cc = c & 31, ob = rr * 64 + cc * 2; return st * 1024 + (ob ^ (((ob >> 9) & 1) << 5)); }
__host__ __device__ __forceinline__ void stage_rc(int b, int& R, int& C) { const int st = b / 1024, sb = b % 1024, swz = sb ^ (((sb >> 9) & 1) << 5); R = (st >> 1) * 16 + swz / 64; C = (st & 1) * 32 + (swz % 64) / 2; }
__host__ __device__ __forceinline__ int perm32(int rho) { const int n = rho >> 4, i = rho & 15; return 8 * (i >> 2) + 4 * n + (i & 3); }

struct Unit { int pm, pn; };
struct Gemm { const bf16_t* A; const bf16_t* Bt; int M, N, K; int klen, nsp; };

struct StaticOrder {
    int nM, nN, nwg, G, c;
    __host__ __device__ void init(int M, int N, int G_, int c_) { nM = M / BM; nN = N / BM; nwg = nM * nN; G = G_; c = c_; }
    __host__ __device__ bool next(int i, Unit& u) const {
        const long L = (long)i * G + c; if (L >= nwg) return false;
        int wgid = (int)L; { const int q = nwg / NXCD, r = nwg % NXCD, xcd = wgid % NXCD, off = wgid / NXCD; wgid = (xcd < r ? xcd * (q + 1) : r * (q + 1) + (xcd - r) * q) + off; }
        const int nig = WGM * nN, gid = wgid / nig, fm = gid * WGM, gsz = (nM - fm) < WGM ? (nM - fm) : WGM;
        u.pm = fm + ((wgid % nig) % gsz); u.pn = (wgid % nig) / gsz; return true;
    }
    __device__ __forceinline__ void a_ready(const Unit&) const {}
    __device__ __forceinline__ void done(const Unit&) const {}
};
__device__ __forceinline__ unsigned pk2bf(float a, float b) { typedef float f2v __attribute__((ext_vector_type(2))); typedef __bf16 b2v __attribute__((ext_vector_type(2))); f2v v = {a, b}; b2v r = __builtin_convertvector(v, b2v); return __builtin_bit_cast(unsigned, r); }
__device__ __forceinline__ float bflo(unsigned u) { return __uint_as_float(u << 16); }
__device__ __forceinline__ float bfhi(unsigned u) { return __uint_as_float(u & 0xffff0000u); }
__device__ __forceinline__ float sigmf(float x) { return __builtin_amdgcn_rcpf(1.f + __expf(-x)); }
__device__ __forceinline__ float siluf(float x) { return x * sigmf(x); }
__device__ __forceinline__ int cond_of_tile(int pm) { return pm < 16 ? 0 : 1 + ((pm - 16) >> 2); }
constexpr int NTOK = 6144, DM = 1024, FFH = 2816, NMOD = 9216;
typedef unsigned u32x2 __attribute__((ext_vector_type(2)));

struct EpiSwiglu {
    static constexpr bool PERM = true, AFTER_DRAIN = false;
    bf16_t* H;
    __device__ __forceinline__ void operator()(const f32x4 (&acc)[2][2][4][2], const Unit& u, int wr, int wc, int fr, int fq) const {
        const int row0 = u.pm * BM + wr * 64 + fr, col0 = u.pn * 128 + wc * 32 + 8 * fq;
#pragma unroll
        for (int ai = 0; ai < 2; ++ai)
#pragma unroll
            for (int m = 0; m < 4; ++m) { bf16_t* rowp = H + (size_t)(row0 + ai * HALF + m * 16) * FFH + col0;
                const f32x4 g0 = acc[ai][0][m][0], u0 = acc[ai][1][m][0], g1 = acc[ai][0][m][1], u1 = acc[ai][1][m][1];
                u32x4 o; o.x = pk2bf(siluf(g0[0]) * u0[0], siluf(g0[1]) * u0[1]); o.y = pk2bf(siluf(g0[2]) * u0[2], siluf(g0[3]) * u0[3]);
                o.z = pk2bf(siluf(g1[0]) * u1[0], siluf(g1[1]) * u1[1]); o.w = pk2bf(siluf(g1[2]) * u1[2], siluf(g1[3]) * u1[3]);
                *(u32x4*)rowp = o; }
    }
};
struct EpiResid {
    static constexpr bool PERM = false, AFTER_DRAIN = false;
    const float* Xin; float* Xout; const float* gate; float scale;
    __device__ __forceinline__ void operator()(const f32x4 (&acc)[2][2][4][2], const Unit& u, int wr, int wc, int fr, int fq) const {
        const int row0 = u.pm * BM + wr * 64 + fr, col0 = u.pn * BM + wc * 32 + 4 * fq;
        const float* gp = gate + (size_t)cond_of_tile(u.pm) * NMOD + col0;
        f32x4 gv[2][2];
#pragma unroll
        for (int bj = 0; bj < 2; ++bj)
#pragma unroll
            for (int n = 0; n < 2; ++n) gv[bj][n] = *(const f32x4*)(gp + bj * HALF + n * 16) * scale;
#pragma unroll
        for (int ai = 0; ai < 2; ++ai)
#pragma unroll
            for (int m = 0; m < 4; ++m) { const size_t off = (size_t)(row0 + ai * HALF + m * 16) * DM + col0;
#pragma unroll
                for (int bj = 0; bj < 2; ++bj)
#pragma unroll
                    for (int n = 0; n < 2; ++n) { const f32x4 x = *(const f32x4*)(Xin + off + bj * HALF + n * 16);
                        *(f32x4*)(Xout + off + bj * HALF + n * 16) = x + gv[bj][n] * acc[ai][bj][m][n]; } }
    }
};
struct EpiProj {
    static constexpr bool PERM = true, AFTER_DRAIN = false;
    bf16_t* P; float* EX;
    __device__ __forceinline__ void operator()(const f32x4 (&acc)[2][2][4][2], const Unit& u, int wr, int wc, int fr, int fq) const {
        const int row0 = u.pm * BM + wr * 64 + fr;
        if (u.pn < 36) {
            bf16_t* base = P + (size_t)(u.pn >> 2) * NTOK * DM; const int col0 = (u.pn & 3) * 256 + wc * 32 + 8 * fq;
#pragma unroll
            for (int ai = 0; ai < 2; ++ai)
#pragma unroll
                for (int m = 0; m < 4; ++m) { bf16_t* rowp = base + (size_t)(row0 + ai * HALF + m * 16) * DM + col0;
#pragma unroll
                    for (int bj = 0; bj < 2; ++bj) { const f32x4 v0 = acc[ai][bj][m][0], v1 = acc[ai][bj][m][1];
                        u32x4 o; o.x = pk2bf(v0[0], v0[1]); o.y = pk2bf(v0[2], v0[3]); o.z = pk2bf(v1[0], v1[1]); o.w = pk2bf(v1[2], v1[3]); *(u32x4*)(rowp + bj * HALF) = o; } }
        } else if (wc == 0) {
#pragma unroll
            for (int ai = 0; ai < 2; ++ai)
#pragma unroll
                for (int m = 0; m < 4; ++m)
#pragma unroll
                    for (int n = 0; n < 2; ++n) *(f32x4*)(EX + (size_t)(row0 + ai * HALF + m * 16) * 32 + 8 * fq + 4 * n) = acc[ai][0][m][n];
        }
    }
};
struct EpiPartial {
    static constexpr bool PERM = true, AFTER_DRAIN = false;
    bf16_t* P;
    __device__ __forceinline__ void operator()(const f32x4 (&acc)[2][2][4][2], const Unit& u, int wr, int wc, int fr, int fq) const {
        const int kh = u.pn >> 2, pn = u.pn & 3;
        const int row0 = u.pm * BM + wr * 64 + fr, col0 = pn * BM + wc * 32 + 8 * fq;
        bf16_t* base = P + (size_t)kh * NTOK * DM;
#pragma unroll
        for (int ai = 0; ai < 2; ++ai)
#pragma unroll
            for (int m = 0; m < 4; ++m) { bf16_t* rowp = base + (size_t)(row0 + ai * HALF + m * 16) * DM + col0;
#pragma unroll
                for (int bj = 0; bj < 2; ++bj) { const f32x4 v0 = acc[ai][bj][m][0], v1 = acc[ai][bj][m][1];
                    u32x4 o; o.x = pk2bf(v0[0], v0[1]); o.y = pk2bf(v0[2], v0[3]); o.z = pk2bf(v1[0], v1[1]); o.w = pk2bf(v1[2], v1[3]); *(u32x4*)(rowp + bj * HALF) = o; } }
    }
};
template <int SECOND> struct EpiGate {
    static constexpr bool PERM = false, AFTER_DRAIN = false;
    const bf16_t* G; float* T; bf16_t* O;
    __device__ __forceinline__ void operator()(const f32x4 (&acc)[2][2][4][2], const Unit& u, int wr, int wc, int fr, int fq) const {
        const int row0 = u.pm * BM + wr * 64 + fr, col0 = u.pn * BM + wc * 32 + 4 * fq;
#pragma unroll
        for (int ai = 0; ai < 2; ++ai)
#pragma unroll
            for (int m = 0; m < 4; ++m) { const size_t off = (size_t)(row0 + ai * HALF + m * 16) * DM + col0;
#pragma unroll
                for (int bj = 0; bj < 2; ++bj)
#pragma unroll
                    for (int n = 0; n < 2; ++n) { const size_t o = off + bj * HALF + n * 16; const u32x2 gr = *(const u32x2*)(G + o); const f32x4 a = acc[ai][bj][m][n];
                        f32x4 v; v[0] = sigmf(bflo(gr.x)) * a[0]; v[1] = sigmf(bfhi(gr.x)) * a[1]; v[2] = sigmf(bflo(gr.y)) * a[2]; v[3] = sigmf(bfhi(gr.y)) * a[3];
                        if (SECOND == 0) *(f32x4*)(T + o) = v;
                        else { const f32x4 t = *(const f32x4*)(T + o); v = v + t; u32x2 w; w.x = pk2bf(v[0], v[1]); w.y = pk2bf(v[2], v[3]); *(u32x2*)(O + o) = w; } } }
    }
};

template <class Epi, class Sched, bool STAMP = false>
__device__ __forceinline__ void gemm_phase(PG8_LAS unsigned char* lds, const Gemm g, const Sched& S, const Epi& E, unsigned long long* stamps) {
    int tid_l = threadIdx.x; asm volatile("" : "+v"(tid_l));
    const int tid = tid_l, wid = __builtin_amdgcn_readfirstlane(tid >> 6), lane = tid & 63, wr = wid >> 2, wc = wid & 3, fr = lane & 15, fq = lane >> 4;
    const int K = g.K, nt = g.klen / BK;
    int ts_lo = 0, ts_hi = 0, nts = 0; const unsigned long long rt_entry = STAMP ? (unsigned long long)wall_clock64() : 0ull;
#define PG8_STAMP() do { if (STAMP && wid == 0 && nts < 64) { const unsigned long long _c = (unsigned long long)clock64(); \
        ts_lo = (lane == nts) ? (int)(unsigned)_c : ts_lo; ts_hi = (lane == nts) ? (int)(unsigned)(_c >> 32) : ts_hi; ++nts; } } while (0)
    PG8_STAMP();
    unsigned voffA[2], voffB[2];
#pragma unroll
    for (int i = 0; i < 2; ++i) { int R, C; stage_rc(tid * 16 + i * 8192, R, C); const int Rb = Epi::PERM ? ((R & ~31) + perm32(R & 31)) : R;
        voffA[i] = (unsigned)(R * K + C) * 2u; voffB[i] = (unsigned)(Rb * K + C) * 2u; }
    const size_t kstep = (size_t)(BK * 2);
    const size_t hstep = (size_t)HALF * K * 2;
    const size_t tstep = 2 * hstep;
    const unsigned ldsw = (unsigned)wid * 1024u;
    const int aoff = lds_byte(wr * 64 + fr, fq * 8), boff = lds_byte(wc * 32 + fr, fq * 8);
#define PG8_SA(b, h) (((b) * 2 + (h)) * HTB)
#define PG8_SB(b, h) ((4 + (b) * 2 + (h)) * HTB)
#define PG8_STAGE(bufoff, gbase, voff) do { _Pragma("unroll") for (int _i = 0; _i < 2; ++_i) \
        __builtin_amdgcn_global_load_lds((const unsigned*)((const char*)(gbase) + (voff)[_i]), (PG8_LAS unsigned*)(lds + (bufoff) + ldsw + _i * 8192), 16, 0, 0); } while (0)
#define PG8_LDA(dst, b, h) do { _Pragma("unroll") for (int m = 0; m < 4; ++m) _Pragma("unroll") for (int k = 0; k < 2; ++k) dst[m][k] = *(const PG8_LAS bf16x8*)(lds + PG8_SA(b, h) + aoff + m * 2048 + k * 1024); } while (0)
#define PG8_LDB(dst, b, h) do { _Pragma("unroll") for (int n = 0; n < 2; ++n) _Pragma("unroll") for (int k = 0; k < 2; ++k) dst[n][k] = *(const PG8_LAS bf16x8*)(lds + PG8_SB(b, h) + boff + n * 2048 + k * 1024); } while (0)
#define PG8_MMA(ai, bj, At, Bt) do { __builtin_amdgcn_s_setprio(1); _Pragma("unroll") for (int m = 0; m < 4; ++m) _Pragma("unroll") for (int n = 0; n < 2; ++n) _Pragma("unroll") for (int k = 0; k < 2; ++k) \
        acc[ai][bj][m][n] = __builtin_amdgcn_mfma_f32_16x16x32_bf16(Bt[n][k], At[m][k], acc[ai][bj][m][n], 0, 0, 0); __builtin_amdgcn_s_setprio(0); } while (0)
#define PG8_WAIT_V(n) asm volatile("s_waitcnt vmcnt(" #n ")" ::: "memory")
#define PG8_WAIT_L(n) asm volatile("s_waitcnt lgkmcnt(" #n ")" ::: "memory")
#define PG8_BAR __builtin_amdgcn_s_barrier()
#define PG8_SCHED __builtin_amdgcn_sched_barrier(0)
    Unit cur, nxt; int ui = 0;
    if (!S.next(0, cur)) return;
    f32x4 acc[2][2][4][2];
#pragma unroll
    for (int a = 0; a < 2; ++a)
#pragma unroll
        for (int b = 0; b < 2; ++b)
#pragma unroll
            for (int m = 0; m < 4; ++m)
#pragma unroll
                for (int n = 0; n < 2; ++n) acc[a][b][m][n] = (f32x4){0.f, 0.f, 0.f, 0.f};
    bf16x8 At[4][2], B0[2][2], B1[2][2];
    const size_t khb = (size_t)g.klen * 2;
    const char* cA = (const char*)g.A + (size_t)cur.pm * tstep + (cur.pn >= g.nsp ? khb : 0); const char* cB = (const char*)g.Bt + (size_t)(cur.pn >= g.nsp ? cur.pn - g.nsp : cur.pn) * tstep + (cur.pn >= g.nsp ? khb : 0);
    S.a_ready(cur);
    PG8_STAGE(PG8_SB(0, 0), cB, voffB); PG8_STAGE(PG8_SA(0, 0), cA, voffA); PG8_STAGE(PG8_SB(0, 1), cB + hstep, voffB); PG8_STAGE(PG8_SA(0, 1), cA + hstep, voffA);
    if (wr == 1) PG8_BAR;
    PG8_WAIT_V(4); PG8_BAR;
    PG8_STAGE(PG8_SB(1, 0), cB + kstep, voffB); PG8_STAGE(PG8_SA(1, 0), cA + kstep, voffA); PG8_STAGE(PG8_SB(1, 1), cB + hstep + kstep, voffB);
    PG8_WAIT_V(6); PG8_BAR;
    PG8_STAMP();
    for (;;) {
        const bool has_next = S.next(ui + 1, nxt);
        const char* nA = has_next ? (const char*)g.A + (size_t)nxt.pm * tstep + (nxt.pn >= g.nsp ? khb : 0) : cA; const char* nB = has_next ? (const char*)g.Bt + (size_t)(nxt.pn >= g.nsp ? nxt.pn - g.nsp : nxt.pn) * tstep + (nxt.pn >= g.nsp ? khb : 0) : cB;
        for (int t = 0; t < nt; t += 2) {
            const bool last = (t == nt - 2);
            const char* a1 = cA + (size_t)(t + 1) * kstep;
            const char* a2 = last ? nA : cA + (size_t)(t + 2) * kstep; const char* b2 = last ? nB : cB + (size_t)(t + 2) * kstep;
            const char* a3 = a2 + kstep; const char* b3 = b2 + kstep;
            if (last && has_next) S.a_ready(nxt);
            PG8_LDB(B0, 0, 0); PG8_SCHED; PG8_LDA(At, 0, 0); PG8_STAGE(PG8_SA(1, 1), a1 + hstep, voffA);
            PG8_WAIT_L(8); PG8_BAR; PG8_WAIT_L(0); PG8_MMA(0, 0, At, B0); PG8_BAR; PG8_SCHED;
            PG8_LDB(B1, 0, 1); PG8_STAGE(PG8_SB(0, 0), b2, voffB);
            PG8_BAR; PG8_WAIT_L(0); PG8_MMA(0, 1, At, B1); PG8_BAR;
            PG8_LDA(At, 0, 1); PG8_STAGE(PG8_SA(0, 0), a2, voffA);
            PG8_BAR; PG8_WAIT_L(0); PG8_MMA(1, 0, At, B0); PG8_BAR; PG8_SCHED;
            PG8_STAGE(PG8_SB(0, 1), b2 + hstep, voffB);
            PG8_WAIT_V(6); PG8_BAR; PG8_MMA(1, 1, At, B1); PG8_BAR;
            PG8_LDB(B0, 1, 0); PG8_SCHED; PG8_LDA(At, 1, 0); PG8_STAGE(PG8_SA(0, 1), a2 + hstep, voffA);
            PG8_WAIT_L(8); PG8_BAR; PG8_WAIT_L(0); PG8_MMA(0, 0, At, B0); PG8_BAR; PG8_SCHED;
            PG8_LDB(B1, 1, 1); PG8_STAGE(PG8_SB(1, 0), b3, voffB);
            PG8_BAR; PG8_WAIT_L(0); PG8_MMA(0, 1, At, B1); PG8_BAR;
            PG8_LDA(At, 1, 1); PG8_STAGE(PG8_SA(1, 0), a3, voffA);
            PG8_BAR; PG8_WAIT_L(0); PG8_MMA(1, 0, At, B0); PG8_BAR; PG8_SCHED;
            PG8_STAGE(PG8_SB(1, 1), b3 + hstep, voffB);
            PG8_WAIT_V(6); PG8_BAR; PG8_MMA(1, 1, At, B1); PG8_BAR;
        }
        PG8_STAMP();
        if constexpr (!Epi::AFTER_DRAIN) { E(acc, cur, wr, wc, fr, fq); S.done(cur); }
        PG8_STAMP();
        if (!has_next) break;
#pragma unroll
        for (int a = 0; a < 2; ++a)
#pragma unroll
            for (int b = 0; b < 2; ++b)
#pragma unroll
                for (int m = 0; m < 4; ++m)
#pragma unroll
                    for (int n = 0; n < 2; ++n) acc[a][b][m][n] = (f32x4){0.f, 0.f, 0.f, 0.f};
        cur = nxt; cA = nA; cB = nB; ++ui;
    }
    PG8_WAIT_V(0);
    if (wr == 0) PG8_BAR;
    PG8_BAR;
    if constexpr (Epi::AFTER_DRAIN) { E.fused(acc, cur, wr, wc, fr, fq, lds, wid, lane); S.done(cur); }
    PG8_STAMP();
    if (STAMP && wid == 0) { stamps[lane] = lane < nts ? (((unsigned long long)(unsigned)ts_hi << 32) | (unsigned)ts_lo) : 0ull;
        if (lane == 62) stamps[62] = rt_entry; if (lane == 63) stamps[63] = (unsigned long long)wall_clock64(); }
#undef PG8_STAMP
#undef PG8_SA
#undef PG8_SB
#undef PG8_STAGE
#undef PG8_LDA
#undef PG8_LDB
#undef PG8_MMA
#undef PG8_WAIT_V
#undef PG8_WAIT_L
#undef PG8_BAR
#undef PG8_SCHED
}
}
#define XB_TMO      128
#define XB_XCNT(j)  (256  + 64 * (j))
#define XB_XSUB(j)  (1280 + 64 * (j))
#define XB_XGEN(j)  (2304 + 64 * (j))
#define XB_TOP      3328
#define XB_TOPGEN   3392
#define XCD_BAR_WORDS 3456
#define XB_SPIN_CAP (1u << 18)
#define XLAS __attribute__((address_space(3)))

__device__ __forceinline__ unsigned xb_ld(unsigned* p)              { return __hip_atomic_load(p, __ATOMIC_RELAXED, __HIP_MEMORY_SCOPE_AGENT); }
__device__ __forceinline__ unsigned xb_add(unsigned* p, unsigned v) { return __hip_atomic_fetch_add(p, v, __ATOMIC_RELAXED, __HIP_MEMORY_SCOPE_AGENT); }
__device__ __forceinline__ unsigned xb_xcc_id() { return (unsigned)__builtin_amdgcn_s_getreg((3 << 11) | 20) & 0xFu; }
#define XB_SPIN(cond, bar) do { unsigned _sp = 0; while (cond) { __builtin_amdgcn_s_sleep(1); \
    if ((++_sp & 255u) == 0u) { if (xb_ld(&(bar)[XB_TMO])) break; if (_sp > XB_SPIN_CAP) { atomicAdd(&(bar)[XB_TMO], 1u); break; } } } } while (0)

struct XcdBarrier {
    unsigned* bar; unsigned x;
    volatile XLAS unsigned* st;
};

__device__ __forceinline__ XcdBarrier xcd_barrier_post(unsigned* bar, volatile XLAS unsigned* st) {
    XcdBarrier b; b.bar = bar; b.x = xb_xcc_id(); b.st = st;
    if (threadIdx.x == 0) (void)xb_add(&bar[XB_XCNT(b.x)], 1u);
    return b;
}
__device__ __forceinline__ void xcd_barrier_complete(unsigned* bar, unsigned x, unsigned& nloc, unsigned& nx) {
    const unsigned G = gridDim.x * gridDim.y * gridDim.z;
    unsigned sum, cnt, mine, sp = 0u;
    for (;;) {
        sum = 0u; cnt = 0u; mine = 0u;
#pragma unroll
        for (unsigned j = 0; j < 16; ++j) { const unsigned c = xb_ld(&bar[XB_XCNT(j)]); sum += c; cnt += (c > 0u) ? 1u : 0u; mine = (j == x) ? c : mine; }
        if (sum == G) break;
        __builtin_amdgcn_s_sleep(1);
        if ((++sp & 255u) == 0u) { if (xb_ld(&bar[XB_TMO])) break; if (sp > XB_SPIN_CAP) { atomicAdd(&bar[XB_TMO], 1u); break; } }
    }
    nloc = mine > 0u ? mine : 1u; nx = cnt > 0u ? cnt : 1u;
}

__device__ __forceinline__ void xcd_barrier(const XcdBarrier& b) {
    asm volatile("s_waitcnt vmcnt(0)" ::: "memory");
    __syncthreads();
    if (threadIdx.x == 0) {
        unsigned* bar = b.bar;
        __builtin_amdgcn_s_waitcnt(0);
        unsigned nloc = b.st[0], nx = b.st[1];
        if (nloc == 0u) { xcd_barrier_complete(bar, b.x, nloc, nx); b.st[0] = nloc; b.st[1] = nx; }
        const unsigned old = xb_add(&bar[XB_XSUB(b.x)], 1u);
        const unsigned gen = old / nloc;
        if (old + 1u == (gen + 1u) * nloc) {
            __builtin_amdgcn_fence(__ATOMIC_RELEASE, "agent");
            asm volatile("s_waitcnt vmcnt(0)" ::: "memory");
            const unsigned og = xb_add(&bar[XB_TOP], 1u);
            const unsigned tg = og / nx;
            if (og + 1u == (tg + 1u) * nx) xb_add(&bar[XB_TOPGEN], 1u);
            else XB_SPIN(xb_ld(&bar[XB_TOPGEN]) == tg, bar);
            __builtin_amdgcn_fence(__ATOMIC_ACQUIRE, "agent");
            xb_add(&bar[XB_XGEN(b.x)], 1u);
            asm volatile("s_waitcnt vmcnt(0)" ::: "memory");
        } else {
            XB_SPIN(xb_ld(&bar[XB_XGEN(b.x)]) == gen, bar);
            __builtin_amdgcn_fence(__ATOMIC_ACQUIRE, "agent");
            asm volatile("s_waitcnt vmcnt(0)" ::: "memory");
        }
    }
    __syncthreads();
}


using pg8::bf16_t; using pg8::f32x4; using pg8::pk2bf; using pg8::bflo; using pg8::bfhi; using pg8::siluf; using pg8::sigmf; using pg8::u32x2;
using pg8::NTOK; using pg8::DM; using pg8::FFH; using pg8::NMOD;
typedef unsigned v4u __attribute__((ext_vector_type(4)));
#define LDS_WAIT() asm volatile("s_waitcnt lgkmcnt(0)" ::: "memory")
constexpr int NCTX = 4096, NWAVES = 8, LDS_BYTES = 143360;
constexpr size_t MiB = 1048576;
constexpr size_t OFF_WCO = 0, OFF_WDNO = 2 * MiB, OFF_WO = 4 * MiB;
constexpr size_t OFF_WGU = 6 * MiB;
constexpr size_t OFF_WD = 17 * MiB;
constexpr size_t OFF_WIN = 23 * MiB;
constexpr size_t OFF_X0 = 42 * MiB;
constexpr size_t OFF_DN = 6 * MiB;
constexpr size_t OFF_X1 = 114 * MiB;
constexpr size_t OFF_PROJ = 138 * MiB;
constexpr size_t OFF_EX = 246 * MiB;
constexpr size_t OFF_MOD = 247 * MiB;
constexpr size_t OFF_BAR = 247 * MiB + 512 * 1024;
constexpr size_t WS_NEED = 248 * MiB;
constexpr size_t BLK = (size_t)NTOK * DM;

struct Params {
    const float *x_prompt, *x_sample, *st_f, *st_b, *c, *c_ctx, *ada_w, *ada_b, *norm_ffn1, *f1g, *f1u, *f1d, *norm_mix, *w_in, *conv_w, *conv_out_w,
        *dn_conv_w, *dn_a_log, *dn_dt_bias, *dn_norm_w, *dn_out_w, *w_o, *norm_ffn2, *f2g, *f2u, *f2d, *norm_f;
    float* out; unsigned char* ws; int rep_prep, rep_gemm, rep_dnpre, rep_scan, rep_thin, rep_sync;
};

__device__ __forceinline__ float wave_sum(float v) {
#pragma unroll
    for (int o = 1; o < 64; o <<= 1) v += __shfl_xor(v, o);
    return v;
}
__device__ __forceinline__ float sum16(float v) {
#pragma unroll
    for (int o = 1; o < 16; o <<= 1) v += __shfl_xor(v, o);
    return v;
}
__device__ __forceinline__ void transpose_item(const float* W, int N, int k0, int n0, bf16_t* WT, int Kd, int dst_row0, float* scr, int lane) {
#pragma unroll 8
    for (int i = 0; i < 32; ++i) { const int kk = 2 * i + (lane >> 5); scr[kk * 33 + (lane & 31)] = W[(size_t)(k0 + kk) * N + n0 + (lane & 31)]; }
    LDS_WAIT();
    const int c = lane & 7;
#pragma unroll
    for (int j = 0; j < 4; ++j) { const int n = (lane >> 3) + 8 * j; const float* s = scr + (8 * c) * 33 + n;
        v4u o; o.x = pk2bf(s[0 * 33], s[1 * 33]); o.y = pk2bf(s[2 * 33], s[3 * 33]); o.z = pk2bf(s[4 * 33], s[5 * 33]); o.w = pk2bf(s[6 * 33], s[7 * 33]);
        *(v4u*)(WT + (size_t)(dst_row0 + n) * Kd + k0 + 8 * c) = o; }
    LDS_WAIT();
}
__device__ __forceinline__ void transpose_matrix(const float* W, int K, int N, bf16_t* WT, int mode, int gw, int ngw, float* scr, int lane) {
    const int nblk = N / 32, nitems = (K / 64) * nblk;
    for (int it = gw; it < nitems; it += ngw) {
        const int kb = it / nblk, nb = it % nblk, n0 = nb * 32;
        const int dr = mode == 0 ? n0 : ((n0 >> 7) * 256 + (n0 & 127) + (mode == 2 ? 128 : 0));
        transpose_item(W, N, kb * 64, n0, WT, K, dr, scr, lane);
    }
}

__device__ __forceinline__ void phase_prep(const Params& p, unsigned char* lds, int wave, int lane) {
    unsigned char* ws = p.ws;
    float* scr = (float*)lds + wave * (64 * 33);
    const int gw = wave * gridDim.x + blockIdx.x, ngw = gridDim.x * NWAVES;
    transpose_matrix(p.f1g, 1024, FFH, (bf16_t*)(ws + OFF_WGU), 1, gw, ngw, scr, lane);
    transpose_matrix(p.f1u, 1024, FFH, (bf16_t*)(ws + OFF_WGU), 2, gw, ngw, scr, lane);
    __syncthreads();
    float* sc = (float*)lds;
    float* red = (float*)lds + 3072;
    if ((int)blockIdx.x < 144) {
        for (int i = threadIdx.x; i < 3072; i += 512) { const int cc = i >> 10, k = i & 1023; const float v = cc == 0 ? p.c_ctx[k] : p.c[(cc - 1) * 1024 + k]; sc[i] = siluf(v); }
        __syncthreads();
        for (int it = blockIdx.x; it < 144; it += gridDim.x) {
            const int n = it * 64 + lane; float a0 = 0.f, a1 = 0.f, a2 = 0.f;
            const float* wp = p.ada_w + (size_t)(wave * 128) * NMOD + n;
#pragma unroll 8
            for (int k = 0; k < 128; ++k) { const float wv = wp[(size_t)k * NMOD]; const int kk = wave * 128 + k; a0 += sc[kk] * wv; a1 += sc[1024 + kk] * wv; a2 += sc[2048 + kk] * wv; }
            red[(wave * 3 + 0) * 64 + lane] = a0; red[(wave * 3 + 1) * 64 + lane] = a1; red[(wave * 3 + 2) * 64 + lane] = a2;
            __syncthreads();
            if (threadIdx.x < 192) { const int cc = threadIdx.x >> 6, l = threadIdx.x & 63; float s = 0.f;
#pragma unroll
                for (int w = 0; w < 8; ++w) s += red[(w * 3 + cc) * 64 + l];
                ((float*)(ws + OFF_MOD))[cc * NMOD + it * 64 + l] = s + p.ada_b[it * 64 + l]; }
            __syncthreads();
        }
    }
}


__device__ __forceinline__ void side_transposes(const Params& p, unsigned char* lds, int wave, int lane, int which, int b0) {
    if (gridDim.x < 256) b0 = 0;
    const int nb = (int)gridDim.x - b0, bi = (int)blockIdx.x - b0;
    if (bi < 0) return;
    unsigned char* ws = p.ws;
    float* scr = (float*)lds + wave * (64 * 33);
    const int gw = wave * nb + bi, ngw = nb * NWAVES;
    if (which == 0) {
        transpose_matrix(p.f1d, FFH, 1024, (bf16_t*)(ws + OFF_WD), 0, gw, ngw, scr, lane);
    } else if (which == 1) {
        transpose_matrix(p.w_in, 1024, 9248, (bf16_t*)(ws + OFF_WIN), 0, gw, ngw, scr, lane);
        transpose_matrix(p.conv_out_w, 1024, 1024, (bf16_t*)(ws + OFF_WCO), 0, gw, ngw, scr, lane);
        transpose_matrix(p.dn_out_w, 1024, 1024, (bf16_t*)(ws + OFF_WDNO), 0, gw, ngw, scr, lane);
        transpose_matrix(p.w_o, 1024, 1024, (bf16_t*)(ws + OFF_WO), 0, gw, ngw, scr, lane);
        v4u z = {0u, 0u, 0u, 0u}; v4u* zp = (v4u*)((bf16_t*)(ws + OFF_WIN) + (size_t)9248 * 1024);
        const int nz = 224 * 1024 * 2 / 16;
        for (int i = bi * 512 + (int)threadIdx.x; i < nz; i += nb * 512) zp[i] = z;
    } else {
        transpose_matrix(p.f2g, 1024, FFH, (bf16_t*)(ws + OFF_WGU), 1, gw, ngw, scr, lane);
        transpose_matrix(p.f2u, 1024, FFH, (bf16_t*)(ws + OFF_WGU), 2, gw, ngw, scr, lane);
        transpose_matrix(p.f2d, FFH, 1024, (bf16_t*)(ws + OFF_WD), 0, gw, ngw, scr, lane);
    }
    __syncthreads();
}

template <int FIRST> __device__ __forceinline__ void phase_norm(const Params& p, const float* X, float* X0, const float* nw, int modi, bf16_t* A, int wave, int lane, const bf16_t* PART = nullptr, int gatei = 0, float gscale = 0.f) {
    const float* mod = (const float*)(p.ws + OFF_MOD);
    const int gw = wave * gridDim.x + blockIdx.x, ngw = gridDim.x * NWAVES;
    for (int row = gw; row < NTOK; row += ngw) {
        const int cond = row < NCTX ? 0 : 1 + ((row - NCTX) >> 10);
        f32x4 v[4];
        if (FIRST == 1) {
            const float* src = row < NCTX ? p.x_prompt + (size_t)row * DM : p.x_sample + (size_t)(row - NCTX) * DM;
#pragma unroll
            for (int j = 0; j < 4; ++j) v[j] = *(const f32x4*)(src + 4 * lane + 256 * j);
            if (row >= NCTX) {
                const int t = (row - NCTX) & 1023; const float r = (float)(t >> 6), cl = (float)(t & 63);
#pragma unroll
                for (int e = 0; e < 4; ++e) { const int i = 4 * lane + e; const float om = 1.0f / powf(10000.0f, (float)i * (1.0f / 256.0f));
                    v[0][e] += sinf(r * om); v[1][e] += cosf(r * om); v[2][e] += sinf(cl * om); v[3][e] += cosf(cl * om); }
            }
#pragma unroll
            for (int j = 0; j < 4; ++j) *(f32x4*)(X0 + (size_t)row * DM + 4 * lane + 256 * j) = v[j];
        } else if (FIRST == 2) {
            const float* gp = mod + (size_t)cond * NMOD + gatei * 1024;
#pragma unroll
            for (int j = 0; j < 4; ++j) { const size_t o = (size_t)row * DM + 4 * lane + 256 * j;
                const f32x4 x = *(const f32x4*)(X + o), gg = *(const f32x4*)(gp + 4 * lane + 256 * j); const u32x2 q0 = *(const u32x2*)(PART + o), q1 = *(const u32x2*)(PART + BLK + o);
                f32x4 ps; ps[0] = bflo(q0.x) + bflo(q1.x); ps[1] = bfhi(q0.x) + bfhi(q1.x); ps[2] = bflo(q0.y) + bflo(q1.y); ps[3] = bfhi(q0.y) + bfhi(q1.y);
                v[j] = x + (gg * gscale) * ps; *(f32x4*)(X0 + o) = v[j]; }
        } else {
#pragma unroll
            for (int j = 0; j < 4; ++j) v[j] = *(const f32x4*)(X + (size_t)row * DM + 4 * lane + 256 * j);
        }
        float ss = 0.f;
#pragma unroll
        for (int j = 0; j < 4; ++j) ss += v[j][0] * v[j][0] + v[j][1] * v[j][1] + v[j][2] * v[j][2] + v[j][3] * v[j][3];
        const float rstd = rsqrtf(wave_sum(ss) * (1.0f / 1024.0f) + 1e-6f);
        const float* sh = mod + (size_t)cond * NMOD + modi * 1024; const float* scp = sh + 1024;
#pragma unroll
        for (int j = 0; j < 4; ++j) { const int d = 4 * lane + 256 * j; const f32x4 w = *(const f32x4*)(nw + d), s1 = *(const f32x4*)(scp + d), s0 = *(const f32x4*)(sh + d);
            f32x4 y;
#pragma unroll
            for (int e = 0; e < 4; ++e) y[e] = v[j][e] * rstd * w[e] * (1.f + s1[e]) + s0[e];
            u32x2 o; o.x = pk2bf(y[0], y[1]); o.y = pk2bf(y[2], y[3]); *(u32x2*)(A + (size_t)row * DM + d) = o; }
    }
}
__device__ __forceinline__ void phase_final_norm(const Params& p, const float* X, const bf16_t* PART, float* Y, int wave, int lane) {
    const float* mod = (const float*)(p.ws + OFF_MOD);
    const int gw = wave * gridDim.x + blockIdx.x, ngw = gridDim.x * NWAVES;
    for (int row = gw; row < NTOK; row += ngw) {
        f32x4 v[4]; float ss = 0.f;
#pragma unroll
        for (int j = 0; j < 4; ++j) { const size_t o = (size_t)row * DM + 4 * lane + 256 * j; const int cond = row < NCTX ? 0 : 1 + ((row - NCTX) >> 10);
            const f32x4 x = *(const f32x4*)(X + o), gg = *(const f32x4*)(mod + (size_t)cond * NMOD + 8 * 1024 + 4 * lane + 256 * j); const u32x2 q0 = *(const u32x2*)(PART + o), q1 = *(const u32x2*)(PART + BLK + o);
            f32x4 ps; ps[0] = bflo(q0.x) + bflo(q1.x); ps[1] = bfhi(q0.x) + bfhi(q1.x); ps[2] = bflo(q0.y) + bflo(q1.y); ps[3] = bfhi(q0.y) + bfhi(q1.y);
            v[j] = x + (gg * 0.5f) * ps; ss += v[j][0] * v[j][0] + v[j][1] * v[j][1] + v[j][2] * v[j][2] + v[j][3] * v[j][3]; }
        const float rstd = rsqrtf(wave_sum(ss) * (1.0f / 1024.0f) + 1e-6f);
#pragma unroll
        for (int j = 0; j < 4; ++j) { const f32x4 w = *(const f32x4*)(p.norm_f + 4 * lane + 256 * j); *(f32x4*)(Y + (size_t)row * DM + 4 * lane + 256 * j) = v[j] * rstd * w; }
    }
}

__device__ __forceinline__ void unpack8(const v4u r, float (&f)[8]) { f[0] = bflo(r.x); f[1] = bfhi(r.x); f[2] = bflo(r.y); f[3] = bfhi(r.y); f[4] = bflo(r.z); f[5] = bfhi(r.z); f[6] = bflo(r.w); f[7] = bfhi(r.w); }
__device__ __forceinline__ void load8f(const float* p, float (&f)[8]) { const f32x4 a = *(const f32x4*)p, b = *(const f32x4*)(p + 4); f[0] = a[0]; f[1] = a[1]; f[2] = a[2]; f[3] = a[3]; f[4] = b[0]; f[5] = b[1]; f[6] = b[2]; f[7] = b[3]; }
__device__ __forceinline__ void phase_qkv_naive(const Params& p, const bf16_t* PROJ, const float* EX, float* QF, float* KF, float* VF, float* BG, bf16_t* YA, int wave, int lane) {
    const int gw = wave * gridDim.x + blockIdx.x, ngw = gridDim.x * NWAVES;
    const v4u zero4 = {0u, 0u, 0u, 0u};
    for (int tok = gw; tok < NTOK; tok += ngw) {
        const int pos = tok < NCTX ? (tok & 255) : ((tok - NCTX) & 63); const int L = tok < NCTX ? 256 : 64;
        const bool hasL = pos != 0, hasR = pos != L - 1;
#pragma unroll 1
        for (int grp = 0; grp < 6; ++grp) {
            const int part = grp >> 1, ch0 = (grp & 1) * 512 + lane * 8;
            const bf16_t* src = PROJ + (size_t)(3 + part) * BLK + (size_t)tok * DM + ch0;
            float c[8], l[8], r[8], w0[8], w1[8], w2[8], y[8];
            unpack8(*(const v4u*)src, c); unpack8(hasL ? *(const v4u*)(src - DM) : zero4, l); unpack8(hasR ? *(const v4u*)(src + DM) : zero4, r);
            const float* cw = p.dn_conv_w + part * 1024 + ch0;
            load8f(cw, w0); load8f(cw + 3072, w1); load8f(cw + 6144, w2);
            float ss = 0.f;
#pragma unroll
            for (int e = 0; e < 8; ++e) { y[e] = siluf(w0[e] * l[e] + w1[e] * c[e] + w2[e] * r[e]); ss += y[e] * y[e]; }
            if (part < 2) { const float sc = rsqrtf(sum16(ss) + 1e-6f) * (part == 0 ? 0.08838834764831845f : 1.0f);
#pragma unroll
                for (int e = 0; e < 8; ++e) y[e] *= sc; }
            float* dst = (part == 0 ? QF : part == 1 ? KF : VF) + (size_t)tok * DM + ch0;
            f32x4 o0 = {y[0], y[1], y[2], y[3]}, o1 = {y[4], y[5], y[6], y[7]};
            *(f32x4*)dst = o0; *(f32x4*)(dst + 4) = o1;
        }
#pragma unroll 1
        for (int grp = 0; grp < 2; ++grp) {
            const int ch0 = grp * 512 + lane * 8; const size_t o = (size_t)tok * DM + ch0;
            float bg[8], cc[8], cl[8], cr[8], xc[8], xl[8], xr[8], w0[8], w1[8], w2[8];
            unpack8(*(const v4u*)(PROJ + o), bg);
            unpack8(*(const v4u*)(PROJ + BLK + o), cc); unpack8(hasL ? *(const v4u*)(PROJ + BLK + o - DM) : zero4, cl); unpack8(hasR ? *(const v4u*)(PROJ + BLK + o + DM) : zero4, cr);
            unpack8(*(const v4u*)(PROJ + 2 * BLK + o), xc); unpack8(hasL ? *(const v4u*)(PROJ + 2 * BLK + o - DM) : zero4, xl); unpack8(hasR ? *(const v4u*)(PROJ + 2 * BLK + o + DM) : zero4, xr);
            load8f(p.conv_w + ch0, w0); load8f(p.conv_w + 1024 + ch0, w1); load8f(p.conv_w + 2048 + ch0, w2);
            float y[8];
#pragma unroll
            for (int e = 0; e < 8; ++e) y[e] = bg[e] * (w0[e] * cl[e] * xl[e] + w1[e] * cc[e] * xc[e] + w2[e] * cr[e] * xr[e]);
            v4u ov; ov.x = pk2bf(y[0], y[1]); ov.y = pk2bf(y[2], y[3]); ov.z = pk2bf(y[4], y[5]); ov.w = pk2bf(y[6], y[7]);
            *(v4u*)(YA + o) = ov;
        }
        if (lane < 16) {
            const float b_raw = EX[(size_t)tok * 32 + lane], a_raw = EX[(size_t)tok * 32 + 16 + lane];
            const float xx = a_raw + p.dn_dt_bias[lane]; const float sp = xx > 20.f ? xx : log1pf(expf(xx));
            BG[(size_t)tok * 32 + lane] = 1.f / (1.f + expf(-b_raw));
            BG[(size_t)tok * 32 + 16 + lane] = -expf(p.dn_a_log[lane]) * sp;
        }
    }
}

__device__ __forceinline__ void dn_naive_item(const Params& p, const float* QF, const float* KF, const float* VF, const float* BG, float* OF, float* OBk, float* lds, int item) {
    const bool lat = item < 32; const int j = lat ? item : item - 32; const int b = j >> 4, h = (j >> 1) & 7, dir = j & 1;
    const int T = lat ? 1024 : 256; const int tok0 = lat ? NCTX + b * 1024 : b * 256;
    const int tid = threadIdx.x, v = tid & 127, kq = tid >> 7;
    float* qs = lds; float* ks = lds + 128; float* vs = lds + 256; float* gb = lds + 384; float* red = lds + 512; float* red2 = lds + 1024;
    float S[32];
    if (lat) { const float* s0 = (dir ? p.st_b : p.st_f) + ((size_t)(b * 8 + h) * 128) * 128;
#pragma unroll
        for (int i = 0; i < 32; ++i) S[i] = s0[(size_t)(kq * 32 + i) * 128 + v]; }
    else {
#pragma unroll
        for (int i = 0; i < 32; ++i) S[i] = 0.f; }
    float* Od = dir ? OBk : OF;
    for (int t = 0; t < T; ++t) {
        const int tok = tok0 + (dir ? T - 1 - t : t);
        __syncthreads();
        if (tid < 128) qs[tid] = QF[(size_t)tok * DM + h * 128 + tid];
        else if (tid < 256) ks[tid - 128] = KF[(size_t)tok * DM + h * 128 + tid - 128];
        else if (tid < 384) vs[tid - 256] = VF[(size_t)tok * DM + h * 128 + tid - 256];
        else if (tid == 384) gb[0] = BG[(size_t)tok * 32 + dir * 8 + h];
        else if (tid == 385) gb[1] = BG[(size_t)tok * 32 + 16 + dir * 8 + h];
        __syncthreads();
        float part = 0.f;
#pragma unroll
        for (int i = 0; i < 32; ++i) part += ks[kq * 32 + i] * S[i];
        red[kq * 128 + v] = part;
        __syncthreads();
        const float kS = red[v] + red[128 + v] + red[256 + v] + red[384 + v];
        const float eg = expf(gb[1]), beta = gb[0];
        const float delta = beta * (vs[v] - eg * kS);
        float op = 0.f;
#pragma unroll
        for (int i = 0; i < 32; ++i) { S[i] = eg * S[i] + ks[kq * 32 + i] * delta; op += qs[kq * 32 + i] * S[i]; }
        red2[kq * 128 + v] = op;
        __syncthreads();
        if (kq == 0) Od[(size_t)tok * DM + h * 128 + v] = red2[v] + red2[128 + v] + red2[256 + v] + red2[384 + v];
    }
    if (!lat) { float* so = p.out + (size_t)NTOK * DM + (size_t)dir * (16 * 8 * 128 * 128) + ((size_t)(b * 8 + h) * 128) * 128;
#pragma unroll
        for (int i = 0; i < 32; ++i) so[(size_t)(kq * 32 + i) * 128 + v] = S[i]; }
}
__device__ __forceinline__ void phase_dn_naive(const Params& p, const float* QF, const float* KF, const float* VF, const float* BG, float* OF, float* OBk, float* lds) {
    const int bx = blockIdx.x;
    if (gridDim.x >= 256) {
        if (bx < 32) dn_naive_item(p, QF, KF, VF, BG, OF, OBk, lds, bx);
        else if (bx < 256) { dn_naive_item(p, QF, KF, VF, BG, OF, OBk, lds, bx); if (bx < 64) dn_naive_item(p, QF, KF, VF, BG, OF, OBk, lds, 224 + bx); }
    } else { for (int it = bx; it < 288; it += gridDim.x) dn_naive_item(p, QF, KF, VF, BG, OF, OBk, lds, it); }
}

typedef short bf16x8 __attribute__((ext_vector_type(8)));
typedef float f32x16 __attribute__((ext_vector_type(16)));
#define MFMA32(a, b, c) __builtin_amdgcn_mfma_f32_32x32x16_bf16((a), (b), (c), 0, 0, 0)
constexpr int DN_ITEM_BYTES = 73728, DN_W = 0, DN_QD = 16384, DN_KD = 32768, DN_A = 49152, DN_U = 57344;
constexpr int LS = 132;
constexpr int LMS = 68, LMD = 64 * LMS;
constexpr int L_QF = 0, L_KF = 33792, L_VF = 67584, L_LM = 101376, L_CO = 136192;
__device__ __forceinline__ int crow16(int i, int hh) { return (i & 3) + 8 * (i >> 2) + 4 * hh; }
__device__ __forceinline__ bf16x8 frag_from_f32(const float* p) { const f32x4 a = *(const f32x4*)p, b = *(const f32x4*)(p + 4);
    v4u r; r.x = pk2bf(a[0], a[1]); r.y = pk2bf(a[2], a[3]); r.z = pk2bf(b[0], b[1]); r.w = pk2bf(b[2], b[3]); return __builtin_bit_cast(bf16x8, r); }
template <int S> __device__ __forceinline__ bf16x8 pack_step(const f32x16& x) {
    v4u r; r.x = pk2bf(x[8 * S + 0], x[8 * S + 1]); r.y = pk2bf(x[8 * S + 2], x[8 * S + 3]); r.z = pk2bf(x[8 * S + 4], x[8 * S + 5]); r.w = pk2bf(x[8 * S + 6], x[8 * S + 7]); return __builtin_bit_cast(bf16x8, r); }

__device__ __forceinline__ void split_hi_lo(const float* p, bf16x8& hi, bf16x8& lo) {
    const f32x4 a = *(const f32x4*)p, b = *(const f32x4*)(p + 4);
    v4u h; h.x = pk2bf(a[0], a[1]); h.y = pk2bf(a[2], a[3]); h.z = pk2bf(b[0], b[1]); h.w = pk2bf(b[2], b[3]);
    v4u l; l.x = pk2bf(a[0] - bflo(h.x), a[1] - bfhi(h.x)); l.y = pk2bf(a[2] - bflo(h.y), a[3] - bfhi(h.y)); l.z = pk2bf(b[0] - bflo(h.z), b[1] - bfhi(h.z)); l.w = pk2bf(b[2] - bflo(h.w), b[3] - bfhi(h.w));
    hi = __builtin_bit_cast(bf16x8, h); lo = __builtin_bit_cast(bf16x8, l);
}
__device__ __forceinline__ void dn_pre_item(const Params& p, const bf16_t* PROJ, const float* EX, unsigned char* DN, float* GL, unsigned char* lds, int sc, int h) {
    int tid_l = threadIdx.x; asm volatile("" : "+v"(tid_l));
    const int tid = tid_l, lane = tid & 63, wave = tid >> 6;
    const bool ctx = sc < 64; const int nn = ctx ? (sc & 3) : ((sc - 64) & 15);
    const int tok0 = ctx ? (sc >> 2) * 256 + 64 * nn : NCTX + ((sc - 64) >> 4) * 1024 + 64 * nn;
    float* QFl = (float*)(lds + L_QF); float* KFl = (float*)(lds + L_KF); float* VFl = (float*)(lds + L_VF); float* LM = (float*)(lds + L_LM);
    float* CB = (float*)(lds + L_CO);
    float* CG = CB + 128;
    float* CW = CB + 256;
    float* CE = CB + 384;
    float* CK = CB + 512;
    const v4u zero4 = {0u, 0u, 0u, 0u};
    unsigned char* item0 = DN + (size_t)((sc * 8 + h) * 2) * DN_ITEM_BYTES;
    float b_raw = 0.f, a_raw = 0.f, dtb = 0.f, alog = 0.f;
    if (wave < 2) { const int oc = wave ? 63 - lane : lane; const size_t tk = (size_t)(tok0 + oc) * 32;
        b_raw = EX[tk + wave * 8 + h]; a_raw = EX[tk + 16 + wave * 8 + h]; dtb = p.dn_dt_bias[wave * 8 + h]; alog = p.dn_a_log[wave * 8 + h]; }
    {
        const int g = tid >> 4, sub = tid & 15, part = g % 3, tslot = g / 3, d0 = sub * 8;
        if (g < 30) {
            float w0[8], w1[8], w2[8];
            const float* cw = p.dn_conv_w + part * 1024 + h * 128 + d0;
            load8f(cw, w0); load8f(cw + 3072, w1); load8f(cw + 6144, w2);
            const bf16_t* src0 = PROJ + (size_t)(3 + part) * BLK + (size_t)tok0 * DM + h * 128 + d0;
            v4u dc[7], dl[7], dr[7];
#pragma unroll
            for (int jj = 0; jj < 7; ++jj) { const int c = tslot + 10 * jj;
                if (c < 64) { const bool hasL = c > 0 || (ctx && nn > 0), hasR = c < 63 || (ctx && nn < 3); const bf16_t* src = src0 + (size_t)c * DM;
                    dc[jj] = *(const v4u*)src; dl[jj] = hasL ? *(const v4u*)(src - DM) : zero4; dr[jj] = hasR ? *(const v4u*)(src + DM) : zero4; } }
            float* img = part == 0 ? QFl : part == 1 ? KFl : VFl;
#pragma unroll
            for (int jj = 0; jj < 7; ++jj) { const int c = tslot + 10 * jj;
                if (c < 64) {
                    float cc[8], l[8], r[8], y[8];
                    unpack8(dc[jj], cc); unpack8(dl[jj], l); unpack8(dr[jj], r);
                    float ss = 0.f;
#pragma unroll
                    for (int e2 = 0; e2 < 8; ++e2) { y[e2] = siluf(w0[e2] * l[e2] + w1[e2] * cc[e2] + w2[e2] * r[e2]); ss += y[e2] * y[e2]; }
                    const float tot = sum16(ss);
                    if (part < 2) { const float scl = rsqrtf(tot + 1e-6f) * (part == 0 ? 0.08838834764831845f : 1.0f);
#pragma unroll
                        for (int e2 = 0; e2 < 8; ++e2) y[e2] *= scl; }
                    float* dst = img + c * LS + d0;
                    f32x4 o0 = {y[0], y[1], y[2], y[3]}, o1 = {y[4], y[5], y[6], y[7]};
                    *(f32x4*)dst = o0; *(f32x4*)(dst + 4) = o1;
                } }
        }
    }
    if (wave < 2) {
        const int d = wave;
        const float xx = a_raw + dtb; const float sp = xx > 20.f ? xx : log1pf(__expf(xx));
        const float beta = sigmf(b_raw); float g = -__expf(alog) * sp;
#pragma unroll
        for (int o = 1; o < 64; o <<= 1) { const float t = __shfl_up(g, o); if (lane >= o) g += t; }
        const float glast = __shfl(g, 63); const float eg = __expf(g);
        CB[d * 64 + lane] = beta; CG[d * 64 + lane] = g; CW[d * 64 + lane] = beta * eg; CE[d * 64 + lane] = eg; CK[d * 64 + lane] = __expf(glast - g);
        if (lane == 0) GL[(sc * 8 + h) * 2 + d] = __expf(glast);
    }
    __syncthreads();
    const int dir = wave >> 2;
    unsigned char* item = item0 + (size_t)dir * DN_ITEM_BYTES;
    {
        const int w4 = wave & 3, mt = w4 >> 1, nt = w4 & 1, r = lane & 31, hh = lane >> 5;
        const int ia = 32 * mt + r, ib = 32 * nt + r; const int ca = dir ? 63 - ia : ia, cb = dir ? 63 - ib : ib;
        f32x16 kk, pp;
#pragma unroll
        for (int i = 0; i < 16; ++i) { kk[i] = 0.f; pp[i] = 0.f; }
#pragma unroll
        for (int ks = 0; ks < 8; ++ks) {
            const bf16x8 ka = frag_from_f32(KFl + ca * LS + 16 * ks + 8 * hh), kb = frag_from_f32(KFl + cb * LS + 16 * ks + 8 * hh), qb = frag_from_f32(QFl + cb * LS + 16 * ks + 8 * hh);
            kk = MFMA32(ka, kb, kk); pp = MFMA32(ka, qb, pp);
        }
        const float* gcd = CG + dir * 64; const float* btd = CB + dir * 64;
        const float g_col = gcd[ib];
        f32x16 pv;
#pragma unroll
        for (int i = 0; i < 16; ++i) {
            const int row = 32 * mt + crow16(i, hh); const float g_row = gcd[row];
            LM[dir * LMD + row * LMS + ib] = (ib < row) ? btd[row] * kk[i] * __expf(g_row - g_col) : 0.f;
            pv[i] = (row <= ib) ? pp[i] * __expf(g_col - g_row) : 0.f;
        }
        v4u* af = (v4u*)(item + DN_A);
        af[(nt * 4 + mt * 2 + 0) * 64 + lane] = __builtin_bit_cast(v4u, pack_step<0>(pv));
        af[(nt * 4 + mt * 2 + 1) * 64 + lane] = __builtin_bit_cast(v4u, pack_step<1>(pv));
    }
    __syncthreads();
    float x[64];
    if (wave < 2) {
        const float* Lm = LM + wave * LMD;
#pragma unroll
        for (int c = 0; c < 64; ++c) {
            float acc = (c == lane) ? 1.f : 0.f;
#pragma unroll
            for (int s = 0; s < c; ++s) acc -= Lm[c * LMS + s] * x[s];
            x[c] = acc;
        }
    } else {
#pragma unroll 1
        for (int idx = tid - 128; idx < 4096; idx += 384) {
            const int d = idx >> 11, kd = (idx >> 10) & 1, f = (idx >> 6) & 15, ln = idx & 63, r = ln & 31, hh = ln >> 5;
            unsigned char* itd = item0 + (size_t)d * DN_ITEM_BYTES;
            if (kd == 0) {
                const int mt = f >> 3, ks8 = f & 7, cp = 32 * mt + r, oc = d ? 63 - cp : cp, dkb = 16 * ks8 + 4 * hh;
                const f32x4 qa = *(const f32x4*)(QFl + oc * LS + dkb), qb = *(const f32x4*)(QFl + oc * LS + dkb + 8); const float e = CE[d * 64 + cp];
                v4u qv; qv.x = pk2bf(qa[0] * e, qa[1] * e); qv.y = pk2bf(qa[2] * e, qa[3] * e); qv.z = pk2bf(qb[0] * e, qb[1] * e); qv.w = pk2bf(qb[2] * e, qb[3] * e);
                ((v4u*)(itd + DN_QD))[f * 64 + ln] = qv;
            } else {
                const int mtK = f >> 2, kst = f & 3, dk = 32 * mtK + r, sb = 16 * kst + 4 * hh;
                float kv[8];
#pragma unroll
                for (int j = 0; j < 8; ++j) { const int sp = sb + (j & 3) + 8 * (j >> 2); const int os = d ? 63 - sp : sp; kv[j] = KFl[os * LS + dk] * CK[d * 64 + sp]; }
                v4u kq; kq.x = pk2bf(kv[0], kv[1]); kq.y = pk2bf(kv[2], kv[3]); kq.z = pk2bf(kv[4], kv[5]); kq.w = pk2bf(kv[6], kv[7]);
                ((v4u*)(itd + DN_KD))[f * 64 + ln] = kq;
            }
        }
    }
    __syncthreads();
    if (wave < 2) {
#pragma unroll
        for (int c = 0; c < 64; ++c) LM[wave * LMD + c * LMS + lane] = x[c];
    }
    __syncthreads();
    {
        const int w4 = wave & 3, r = lane & 31, hh = lane >> 5;
        const float* TI = LM + dir * LMD; const float* cbd = CB + dir * 64; const float* cwd = CW + dir * 64;
#pragma unroll 1
        for (int tt = 0; tt < 2; ++tt) {
            {
                const int tix = w4 * 2 + tt, jj = tix >> 1, mt = tix & 1;
                f32x16 acc;
#pragma unroll
                for (int i = 0; i < 16; ++i) acc[i] = 0.f;
#pragma unroll
                for (int ks = 0; ks < 4; ++ks) {
                    bf16x8 ah, al; split_hi_lo(TI + (32 * mt + r) * LMS + 16 * ks + 8 * hh, ah, al);
                    float bv[8];
#pragma unroll
                    for (int j = 0; j < 8; ++j) { const int s = 16 * ks + 8 * hh + j; const int os = dir ? 63 - s : s; bv[j] = VFl[os * LS + 32 * jj + r] * cbd[s]; }
                    v4u bb; bb.x = pk2bf(bv[0], bv[1]); bb.y = pk2bf(bv[2], bv[3]); bb.z = pk2bf(bv[4], bv[5]); bb.w = pk2bf(bv[6], bv[7]);
                    const bf16x8 b = __builtin_bit_cast(bf16x8, bb);
                    acc = MFMA32(ah, b, acc); acc = MFMA32(al, b, acc);
                }
                v4u lo, hi;
                lo.x = pk2bf(acc[0], acc[1]); lo.y = pk2bf(acc[2], acc[3]); lo.z = pk2bf(acc[4], acc[5]); lo.w = pk2bf(acc[6], acc[7]);
                hi.x = pk2bf(acc[8], acc[9]); hi.y = pk2bf(acc[10], acc[11]); hi.z = pk2bf(acc[12], acc[13]); hi.w = pk2bf(acc[14], acc[15]);
                v4u* dst = (v4u*)(item + DN_U + (size_t)(((jj * 2 + mt) * 64 + lane) * 32));
                dst[0] = lo; dst[1] = hi;
            }
            {
                const int tix = w4 * 2 + tt, mtK = tix >> 1, nt = tix & 1;
                f32x16 acc;
#pragma unroll
                for (int i = 0; i < 16; ++i) acc[i] = 0.f;
#pragma unroll
                for (int ks = 0; ks < 4; ++ks) {
                    bf16x8 bh, bl; split_hi_lo(TI + (32 * nt + r) * LMS + 16 * ks + 8 * hh, bh, bl);
                    float av[8];
#pragma unroll
                    for (int j = 0; j < 8; ++j) { const int s = 16 * ks + 8 * hh + j; const int os = dir ? 63 - s : s; av[j] = KFl[os * LS + 32 * mtK + r] * cwd[s]; }
                    v4u aa; aa.x = pk2bf(av[0], av[1]); aa.y = pk2bf(av[2], av[3]); aa.z = pk2bf(av[4], av[5]); aa.w = pk2bf(av[6], av[7]);
                    const bf16x8 a = __builtin_bit_cast(bf16x8, aa);
                    acc = MFMA32(a, bh, acc); acc = MFMA32(a, bl, acc);
                }
                v4u* wf = (v4u*)(item + DN_W);
                wf[(nt * 8 + mtK * 2 + 0) * 64 + lane] = __builtin_bit_cast(v4u, pack_step<0>(acc));
                wf[(nt * 8 + mtK * 2 + 1) * 64 + lane] = __builtin_bit_cast(v4u, pack_step<1>(acc));
            }
        }
    }
    __syncthreads();
}

__device__ __forceinline__ void phase_branch_a(const Params& p, const bf16_t* PROJ, bf16_t* YA, int wave, int lane) {
    const int gw = wave * gridDim.x + blockIdx.x, ngw = gridDim.x * NWAVES;
    const v4u zero4 = {0u, 0u, 0u, 0u};
    for (int tok = gw; tok < NTOK; tok += ngw) {
        const int pos = tok < NCTX ? (tok & 255) : ((tok - NCTX) & 63); const int L = tok < NCTX ? 256 : 64;
        const bool hasL = pos != 0, hasR = pos != L - 1;
#pragma unroll 1
        for (int grp = 0; grp < 2; ++grp) {
            const int ch0 = grp * 512 + lane * 8; const size_t o = (size_t)tok * DM + ch0;
            float bg[8], cc[8], cl[8], cr[8], xc[8], xl[8], xr[8], w0[8], w1[8], w2[8];
            unpack8(*(const v4u*)(PROJ + o), bg);
            unpack8(*(const v4u*)(PROJ + BLK + o), cc); unpack8(hasL ? *(const v4u*)(PROJ + BLK + o - DM) : zero4, cl); unpack8(hasR ? *(const v4u*)(PROJ + BLK + o + DM) : zero4, cr);
            unpack8(*(const v4u*)(PROJ + 2 * BLK + o), xc); unpack8(hasL ? *(const v4u*)(PROJ + 2 * BLK + o - DM) : zero4, xl); unpack8(hasR ? *(const v4u*)(PROJ + 2 * BLK + o + DM) : zero4, xr);
            load8f(p.conv_w + ch0, w0); load8f(p.conv_w + 1024 + ch0, w1); load8f(p.conv_w + 2048 + ch0, w2);
            float y[8];
#pragma unroll
            for (int e = 0; e < 8; ++e) y[e] = bg[e] * (w0[e] * cl[e] * xl[e] + w1[e] * cc[e] * xc[e] + w2[e] * cr[e] * xr[e]);
            v4u ov; ov.x = pk2bf(y[0], y[1]); ov.y = pk2bf(y[2], y[3]); ov.z = pk2bf(y[4], y[5]); ov.w = pk2bf(y[6], y[7]);
            *(v4u*)(YA + o) = ov;
        }
    }
}

__device__ __forceinline__ void dn_scan_item(const Params& p, const unsigned char* DN, const float* GL, float* OF, float* OBk, int it, int lane) {
    const bool lat = it < 128; const int q = lat ? it : it - 128;
    const int jj = q & 3, dir = (q >> 2) & 1, h = (q >> 3) & 7, b = q >> 6;
    const int nch = lat ? 16 : 4, scb = lat ? 64 + 16 * b : 4 * b, tokb = lat ? NCTX + b * 1024 : b * 256;
    const int n = lane & 31, hh = lane >> 5;
    f32x16 S[4];
    if (lat) { const float* s0 = (dir ? p.st_b : p.st_f) + (size_t)(b * 8 + h) * 16384 + 32 * jj + n;
#pragma unroll
        for (int m = 0; m < 4; ++m)
#pragma unroll
            for (int i = 0; i < 16; ++i) S[m][i] = s0[(size_t)(32 * m + crow16(i, hh)) * 128]; }
    else {
#pragma unroll
        for (int m = 0; m < 4; ++m)
#pragma unroll
            for (int i = 0; i < 16; ++i) S[m][i] = 0.f; }
    float* Od = (dir ? OBk : OF) + h * 128 + 32 * jj + n;
#pragma unroll 1
    for (int ci = 0; ci < nch; ++ci) {
        const int no = dir ? nch - 1 - ci : ci; const int id = ((scb + no) * 8 + h) * 2 + dir;
        const unsigned char* item = DN + (size_t)id * DN_ITEM_BYTES;
        const v4u* Wf = (const v4u*)(item + DN_W) + lane; const v4u* Qf = (const v4u*)(item + DN_QD) + lane; const v4u* Kf = (const v4u*)(item + DN_KD) + lane; const v4u* Af = (const v4u*)(item + DN_A) + lane;
        const float gl = GL[id];
        bf16x8 Sb[8];
        Sb[0] = pack_step<0>(S[0]); Sb[1] = pack_step<1>(S[0]); Sb[2] = pack_step<0>(S[1]); Sb[3] = pack_step<1>(S[1]);
        Sb[4] = pack_step<0>(S[2]); Sb[5] = pack_step<1>(S[2]); Sb[6] = pack_step<0>(S[3]); Sb[7] = pack_step<1>(S[3]);
        f32x16 vn[2], o[2];
#pragma unroll
        for (int mt = 0; mt < 2; ++mt) {
            f32x16 ws;
#pragma unroll
            for (int i = 0; i < 16; ++i) { ws[i] = 0.f; o[mt][i] = 0.f; }
#pragma unroll
            for (int ks = 0; ks < 8; ++ks) { ws = MFMA32(__builtin_bit_cast(bf16x8, Wf[(mt * 8 + ks) * 64]), Sb[ks], ws); o[mt] = MFMA32(__builtin_bit_cast(bf16x8, Qf[(mt * 8 + ks) * 64]), Sb[ks], o[mt]); }
            const v4u* up = (const v4u*)(item + DN_U + (size_t)(((jj * 2 + mt) * 64 + lane) * 32));
            const v4u u0 = up[0], u1 = up[1];
            vn[mt][0] = bflo(u0.x) - ws[0]; vn[mt][1] = bfhi(u0.x) - ws[1]; vn[mt][2] = bflo(u0.y) - ws[2]; vn[mt][3] = bfhi(u0.y) - ws[3];
            vn[mt][4] = bflo(u0.z) - ws[4]; vn[mt][5] = bfhi(u0.z) - ws[5]; vn[mt][6] = bflo(u0.w) - ws[6]; vn[mt][7] = bfhi(u0.w) - ws[7];
            vn[mt][8] = bflo(u1.x) - ws[8]; vn[mt][9] = bfhi(u1.x) - ws[9]; vn[mt][10] = bflo(u1.y) - ws[10]; vn[mt][11] = bfhi(u1.y) - ws[11];
            vn[mt][12] = bflo(u1.z) - ws[12]; vn[mt][13] = bfhi(u1.z) - ws[13]; vn[mt][14] = bflo(u1.w) - ws[14]; vn[mt][15] = bfhi(u1.w) - ws[15];
        }
        bf16x8 Vb[4];
        Vb[0] = pack_step<0>(vn[0]); Vb[1] = pack_step<1>(vn[0]); Vb[2] = pack_step<0>(vn[1]); Vb[3] = pack_step<1>(vn[1]);
#pragma unroll
        for (int mt = 0; mt < 2; ++mt)
#pragma unroll
            for (int kst = 0; kst < 4; ++kst) o[mt] = MFMA32(__builtin_bit_cast(bf16x8, Af[(mt * 4 + kst) * 64]), Vb[kst], o[mt]);
#pragma unroll
        for (int m = 0; m < 4; ++m) {
#pragma unroll
            for (int i = 0; i < 16; ++i) S[m][i] *= gl;
#pragma unroll
            for (int kst = 0; kst < 4; ++kst) S[m] = MFMA32(__builtin_bit_cast(bf16x8, Kf[(m * 4 + kst) * 64]), Vb[kst], S[m]);
        }
        const int tok0 = tokb + 64 * no;
#pragma unroll
        for (int mt = 0; mt < 2; ++mt)
#pragma unroll
            for (int i = 0; i < 16; ++i) { const int cp = 32 * mt + crow16(i, hh); const int oc = dir ? 63 - cp : cp; Od[(size_t)(tok0 + oc) * DM] = o[mt][i]; }
    }
    if (!lat) { float* so = p.out + (size_t)NTOK * DM + (size_t)dir * (16 * 8 * 128 * 128) + (size_t)(b * 8 + h) * 16384 + 32 * jj + n;
#pragma unroll
        for (int m = 0; m < 4; ++m)
#pragma unroll
            for (int i = 0; i < 16; ++i) so[(size_t)(32 * m + crow16(i, hh)) * 128] = S[m][i]; }
}

constexpr int SC_BUF = 57344;
__device__ __forceinline__ void dn_scan_group(const Params& p, const unsigned char* DN, const float* GL, float* OF, float* OBk, unsigned char* lds, int grp) {
    int tid_l = threadIdx.x; asm volatile("" : "+v"(tid_l));
    const int tid = tid_l, lane = tid & 63, wave = __builtin_amdgcn_readfirstlane(tid >> 6);
    const bool lat = grp < 32; const int q = lat ? grp : grp - 32;
    const int dir = q & 1, h = (q >> 1) & 7, b = q >> 4;
    const int nch = lat ? 16 : 4, scb = lat ? 64 + 16 * b : 4 * b, tokb = lat ? NCTX + b * 1024 : b * 256;
    if (wave >= 4) {
        const int lt = tid - 256;
        v4u r[14];
        {   const v4u* src = (const v4u*)(DN + (size_t)(((scb + (dir ? nch - 1 : 0)) * 8 + h) * 2 + dir) * DN_ITEM_BYTES) + lt;
#pragma unroll
            for (int k = 0; k < 14; ++k) r[k] = src[256 * k];
            v4u* dst = (v4u*)lds + lt;
#pragma unroll
            for (int k = 0; k < 14; ++k) dst[256 * k] = r[k]; }
        {   const v4u* src = (const v4u*)(DN + (size_t)(((scb + (dir ? nch - 2 : 1)) * 8 + h) * 2 + dir) * DN_ITEM_BYTES) + lt;
#pragma unroll
            for (int k = 0; k < 14; ++k) r[k] = src[256 * k]; }
        __syncthreads();
#pragma unroll 1
        for (int ci = 0; ci < nch; ++ci) {
            if (ci + 1 < nch) { v4u* dst = (v4u*)(lds + ((ci + 1) & 1) * SC_BUF) + lt;
#pragma unroll
                for (int k = 0; k < 14; ++k) dst[256 * k] = r[k]; }
            if (ci + 2 < nch) { const int no = dir ? nch - 3 - ci : ci + 2;
                const v4u* src = (const v4u*)(DN + (size_t)(((scb + no) * 8 + h) * 2 + dir) * DN_ITEM_BYTES) + lt;
#pragma unroll
                for (int k = 0; k < 14; ++k) r[k] = src[256 * k]; }
            __syncthreads();
        }
    } else {
        const int jj = wave, n = lane & 31, hh = lane >> 5;
        f32x16 S[4];
        if (lat) { const float* s0 = (dir ? p.st_b : p.st_f) + (size_t)(b * 8 + h) * 16384 + 32 * jj + n;
#pragma unroll
            for (int m = 0; m < 4; ++m)
#pragma unroll
                for (int i = 0; i < 16; ++i) S[m][i] = s0[(size_t)(32 * m + crow16(i, hh)) * 128]; }
        else {
#pragma unroll
            for (int m = 0; m < 4; ++m)
#pragma unroll
                for (int i = 0; i < 16; ++i) S[m][i] = 0.f; }
        float* Od = (dir ? OBk : OF) + h * 128 + 32 * jj + n;
        v4u un[4]; float gln;
        {   const int id0 = ((scb + (dir ? nch - 1 : 0)) * 8 + h) * 2 + dir; const unsigned char* it0 = DN + (size_t)id0 * DN_ITEM_BYTES + DN_U;
            const v4u* u0 = (const v4u*)(it0 + (size_t)(((jj * 2 + 0) * 64 + lane) * 32)); const v4u* u1 = (const v4u*)(it0 + (size_t)(((jj * 2 + 1) * 64 + lane) * 32));
            un[0] = u0[0]; un[1] = u0[1]; un[2] = u1[0]; un[3] = u1[1]; gln = GL[id0]; }
        __syncthreads();
#pragma unroll 1
        for (int ci = 0; ci < nch; ++ci) {
            const int no = dir ? nch - 1 - ci : ci;
            const float gl = gln;
            const unsigned char* buf = lds + (ci & 1) * SC_BUF;
            const v4u* Wf = (const v4u*)(buf + DN_W) + lane; const v4u* Qf = (const v4u*)(buf + DN_QD) + lane; const v4u* Kf = (const v4u*)(buf + DN_KD) + lane; const v4u* Af = (const v4u*)(buf + DN_A) + lane;
            f32x16 vn[2], o[2];
            {
                bf16x8 Sb[8];
                Sb[0] = pack_step<0>(S[0]); Sb[1] = pack_step<1>(S[0]); Sb[2] = pack_step<0>(S[1]); Sb[3] = pack_step<1>(S[1]);
                Sb[4] = pack_step<0>(S[2]); Sb[5] = pack_step<1>(S[2]); Sb[6] = pack_step<0>(S[3]); Sb[7] = pack_step<1>(S[3]);
#pragma unroll
                for (int mt = 0; mt < 2; ++mt) {
                    f32x16 ws;
#pragma unroll
                    for (int i = 0; i < 16; ++i) { ws[i] = 0.f; o[mt][i] = 0.f; }
#pragma unroll
                    for (int ks = 0; ks < 8; ++ks) { ws = MFMA32(__builtin_bit_cast(bf16x8, Wf[(mt * 8 + ks) * 64]), Sb[ks], ws); o[mt] = MFMA32(__builtin_bit_cast(bf16x8, Qf[(mt * 8 + ks) * 64]), Sb[ks], o[mt]); }
                    const v4u u0 = un[2 * mt], u1 = un[2 * mt + 1];
                    vn[mt][0] = bflo(u0.x) - ws[0]; vn[mt][1] = bfhi(u0.x) - ws[1]; vn[mt][2] = bflo(u0.y) - ws[2]; vn[mt][3] = bfhi(u0.y) - ws[3];
                    vn[mt][4] = bflo(u0.z) - ws[4]; vn[mt][5] = bfhi(u0.z) - ws[5]; vn[mt][6] = bflo(u0.w) - ws[6]; vn[mt][7] = bfhi(u0.w) - ws[7];
                    vn[mt][8] = bflo(u1.x) - ws[8]; vn[mt][9] = bfhi(u1.x) - ws[9]; vn[mt][10] = bflo(u1.y) - ws[10]; vn[mt][11] = bfhi(u1.y) - ws[11];
                    vn[mt][12] = bflo(u1.z) - ws[12]; vn[mt][13] = bfhi(u1.z) - ws[13]; vn[mt][14] = bflo(u1.w) - ws[14]; vn[mt][15] = bfhi(u1.w) - ws[15];
                    __builtin_amdgcn_sched_barrier(0);
                }
            }
            if (ci + 1 < nch) { const int no1 = dir ? nch - 2 - ci : ci + 1; const int id1 = ((scb + no1) * 8 + h) * 2 + dir; const unsigned char* it1 = DN + (size_t)id1 * DN_ITEM_BYTES + DN_U;
                const v4u* u0 = (const v4u*)(it1 + (size_t)(((jj * 2 + 0) * 64 + lane) * 32)); const v4u* u1 = (const v4u*)(it1 + (size_t)(((jj * 2 + 1) * 64 + lane) * 32));
                un[0] = u0[0]; un[1] = u0[1]; un[2] = u1[0]; un[3] = u1[1]; gln = GL[id1]; }
            bf16x8 Vb[4];
            Vb[0] = pack_step<0>(vn[0]); Vb[1] = pack_step<1>(vn[0]); Vb[2] = pack_step<0>(vn[1]); Vb[3] = pack_step<1>(vn[1]);
            __builtin_amdgcn_sched_barrier(0);
#pragma unroll
            for (int mt = 0; mt < 2; ++mt)
#pragma unroll
                for (int kst = 0; kst < 4; ++kst) o[mt] = MFMA32(__builtin_bit_cast(bf16x8, Af[(mt * 4 + kst) * 64]), Vb[kst], o[mt]);
            const int tok0 = tokb + 64 * no;
#pragma unroll
            for (int mt = 0; mt < 2; ++mt)
#pragma unroll
                for (int i = 0; i < 16; ++i) { const int cp = 32 * mt + crow16(i, hh); const int oc = dir ? 63 - cp : cp; Od[(size_t)(tok0 + oc) * DM] = o[mt][i]; }
            __builtin_amdgcn_sched_barrier(0);
#pragma unroll
            for (int m = 0; m < 4; ++m) {
#pragma unroll
                for (int i = 0; i < 16; ++i) S[m][i] *= gl;
#pragma unroll
                for (int kst = 0; kst < 4; ++kst) S[m] = MFMA32(__builtin_bit_cast(bf16x8, Kf[(m * 4 + kst) * 64]), Vb[kst], S[m]);
            }
            __builtin_amdgcn_sched_barrier(0);
            __syncthreads();
        }
        if (!lat) { float* so = p.out + (size_t)NTOK * DM + (size_t)dir * (16 * 8 * 128 * 128) + (size_t)(b * 8 + h) * 16384 + 32 * jj + n;
#pragma unroll
            for (int m = 0; m < 4; ++m)
#pragma unroll
                for (int i = 0; i < 16; ++i) so[(size_t)(32 * m + crow16(i, hh)) * 128] = S[m][i]; }
    }
}
__device__ __forceinline__ void phase_dn_scan(const Params& p, const unsigned char* DN, const float* GL, float* OF, float* OBk, unsigned char* lds) {
    const int bx = blockIdx.x;
    if (gridDim.x >= 256) {
        const int ng = (bx >= 32 && bx < 64) ? 2 : 1;
#pragma unroll 1
        for (int gi = 0; gi < ng; ++gi) dn_scan_group(p, DN, GL, OF, OBk, lds, gi ? 224 + bx : bx);
    } else { for (int g = bx; g < 288; g += gridDim.x) dn_scan_group(p, DN, GL, OF, OBk, lds, g); }
}

__device__ __forceinline__ void phase_ogate(const Params& p, const float* OF, const float* OBk, const bf16_t* Z, bf16_t* OG, int wave, int lane) {
    const int gw = wave * gridDim.x + blockIdx.x, ngw = gridDim.x * NWAVES;
    for (int tok = gw; tok < NTOK; tok += ngw) {
#pragma unroll
        for (int hf = 0; hf < 2; ++hf) {
            const int ch0 = hf * 512 + lane * 8; const size_t o = (size_t)tok * DM + ch0;
            float a[8], b2[8], z[8], nw[8];
            load8f(OF + o, a); load8f(OBk + o, b2); unpack8(*(const v4u*)(Z + o), z); load8f(p.dn_norm_w + (ch0 & 127), nw);
            float ss = 0.f;
#pragma unroll
            for (int e = 0; e < 8; ++e) { a[e] += b2[e]; ss += a[e] * a[e]; }
            const float r = rsqrtf(sum16(ss) * (1.0f / 128.0f) + 1e-6f);
            float y[8];
#pragma unroll
            for (int e = 0; e < 8; ++e) y[e] = a[e] * r * nw[e] * siluf(z[e]);
            v4u ov; ov.x = pk2bf(y[0], y[1]); ov.y = pk2bf(y[2], y[3]); ov.z = pk2bf(y[4], y[5]); ov.w = pk2bf(y[6], y[7]);
            *(v4u*)(OG + o) = ov;
        }
    }
}

template <class Epi> __device__ __forceinline__ void run_gemm(PG8_LAS unsigned char* lds, const bf16_t* A, const bf16_t* Bt, int N, int K, const Epi& E, int nrep, int split = 1) {
    pg8::Gemm g; g.A = A; g.Bt = Bt; g.M = NTOK; g.N = N; g.K = K; g.klen = K / split; g.nsp = N / 256;
    pg8::StaticOrder S; S.init(NTOK, N * split, (int)gridDim.x, (int)blockIdx.x);
    pg8::gemm_phase<Epi, pg8::StaticOrder, false>(lds, g, S, E, nullptr);
    __syncthreads();
}

__global__ void __launch_bounds__(512) fwd_megakernel(Params p) {
    extern __shared__ __attribute__((aligned(16))) unsigned char shm[];
    cg::grid_group grid = cg::this_grid();
    PG8_LAS unsigned char* lds3 = (PG8_LAS unsigned char*)shm;
    const int wave = __builtin_amdgcn_readfirstlane(threadIdx.x >> 6), lane = threadIdx.x & 63;
    unsigned char* ws = p.ws;
    volatile XLAS unsigned* xst = (volatile XLAS unsigned*)(lds3 + (LDS_BYTES - 16));
    if (threadIdx.x == 0) { xst[0] = 0u; xst[1] = 0u; }
    __syncthreads();
    XcdBarrier xb = xcd_barrier_post((unsigned*)(ws + OFF_BAR), xst);
    float* X0 = (float*)(ws + OFF_X0); float* X1 = (float*)(ws + OFF_X1); float* MOD = (float*)(ws + OFF_MOD);
    bf16_t* PROJ = (bf16_t*)(ws + OFF_PROJ); float* EX = (float*)(ws + OFF_EX);
    bf16_t* AM = (bf16_t*)p.out;
    bf16_t* HB = (bf16_t*)(ws + OFF_PROJ);
    float* QF = (float*)(ws + OFF_DN); float* KF = QF + BLK; float* VF = KF + BLK; float* BG = VF + BLK;
    float* OF = (float*)(ws + OFF_PROJ); float* OBk = OF + BLK;
    bf16_t* PART = (bf16_t*)(ws + 66 * MiB);
    float* T1 = (float*)(PROJ + 4 * BLK);
    float* GLp = (float*)(ws + OFF_EX + 786432);
    bf16_t* OG = (bf16_t*)p.out + BLK; bf16_t* MRG = AM;

#pragma unroll 1
    for (int rep = 0; rep < p.rep_prep; ++rep) { phase_prep(p, shm, wave, lane); __syncthreads(); }
    xcd_barrier(xb);
#pragma unroll 1
    for (int rep = 0; rep < p.rep_thin; ++rep) phase_norm<1>(p, nullptr, X0, p.norm_ffn1, 0, AM, wave, lane);
    xcd_barrier(xb);
    { pg8::EpiSwiglu E; E.H = HB; run_gemm(lds3, AM, (const bf16_t*)(ws + OFF_WGU), 5632, 1024, E, p.rep_gemm); }
    side_transposes(p, shm, wave, lane, 0, 16);
    xcd_barrier(xb);
    { pg8::EpiPartial E; E.P = PART; run_gemm(lds3, HB, (const bf16_t*)(ws + OFF_WD), 1024, FFH, E, p.rep_gemm, 2); }
    side_transposes(p, shm, wave, lane, 1, 192);
    xcd_barrier(xb);
#pragma unroll 1
    for (int rep = 0; rep < p.rep_thin; ++rep) phase_norm<2>(p, X0, X1, p.norm_mix, 3, AM, wave, lane, PART, 2, 0.5f);
    xcd_barrier(xb);
    { pg8::EpiProj E; E.P = PROJ; E.EX = EX; run_gemm(lds3, AM, (const bf16_t*)(ws + OFF_WIN), 9472, 1024, E, p.rep_gemm); }
    xcd_barrier(xb);
#pragma unroll 1
    for (int rep = 0; rep < p.rep_dnpre; ++rep) for (int it = blockIdx.x; it < 768; it += gridDim.x) dn_pre_item(p, PROJ, EX, ws + OFF_DN, GLp, shm, it >> 3, it & 7);
#pragma unroll 1
    for (int rep = 0; rep < p.rep_thin; ++rep) phase_branch_a(p, PROJ, AM, wave, lane);
    xcd_barrier(xb);
#pragma unroll 1
    for (int rep = 0; rep < p.rep_scan; ++rep) phase_dn_scan(p, ws + OFF_DN, GLp, OF, OBk, shm);
    {
        pg8::EpiGate<0> E; E.G = PROJ + 7 * BLK; E.T = T1; E.O = nullptr;
        pg8::Gemm g; g.A = AM; g.Bt = (const bf16_t*)(ws + OFF_WCO); g.M = NTOK; g.N = 1024; g.K = 1024; g.klen = 1024; g.nsp = 4;
        const bool sub = gridDim.x >= 256;
        const int G = sub ? 96 : (int)gridDim.x, c = sub ? (int)blockIdx.x - 64 : (int)blockIdx.x;
        if (c >= 0 && c < G) { pg8::StaticOrder S; S.init(NTOK, 1024, G, c); pg8::gemm_phase<pg8::EpiGate<0>, pg8::StaticOrder, false>(lds3, g, S, E, nullptr); }
        __syncthreads();
    }
    xcd_barrier(xb);
#pragma unroll 1
    for (int rep = 0; rep < p.rep_thin; ++rep) phase_ogate(p, OF, OBk, PROJ + 6 * BLK, OG, wave, lane);
    xcd_barrier(xb);
    { pg8::EpiGate<1> E; E.G = PROJ + 8 * BLK; E.T = T1; E.O = MRG; run_gemm(lds3, OG, (const bf16_t*)(ws + OFF_WDNO), 1024, 1024, E, p.rep_gemm); }
    side_transposes(p, shm, wave, lane, 2, 96);
    xcd_barrier(xb);
    { pg8::EpiPartial E; E.P = PART; run_gemm(lds3, MRG, (const bf16_t*)(ws + OFF_WO), 1024, 1024, E, p.rep_gemm, 2); }
    xcd_barrier(xb);
#pragma unroll 1
    for (int rep = 0; rep < p.rep_thin; ++rep) phase_norm<2>(p, X1, X0, p.norm_ffn2, 6, AM, wave, lane, PART, 5, 1.0f);
    xcd_barrier(xb);
    { pg8::EpiSwiglu E; E.H = HB; run_gemm(lds3, AM, (const bf16_t*)(ws + OFF_WGU), 5632, 1024, E, p.rep_gemm); }
    xcd_barrier(xb);
    { pg8::EpiPartial E; E.P = PART; run_gemm(lds3, HB, (const bf16_t*)(ws + OFF_WD), 1024, FFH, E, p.rep_gemm, 2); }
    xcd_barrier(xb);
#pragma unroll 1
    for (int rep = 0; rep < p.rep_sync; ++rep) grid.sync();
    phase_final_norm(p, X0, PART, p.out, wave, lane);
}

extern "C" void kernel_launch(void* const* d_in, const int* in_sizes, int n_in, void* d_out, int out_size, void* d_ws, size_t ws_size, hipStream_t stream) {
    static int grid_blocks = 0;
    if (grid_blocks == 0) {
        if (n_in != 27 || ws_size < WS_NEED) { fprintf(stderr, "kernel_launch: unexpected n_in %d / ws %zu\n", n_in, ws_size); grid_blocks = -1; return; }
        int dev = 0, cus = 0, per_cu = 0;
        hipGetDevice(&dev); hipDeviceGetAttribute(&cus, hipDeviceAttributeMultiprocessorCount, dev);
        hipFuncSetAttribute((const void*)fwd_megakernel, hipFuncAttributeMaxDynamicSharedMemorySize, LDS_BYTES);
        hipOccupancyMaxActiveBlocksPerMultiprocessor(&per_cu, (const void*)fwd_megakernel, 512, LDS_BYTES);
        if (per_cu < 1) { fprintf(stderr, "kernel_launch: occupancy query says %d blocks/CU\n", per_cu); per_cu = 1; }
        (void)hipGetLastError();
        grid_blocks = cus;
    }
    if (grid_blocks < 0) return;
    Params p{};
    const float** f = (const float**)&p;
    for (int i = 0; i < 27; ++i) f[i] = (const float*)d_in[i];
    p.out = (float*)d_out; p.ws = (unsigned char*)d_ws; p.rep_prep = REP_PREP; p.rep_gemm = REP_GEMM; p.rep_dnpre = REP_DNPRE; p.rep_scan = REP_SCAN; p.rep_thin = REP_THIN; p.rep_sync = REP_SYNC;
    (void)hipMemsetAsync((unsigned char*)d_ws + OFF_BAR, 0, XCD_BAR_WORDS * sizeof(unsigned), stream);
    void* args[] = {&p};
    hipError_t e = hipLaunchCooperativeKernel((const void*)fwd_megakernel, dim3(grid_blocks), dim3(512), args, LDS_BYTES, stream);
    if (e != hipSuccess) fprintf(stderr, "cooperative launch failed: %s (grid %d)\n", hipGetErrorString(e), grid_blocks);
}
```
